# Optimizing an MI355X kernel written in HIP

```python
import jax, jax.numpy as jnp
from jax import lax
import numpy as np

D_MODEL = 2048
BATCH = 4
SEQ = 2048
DEPTH = 1
DEC_BATCH = 128
DEC_SEQ = 1
PAST_LEN = 16384
PAGE_SIZE = 128

D_POOL = D_MODEL // 2
POOL_WINDOWS = (2, 4, 8, 16)
N_POOL_GROUPS = len(POOL_WINDOWS)
POOL_GROUP = D_POOL // N_POOL_GROUPS
D_SSM = D_MODEL // 2
SSM_GROUP = 16
N_SSM_GROUPS = D_SSM // SSM_GROUP
SSM_STATE = 64
DT_MIN = 1e-3
DT_MAX = 1e-1
D_FF = 3 * D_MODEL
CONV_W = 3
D_PLE = 256
D_IN = D_POOL + D_SSM + 2 * D_MODEL
EPS = 1e-6

kernel_name = 'pool_s5_gated_hybrid_step'


def _rmsnorm(x, g):
    xf = x.astype(jnp.float32)
    y = xf * lax.rsqrt(jnp.mean(xf * xf, axis=-1, keepdims=True) + EPS)
    return (y * g.astype(jnp.float32)).astype(x.dtype)


def _causal_pool(u, past, past_valid, w_pool, pool_scale):
    n, t, _ = u.shape
    lb = past.shape[1]
    ext = jnp.concatenate([past.astype(u.dtype), u], axis=1)
    extf = ext.astype(jnp.float32)
    valid = jnp.concatenate([jnp.full((lb,), past_valid, jnp.float32),
                             jnp.ones((t,), jnp.float32)])
    cc = jnp.concatenate([jnp.zeros((1,), jnp.float32), jnp.cumsum(valid)])
    hi = lb + 1
    outs = []
    for k, w in enumerate(POOL_WINDOWS):
        seg = extf[:, :, k * POOL_GROUP:(k + 1) * POOL_GROUP]
        cs = jnp.pad(jnp.cumsum(seg, axis=1), ((0, 0), (1, 0), (0, 0)))
        lo = lb + 1 - w
        win_sum = cs[:, hi:hi + t] - cs[:, lo:lo + t]
        count = (cc[hi:hi + t] - cc[lo:lo + t])[None, :, None]
        diff = win_sum / count - seg[:, lb:]
        outs.append(jnp.einsum('ntc,cd->ntd', diff.astype(u.dtype), w_pool[k]))
    y = jnp.concatenate(outs, axis=-1) * pool_scale
    return y, ext[:, -lb:]


def _causal_dwconv(a, past, w_conv, b_conv):
    t = a.shape[1]
    lb = past.shape[1]
    ext = jnp.concatenate([past.astype(a.dtype), a], axis=1)
    y = b_conv
    for j in range(CONV_W):
        y = y + w_conv[j] * ext[:, j:j + t]
    return y, ext[:, -lb:]


def _cmul_combine(e1, e2):
    a1r, a1i, b1r, b1i = e1
    a2r, a2i, b2r, b2i = e2
    ar = a2r * a1r - a2i * a1i
    ai = a2r * a1i + a2i * a1r
    br = a2r * b1r - a2i * b1i + b2r
    bi = a2r * b1i + a2i * b1r + b2i
    return (ar, ai, br, bi)


def _s5(u, h0_re, h0_im, lam_re, lam_im, log_dt, b_re, b_im, c_re, c_im, d_skip):
    n, t, _ = u.shape
    uf = u.astype(jnp.float32).reshape(n, t, N_SSM_GROUPS, SSM_GROUP)
    dt = jnp.exp(log_dt.astype(jnp.float32))[:, None]
    lr = lam_re.astype(jnp.float32)
    li = lam_im.astype(jnp.float32)
    mag = jnp.exp(lr * dt)
    abar_re = mag * jnp.cos(li * dt)
    abar_im = mag * jnp.sin(li * dt)
    nr = abar_re - 1.0
    ni = abar_im
    den = lr * lr + li * li
    coef_re = ((nr * lr + ni * li) / den)[..., None]
    coef_im = ((ni * lr - nr * li) / den)[..., None]
    br = b_re.astype(jnp.float32)
    bi = b_im.astype(jnp.float32)
    bbar_re = coef_re * br - coef_im * bi
    bbar_im = coef_re * bi + coef_im * br
    bu_re = jnp.einsum('ntgh,gph->ntgp', uf, bbar_re)
    bu_im = jnp.einsum('ntgh,gph->ntgp', uf, bbar_im)
    a_re = jnp.broadcast_to(abar_re, bu_re.shape)
    a_im = jnp.broadcast_to(abar_im, bu_re.shape)
    acr, aci, hzr, hzi = lax.associative_scan(_cmul_combine, (a_re, a_im, bu_re, bu_im), axis=1)
    h0r = h0_re.astype(jnp.float32)[:, None]
    h0i = h0_im.astype(jnp.float32)[:, None]
    h_re = acr * h0r - aci * h0i + hzr
    h_im = acr * h0i + aci * h0r + hzi
    y = (jnp.einsum('ntgp,ghp->ntgh', h_re, c_re.astype(jnp.float32))
         - jnp.einsum('ntgp,ghp->ntgh', h_im, c_im.astype(jnp.float32))
         + d_skip.astype(jnp.float32).reshape(N_SSM_GROUPS, SSM_GROUP) * uf)
    return y.reshape(n, t, D_SSM).astype(u.dtype), h_re[:, -1], h_im[:, -1]


def _layer(x, p, pool_past, pool_valid, h0_re, h0_im, conv_past,
           g_mix, w_in, w_pool, pool_scale, lam_re, lam_im, log_dt, b_re, b_im,
           c_re, c_im, d_skip, w_glu, w_branch_pool, w_branch_ssm, w_out,
           g_ffn, w_up, w_conv, b_conv, w_down, g_ple, w_ple_gate, w_ple):
    h = _rmsnorm(x, g_mix)
    z = h @ w_in
    u_pool, u_ssm, gate_pool, gate_ssm = jnp.split(
        z, [D_POOL, D_POOL + D_SSM, D_POOL + D_SSM + D_MODEL], axis=-1)
    y_pool, pool_new = _causal_pool(u_pool, pool_past, pool_valid, w_pool, pool_scale)
    y_ssm, h_re, h_im = _s5(u_ssm, h0_re, h0_im, lam_re, lam_im, log_dt,
                            b_re, b_im, c_re, c_im, d_skip)
    g = jax.nn.gelu(y_ssm) @ w_glu
    y_ssm = g[..., :D_SSM] * jax.nn.sigmoid(g[..., D_SSM:])
    merged = (jax.nn.sigmoid(gate_pool) * (y_pool @ w_branch_pool)
              + jax.nn.sigmoid(gate_ssm) * (y_ssm @ w_branch_ssm))
    x = x + merged @ w_out
    h = _rmsnorm(x, g_ffn)
    up = h @ w_up
    a, v = jnp.split(up, [D_FF], axis=-1)
    a, conv_new = _causal_dwconv(a, conv_past, w_conv, b_conv)
    x = x + (jax.nn.gelu(a) * v) @ w_down
    gate = jax.nn.sigmoid(_rmsnorm(x, g_ple) @ w_ple_gate)
    x = x + gate * (p.astype(x.dtype) @ w_ple)
    return x, pool_new, h_re.astype(x.dtype), h_im.astype(x.dtype), conv_new


def setup_inputs(seed: int = 0) -> dict:
    key = jax.random.key(seed)
    ks = jax.random.split(key, 40)
    f32 = jnp.float32

    def nrm(k, shape, scale):
        return jax.random.normal(k, shape, f32) * scale

    pool_buf = min(max(POOL_WINDOWS) - 1, PAST_LEN)
    conv_buf = min(CONV_W - 1, PAST_LEN)
    n_idx = jnp.arange(SSM_STATE, dtype=f32)
    lam_re = -0.5 + nrm(ks[12], (DEPTH, N_SSM_GROUPS, SSM_STATE), 0.01)
    lam_im = jnp.pi * n_idx + nrm(ks[13], (DEPTH, N_SSM_GROUPS, SSM_STATE), 0.01)
    log_dt = jax.random.uniform(ks[14], (DEPTH, N_SSM_GROUPS), f32,
                                float(np.log(DT_MIN)), float(np.log(DT_MAX)))
    return {
        'x_prompt': nrm(ks[0], (BATCH, SEQ, D_MODEL), 1.0),
        'x_sample': nrm(ks[1], (DEC_BATCH, DEC_SEQ, D_MODEL), 1.0),
        'cache_pool': nrm(ks[2], (DEPTH, DEC_BATCH, pool_buf, D_POOL), 1.0),
        'state_ssm_re': nrm(ks[3], (DEPTH, DEC_BATCH, N_SSM_GROUPS, SSM_STATE), 0.1),
        'state_ssm_im': nrm(ks[4], (DEPTH, DEC_BATCH, N_SSM_GROUPS, SSM_STATE), 0.1),
        'cache_conv': nrm(ks[5], (DEPTH, DEC_BATCH, conv_buf, D_FF), 1.0),
        'p_prompt': nrm(ks[6], (DEPTH, BATCH, SEQ, D_PLE), 1.0),
        'p_sample': nrm(ks[7], (DEPTH, DEC_BATCH, DEC_SEQ, D_PLE), 1.0),
        'g_mix': 1.0 + nrm(ks[8], (DEPTH, D_MODEL), 0.02),
        'w_in': nrm(ks[9], (DEPTH, D_MODEL, D_IN), D_MODEL ** -0.5),
        'w_pool': nrm(ks[10], (DEPTH, N_POOL_GROUPS, POOL_GROUP, POOL_GROUP), POOL_GROUP ** -0.5),
        'pool_scale': 1.0 + nrm(ks[11], (DEPTH, D_POOL), 0.02),
        'ssm_lam_re': lam_re,
        'ssm_lam_im': lam_im,
        'ssm_log_dt': log_dt,
        'ssm_b_re': nrm(ks[15], (DEPTH, N_SSM_GROUPS, SSM_STATE, SSM_GROUP), (2 * SSM_GROUP) ** -0.5),
        'ssm_b_im': nrm(ks[16], (DEPTH, N_SSM_GROUPS, SSM_STATE, SSM_GROUP), (2 * SSM_GROUP) ** -0.5),
        'ssm_c_re': nrm(ks[17], (DEPTH, N_SSM_GROUPS, SSM_GROUP, SSM_STATE), SSM_STATE ** -0.5),
        'ssm_c_im': nrm(ks[18], (DEPTH, N_SSM_GROUPS, SSM_GROUP, SSM_STATE), SSM_STATE ** -0.5),
        'ssm_d': nrm(ks[19], (DEPTH, D_SSM), 1.0),
        'w_glu': nrm(ks[20], (DEPTH, D_SSM, 2 * D_SSM), D_SSM ** -0.5),
        'w_branch_pool': nrm(ks[21], (DEPTH, D_POOL, D_MODEL), D_POOL ** -0.5),
        'w_branch_ssm': nrm(ks[22], (DEPTH, D_SSM, D_MODEL), D_SSM ** -0.5),
        'w_out': nrm(ks[23], (DEPTH, D_MODEL, D_MODEL), D_MODEL ** -0.5),
        'g_ffn': 1.0 + nrm(ks[24], (DEPTH, D_MODEL), 0.02),
        'w_up': nrm(ks[25], (DEPTH, D_MODEL, 2 * D_FF), D_MODEL ** -0.5),
        'w_conv': nrm(ks[26], (DEPTH, CONV_W, D_FF), CONV_W ** -0.5),
        'b_conv': nrm(ks[27], (DEPTH, D_FF), 0.01),
        'w_down': nrm(ks[28], (DEPTH, D_FF, D_MODEL), D_FF ** -0.5),
        'g_ple': 1.0 + nrm(ks[29], (DEPTH, D_MODEL), 0.02),
        'w_ple_gate': nrm(ks[30], (DEPTH, D_MODEL, D_MODEL), D_MODEL ** -0.5),
        'w_ple': nrm(ks[31], (DEPTH, D_PLE, D_MODEL), D_PLE ** -0.5),
        'g_final': 1.0 + nrm(ks[32], (D_MODEL,), 0.02),
    }


def reference(x_prompt, x_sample, cache_pool, state_ssm_re, state_ssm_im, cache_conv,
              p_prompt, p_sample, g_mix, w_in, w_pool, pool_scale, ssm_lam_re, ssm_lam_im,
              ssm_log_dt, ssm_b_re, ssm_b_im, ssm_c_re, ssm_c_im, ssm_d, w_glu,
              w_branch_pool, w_branch_ssm, w_out, g_ffn, w_up, w_conv, b_conv, w_down,
              g_ple, w_ple_gate, w_ple, g_final):
    xp, xs = x_prompt, x_sample
    nb = x_prompt.shape[0]
    pool_buf = cache_pool.shape[2]
    conv_buf = cache_conv.shape[2]
    pool_p, re_p, im_p, conv_p = [], [], [], []
    pool_s, re_s, im_s, conv_s = [], [], [], []
    for i in range(DEPTH):
        lw = (g_mix[i], w_in[i], w_pool[i], pool_scale[i], ssm_lam_re[i], ssm_lam_im[i],
              ssm_log_dt[i], ssm_b_re[i], ssm_b_im[i], ssm_c_re[i], ssm_c_im[i], ssm_d[i],
              w_glu[i], w_branch_pool[i], w_branch_ssm[i], w_out[i], g_ffn[i], w_up[i],
              w_conv[i], b_conv[i], w_down[i], g_ple[i], w_ple_gate[i], w_ple[i])
        xp, a0, a1, a2, a3 = _layer(
            xp, p_prompt[i],
            jnp.zeros((nb, pool_buf, D_POOL), xp.dtype), 0.0,
            jnp.zeros((nb, N_SSM_GROUPS, SSM_STATE), jnp.float32),
            jnp.zeros((nb, N_SSM_GROUPS, SSM_STATE), jnp.float32),
            jnp.zeros((nb, conv_buf, D_FF), xp.dtype), *lw)
        pool_p.append(a0); re_p.append(a1); im_p.append(a2); conv_p.append(a3)
        xs, b0, b1, b2, b3 = _layer(
            xs, p_sample[i], cache_pool[i], 1.0, state_ssm_re[i], state_ssm_im[i],
            cache_conv[i], *lw)
        pool_s.append(b0); re_s.append(b1); im_s.append(b2); conv_s.append(b3)
    y_prompt = _rmsnorm(xp, g_final)
    y_sample = _rmsnorm(xs, g_final)
    return (y_prompt, y_sample,
            jnp.stack(pool_p, axis=0), jnp.stack(re_p, axis=0), jnp.stack(im_p, axis=0),
            jnp.stack(conv_p, axis=0),
            jnp.stack(pool_s, axis=0), jnp.stack(re_s, axis=0), jnp.stack(im_s, axis=0),
            jnp.stack(conv_s, axis=0))
```

```cpp
#include <hip/hip_runtime.h>
#include <hip/hip_cooperative_groups.h>
#include <cstdio>
#include <cstdint>
namespace cg = cooperative_groups;

#define LAS __attribute__((address_space(3)))
typedef unsigned short bf16_t;
typedef short bf16x8 __attribute__((ext_vector_type(8)));
typedef float f32x4 __attribute__((ext_vector_type(4)));
typedef float f32x2 __attribute__((ext_vector_type(2)));
typedef unsigned u32x4 __attribute__((ext_vector_type(4)));
typedef unsigned u32x2 __attribute__((ext_vector_type(2)));

constexpr int DM = 2048, SEQ = 2048, NSMP = 128, MPR = 8192, MT = 8320, MPAD = 8448;
constexpr int DFF = 6144, DPLE = 256;
constexpr float EPS = 1e-6f;
constexpr size_t OFF_Y = 0;
constexpr size_t OFF_POOL_P = (size_t)MT * DM;
constexpr size_t OFF_RE_P = OFF_POOL_P + 4 * 15 * 1024;
constexpr size_t OFF_IM_P = OFF_RE_P + 4 * 64 * 64;
constexpr size_t OFF_CONV_P = OFF_IM_P + 4 * 64 * 64;
constexpr size_t OFF_POOL_S = OFF_CONV_P + 4 * 2 * 6144;
constexpr size_t OFF_RE_S = OFF_POOL_S + (size_t)128 * 15 * 1024;
constexpr size_t OFF_IM_S = OFF_RE_S + 128 * 64 * 64;
constexpr size_t OFF_CONV_S = OFF_IM_S + 128 * 64 * 64;
constexpr size_t MiB = 1u << 20;
constexpr size_t WS_WUP = 0, WS_WDOWN = 48 * MiB, WS_WPG = 72 * MiB, WS_WPLE = 80 * MiB, WS_WOUT = 81 * MiB, WS_WIN = 89 * MiB,
                 WS_WGLU = 113 * MiB, WS_WBP = 117 * MiB, WS_WBS = 121 * MiB, WS_WPOOL = 125 * MiB;
constexpr size_t WS_X1B = 89 * MiB;
constexpr size_t WS_P = 126 * MiB;
constexpr size_t WS_H = 159 * MiB, WS_PB = 192 * MiB;
constexpr size_t WS_U = 197 * MiB, WS_GATES = 263 * MiB;
constexpr size_t WS_DIFF = 329 * MiB, WS_SSMACT = WS_DIFF + (size_t)MPAD * 1024 * 2;
constexpr size_t WS_YCAT = 159 * MiB, WS_T1 = 197 * MiB, WS_MERGED = 329 * MiB;
constexpr size_t WS_ABUF = 159 * MiB, WS_VBUF = 258 * MiB, WS_X2B = 159 * MiB;
constexpr size_t WS_ROWSS = 372 * MiB, WS_CTL = 362 * MiB + 512 * 1024;
constexpr size_t WS_PM = 363 * MiB, WS_QM = 367 * MiB, WS_KT = 371 * MiB, WS_END = 379 * MiB;
constexpr int LDS_BYTES = 163840;

typedef __bf16 bf16x2_t __attribute__((ext_vector_type(2)));
__device__ __forceinline__ unsigned cvt_pk_bf16(float lo, float hi) { const f32x2 v = {lo, hi}; return __builtin_bit_cast(unsigned, __builtin_convertvector(v, bf16x2_t)); }
__device__ __forceinline__ float bf_lo(unsigned w) { return __uint_as_float(w << 16); }
__device__ __forceinline__ float bf_hi(unsigned w) { return __uint_as_float(w & 0xffff0000u); }
__device__ __forceinline__ float sigmoid_f(float x) { return __builtin_amdgcn_rcpf(1.0f + __builtin_amdgcn_exp2f(-1.4426950408889634f * x)); }
__device__ __forceinline__ float gelu_tanh_f(float x) { const float z = 1.5957691216057308f * (x + 0.044715f * x * x * x); return x * sigmoid_f(z); }
__device__ __forceinline__ u32x4 pack8(const f32x4 a, const f32x4 b) { u32x4 w; w.x = cvt_pk_bf16(a[0], a[1]); w.y = cvt_pk_bf16(a[2], a[3]); w.z = cvt_pk_bf16(b[0], b[1]); w.w = cvt_pk_bf16(b[2], b[3]); return w; }
__device__ __forceinline__ void unpack8(const u32x4 w, f32x4& a, f32x4& b) { a = (f32x4){bf_lo(w.x), bf_hi(w.x), bf_lo(w.y), bf_hi(w.y)}; b = (f32x4){bf_lo(w.z), bf_hi(w.z), bf_lo(w.w), bf_hi(w.w)}; }
__device__ __forceinline__ float sumsq8(const f32x4 a, const f32x4 b) { return (a[0] * a[0] + a[1] * a[1]) + (a[2] * a[2] + a[3] * a[3]) + (b[0] * b[0] + b[1] * b[1]) + (b[2] * b[2] + b[3] * b[3]); }
__device__ __forceinline__ int lane_id() { int l; asm volatile("v_mbcnt_lo_u32_b32 %0, -1, 0\n\tv_mbcnt_hi_u32_b32 %0, -1, %0" : "=v"(l)); return l; }
__device__ __forceinline__ float shfl_xor_f(float v, int lane, int m) { return __int_as_float(__builtin_amdgcn_ds_bpermute((lane ^ m) << 2, __float_as_int(v))); }
constexpr int RS_SLOTS = 64;
__device__ __forceinline__ void put_rowss(float* rs, int row, int slot, float s, int fr, int fq, bool valid) {
    const int lane = fq * 16 + fr; s += shfl_xor_f(s, lane, 16); s += shfl_xor_f(s, lane, 32);
    if (fq == 0 && valid) rs[(size_t)row * RS_SLOTS + slot] = s;
}
__device__ __forceinline__ float rs_rstd_main(const float* rs, int row, int fr, int fq) {
    const f32x4 a = *(const f32x4*)(rs + (size_t)row * RS_SLOTS + 8 * fq), b = *(const f32x4*)(rs + (size_t)row * RS_SLOTS + 8 * fq + 4);
    float s = (a[0] + a[1]) + (a[2] + a[3]) + (b[0] + b[1]) + (b[2] + b[3]); const int lane = fq * 16 + fr;
    s += shfl_xor_f(s, lane, 16); s += shfl_xor_f(s, lane, 32);
    return rsqrtf(s * (1.0f / (float)DM) + EPS);
}
__device__ __forceinline__ float rs_rstd_x(const float* rs, int row, int fr, int fq) {
    float s = 0.f;
#pragma unroll
    for (int q = 0; q < 4; ++q) { const f32x4 a = *(const f32x4*)(rs + (size_t)row * RS_SLOTS + 16 * fq + 4 * q); s += (a[0] + a[1]) + (a[2] + a[3]); }
    const int lane = fq * 16 + fr; s += shfl_xor_f(s, lane, 16); s += shfl_xor_f(s, lane, 32);
    return rsqrtf(s * (1.0f / (float)DM) + EPS);
}
__device__ __forceinline__ float wave_sum(float v, int lane) {
#pragma unroll
    for (int o = 1; o < 64; o <<= 1) v += shfl_xor_f(v, lane, o);
    return v;
}

namespace pg8 {
constexpr int BM = 256, BK = 64, HALF = 128, HTB = HALF * BK * 2, STAGE_BYTES = 8 * HTB, NXCD = 8, WGM = 4;
__device__ __forceinline__ int lds_byte(int r, int c) { const int st = (r >> 4) * 2 + (c >> 5), rr = r & 15, cc = c & 31, ob = rr * 64 + cc * 2; return st * 1024 + (ob ^ (((ob >> 9) & 1) << 5)); }
__device__ __forceinline__ void stage_rc(int b, int& R, int& C) { const int st = b / 1024, sb = b % 1024, swz = sb ^ (((sb >> 9) & 1) << 5); R = (st >> 1) * 16 + swz / 64; C = (st & 1) * 32 + (swz % 64) / 2; }
__device__ __forceinline__ int perm32(int rho) { const int n = rho >> 4, i = rho & 15; return 8 * (i >> 2) + 4 * n + (i & 3); }
struct Unit { int pm, pn; };
struct Gemm { const bf16_t* A; const bf16_t* B; int lda, ldb, K, nM, nN, a_koff, b_half_rows, b_tile_rows; int kp_shift; unsigned a_pstride, b_pstride; };
struct StaticOrder {
    int nM, nN, nwg, G, c;
    __device__ __forceinline__ void init(int nM_, int nN_, int G_, int c_) { nM = nM_; nN = nN_; nwg = nM * nN; G = G_; c = c_; }
    __device__ __forceinline__ bool next(int i, Unit& u) const {
        const long L = (long)i * G + c; if (L >= nwg) return false;
        int wgid = (int)L; { const int q = nwg / NXCD, r = nwg % NXCD, xcd = wgid % NXCD, off = wgid / NXCD; wgid = (xcd < r ? xcd * (q + 1) : r * (q + 1) + (xcd - r) * q) + off; }
        const int nig = WGM * nN, gid = wgid / nig, fm = gid * WGM, gsz = (nM - fm) < WGM ? (nM - fm) : WGM;
        u.pm = fm + ((wgid % nig) % gsz); u.pn = (wgid % nig) / gsz; return true;
    }
};

template <class Epi, bool XROWS_, int WR>
__device__ __forceinline__ void gemm_phase_wr(LAS unsigned char* lds, const Gemm g, int G, int cidx, int wave_s, const Epi& E) {
    const int lane = lane_id();
    constexpr int wr = WR;
    constexpr bool XROWS = XROWS_ && WR == 1;
    const int wid = wave_s, tid = wid * 64 + lane, wc = wid & 3, fr = lane & 15, fq = lane >> 4;
    int K = g.K; asm volatile("" : "+s"(K));
    const int nt = K / BK;
    StaticOrder S; S.init(g.nM, g.nN, G, cidx);
    unsigned voffA[2], voffB[2];
#pragma unroll
    for (int i = 0; i < 2; ++i) { int R, C; stage_rc(tid * 16 + i * 8192, R, C); const int Rb = (R & ~31) + perm32(R & 31);
        voffA[i] = (unsigned)(R * g.lda + C) * 2u; voffB[i] = (unsigned)(Rb * g.ldb + C) * 2u; }
    const unsigned kstep = (unsigned)(BK * 2);
    const unsigned kps = g.kp_shift > 0 ? (unsigned)g.kp_shift : 31u, kpm = (1u << kps) - 1u;
    const unsigned hstepA = (unsigned)HALF * g.lda * 2u, tstepA = 2u * hstepA, kofA = (unsigned)g.a_koff * 2u;
    const unsigned hstepB = (unsigned)g.b_half_rows * g.ldb * 2u, tstepB = (unsigned)g.b_tile_rows * g.ldb * 2u;
    const __amdgpu_buffer_rsrc_t rsA = __builtin_amdgcn_make_buffer_rsrc((void*)g.A, (short)0, 0x7fffffff, 0x00020000);
    const __amdgpu_buffer_rsrc_t rsB = __builtin_amdgcn_make_buffer_rsrc((void*)g.B, (short)0, 0x7fffffff, 0x00020000);
    const unsigned ldsw = (unsigned)wid * 1024u;
    const int aoff = lds_byte(wr * 64 + fr, fq * 8), boff = lds_byte(wc * 32 + fr, fq * 8);
    const unsigned voffX = (unsigned)(fr * g.lda + fq * 8) * 2u;
    const unsigned xrow0 = (unsigned)MPR * g.lda * 2u, xstep = 4u * g.lda * 2u;
#define PG8_SA(b, h) (((b) * 2 + (h)) * HTB)
#define PG8_SB(b, h) ((4 + (b) * 2 + (h)) * HTB)
#define PG8_STAGE(bufoff, rs, soff, voff) do { _Pragma("unroll") for (int _i = 0; _i < 2; ++_i) \
        __builtin_amdgcn_raw_ptr_buffer_load_lds(rs, (LAS unsigned*)(lds + (bufoff) + ldsw + _i * 8192), 16, (voff)[_i], (soff), 0, 0); } while (0)
#define PG8_LDA(dst, b, h) do { _Pragma("unroll") for (int m = 0; m < 4; ++m) _Pragma("unroll") for (int k = 0; k < 2; ++k) dst[m][k] = *(const LAS bf16x8*)(lds + PG8_SA(b, h) + aoff + m * 2048 + k * 1024); } while (0)
#define PG8_LDB(dst, b, h) do { _Pragma("unroll") for (int n = 0; n < 2; ++n) _Pragma("unroll") for (int k = 0; k < 2; ++k) dst[n][k] = *(const LAS bf16x8*)(lds + PG8_SB(b, h) + boff + n * 2048 + k * 1024); } while (0)
#define PG8_MMA(ai, bj, At, Bt) do { __builtin_amdgcn_s_setprio(1); _Pragma("unroll") for (int m = 0; m < 4; ++m) _Pragma("unroll") for (int n = 0; n < 2; ++n) _Pragma("unroll") for (int k = 0; k < 2; ++k) \
        acc[ai][bj][m][n] = __builtin_amdgcn_mfma_f32_16x16x32_bf16(Bt[n][k], At[m][k], acc[ai][bj][m][n], 0, 0, 0); __builtin_amdgcn_s_setprio(0); } while (0)
#define PG8_LOADX(dst, soff) do { if (XROWS) { _Pragma("unroll") for (int k = 0; k < 2; ++k) dst[k] = __builtin_bit_cast(bf16x8, __builtin_amdgcn_raw_buffer_load_b128(rsA, voffX + k * 64, (soff), 0)); } } while (0)
#define PG8_MMAX(Xf) do { if (!XROWS) break; __builtin_amdgcn_s_setprio(1); _Pragma("unroll") for (int k = 0; k < 2; ++k) _Pragma("unroll") for (int n = 0; n < 2; ++n) { \
        accX[n] = __builtin_amdgcn_mfma_f32_16x16x32_bf16(B0[n][k], Xf[k], accX[n], 0, 0, 0); accX[2 + n] = __builtin_amdgcn_mfma_f32_16x16x32_bf16(B1[n][k], Xf[k], accX[2 + n], 0, 0, 0); } __builtin_amdgcn_s_setprio(0); } while (0)
#define PG8_WAIT_V(n) asm volatile("s_waitcnt vmcnt(" #n ")" ::: "memory")
#define PG8_WAITV_SP2 do { if constexpr (XROWS) PG8_WAIT_V(10); else PG8_WAIT_V(8); } while (0)
#define PG8_WAIT_L(n) asm volatile("s_waitcnt lgkmcnt(" #n ")" ::: "memory")
#define PG8_BAR __builtin_amdgcn_s_barrier()
#define PG8_SCHED __builtin_amdgcn_sched_barrier(0)
    Unit cur, nxt; int ui = 0;
    if (!S.next(0, cur)) return;
    f32x4 acc[2][2][4][2];
#pragma unroll
    for (int a = 0; a < 2; ++a)
#pragma unroll
        for (int b = 0; b < 2; ++b)
#pragma unroll
            for (int m = 0; m < 4; ++m)
#pragma unroll
                for (int n = 0; n < 2; ++n) acc[a][b][m][n] = (f32x4){0.f, 0.f, 0.f, 0.f};
    bf16x8 At[4][2], B0[2][2], B1[2][2], XA[2];
    f32x4 accX[4]; accX[0] = (f32x4){0.f, 0.f, 0.f, 0.f}; accX[1] = accX[0]; accX[2] = accX[0]; accX[3] = accX[0];
    unsigned cA = (unsigned)cur.pm * tstepA + (unsigned)cur.pn * kofA, cB = (unsigned)cur.pn * tstepB;
    unsigned cX = xrow0 + (unsigned)cur.pm * xstep + (unsigned)cur.pn * kofA;
    PG8_LOADX(XA, cX);
    PG8_STAGE(PG8_SB(0, 0), rsB, cB, voffB); PG8_STAGE(PG8_SB(0, 1), rsB, cB + hstepB, voffB); PG8_STAGE(PG8_SA(0, 0), rsA, cA, voffA); PG8_STAGE(PG8_SA(0, 1), rsA, cA + hstepA, voffA);
    if (wr == 1) PG8_BAR;
    PG8_WAIT_V(2); PG8_BAR;
    PG8_STAGE(PG8_SB(1, 0), rsB, cB + kstep, voffB); PG8_STAGE(PG8_SA(1, 0), rsA, cA + kstep, voffA); PG8_STAGE(PG8_SB(1, 1), rsB, cB + hstepB + kstep, voffB);
    PG8_WAIT_V(6); PG8_BAR;
    for (;;) {
        const bool has_next = S.next(ui + 1, nxt);
        const unsigned nA = has_next ? (unsigned)nxt.pm * tstepA + (unsigned)nxt.pn * kofA : cA, nB = has_next ? (unsigned)nxt.pn * tstepB : cB;
        const unsigned nX = has_next ? xrow0 + (unsigned)nxt.pm * xstep + (unsigned)nxt.pn * kofA : cX;
        for (int seg = 0; seg < (Epi::MIDK ? 2 : 1); ++seg) {
        const int tbeg = (Epi::MIDK && seg == 1) ? (nt >> 1) : 0, tend = (Epi::MIDK && seg == 0) ? (nt >> 1) : nt;
        if constexpr (Epi::MIDK) { if (seg == 1) E.mid(acc, accX, cur, wr, wc, fr, fq); }
        for (int t = tbeg; t < tend; t += 2) {
            const bool last = (t == nt - 2);
            const unsigned t1 = (unsigned)(t + 1), t2 = (unsigned)(t + 2);
            const unsigned ko1 = (t1 & kpm) * kstep, ko2 = (t2 & kpm) * kstep, pa1 = (t1 >> kps) * g.a_pstride, pa2 = (t2 >> kps) * g.a_pstride, pb2 = (t2 >> kps) * g.b_pstride;
            const unsigned a1 = cA + pa1 + ko1, x1 = cX + pa1 + ko1;
            const unsigned a2 = last ? nA : cA + pa2 + ko2, b2 = last ? nB : cB + pb2 + ko2;
            const unsigned a3 = a2 + kstep, b3 = b2 + kstep, x2 = last ? nX : cX + pa2 + ko2;
            PG8_LDB(B0, 0, 0); PG8_LDB(B1, 0, 1); PG8_SCHED; PG8_LDA(At, 0, 0); PG8_STAGE(PG8_SA(1, 1), rsA, a1 + hstepA, voffA);
            PG8_WAIT_V(8); PG8_WAIT_L(0); PG8_BAR; PG8_MMA(0, 0, At, B0); PG8_MMA(0, 1, At, B1); PG8_MMAX(XA); PG8_LOADX(XA, x1); PG8_BAR; PG8_SCHED;
            PG8_LDA(At, 0, 1); PG8_STAGE(PG8_SB(0, 0), rsB, b2, voffB); PG8_STAGE(PG8_SB(0, 1), rsB, b2 + hstepB, voffB); PG8_STAGE(PG8_SA(0, 0), rsA, a2, voffA);
            PG8_WAITV_SP2; PG8_WAIT_L(0); PG8_BAR; PG8_MMA(1, 0, At, B0); PG8_MMA(1, 1, At, B1); PG8_BAR; PG8_SCHED;
            PG8_LDB(B0, 1, 0); PG8_LDB(B1, 1, 1); PG8_SCHED; PG8_LDA(At, 1, 0); PG8_STAGE(PG8_SA(0, 1), rsA, a2 + hstepA, voffA);
            PG8_WAIT_V(8); PG8_WAIT_L(0); PG8_BAR; PG8_MMA(0, 0, At, B0); PG8_MMA(0, 1, At, B1); PG8_MMAX(XA); PG8_LOADX(XA, x2); PG8_BAR; PG8_SCHED;
            PG8_LDA(At, 1, 1); PG8_STAGE(PG8_SB(1, 0), rsB, b3, voffB); PG8_STAGE(PG8_SB(1, 1), rsB, b3 + hstepB, voffB); PG8_STAGE(PG8_SA(1, 0), rsA, a3, voffA);
            PG8_WAITV_SP2; PG8_WAIT_L(0); PG8_BAR; PG8_MMA(1, 0, At, B0); PG8_MMA(1, 1, At, B1); PG8_BAR; PG8_SCHED;
        }
        }
        if (wr == 0) PG8_BAR;
        if constexpr (XROWS) { { const f32x4 ax2[2] = {accX[0], accX[2]}; E.x(ax2, cur, 0, wc, fr, fq); } { const f32x4 ax3[2] = {accX[1], accX[3]}; E.x(ax3, cur, 1, wc, fr, fq); } }
        E(acc, cur, wr, wc, fr, fq);
        if (!has_next) break;
        accX[0] = (f32x4){0.f, 0.f, 0.f, 0.f}; accX[1] = accX[0]; accX[2] = accX[0]; accX[3] = accX[0];
#pragma unroll
        for (int a = 0; a < 2; ++a)
#pragma unroll
            for (int b = 0; b < 2; ++b)
#pragma unroll
                for (int m = 0; m < 4; ++m)
#pragma unroll
                    for (int n = 0; n < 2; ++n) acc[a][b][m][n] = (f32x4){0.f, 0.f, 0.f, 0.f};
        cur = nxt; cA = nA; cB = nB; cX = nX; ++ui;
        if (wr == 1) PG8_BAR;
    }
    PG8_WAIT_V(0);
    PG8_BAR;
#undef PG8_SA
#undef PG8_SB
#undef PG8_STAGE
#undef PG8_LDA
#undef PG8_LDB
#undef PG8_MMA
#undef PG8_LOADX
#undef PG8_MMAX
#undef PG8_WAIT_V
#undef PG8_WAITV_SP2
#undef PG8_WAIT_L
#undef PG8_BAR
#undef PG8_SCHED
}
template <class Epi, bool XROWS = true>
__device__ __forceinline__ void gemm_phase(LAS unsigned char* lds, const Gemm g, int G, int cidx, int wave_s, const Epi& E) {
    if (wave_s < 4) gemm_phase_wr<Epi, XROWS, 0>(lds, g, G, cidx, wave_s, E); else gemm_phase_wr<Epi, XROWS, 1>(lds, g, G, cidx, wave_s, E);
}
}
using pg8::Unit;

#define EPI_ARGS const f32x4 (&acc)[2][2][4][2], const Unit& u, int wr, int wc, int fr, int fq
#define EPI_FOR_ROWS _Pragma("unroll") for (int ai = 0; ai < 2; ++ai) _Pragma("unroll") for (int m = 0; m < 4; ++m)
#define EPI_ROW (u.pm * 256 + ai * 128 + wr * 64 + m * 16 + fr)

#define XROW_SETUP const bool valid = fr < 4; const int row = MPR + 4 * u.pm + fr; const int cq = wc * 32 + 8 * fq + 4 * wr; (void)valid; (void)row; (void)cq;
__device__ __forceinline__ u32x2 pack4(const f32x4 a) { u32x2 w; w.x = cvt_pk_bf16(a[0], a[1]); w.y = cvt_pk_bf16(a[2], a[3]); return w; }
__device__ __forceinline__ f32x4 unpack4(const u32x2 w) { return (f32x4){bf_lo(w.x), bf_hi(w.x), bf_lo(w.y), bf_hi(w.y)}; }
__device__ __forceinline__ float sumsq4(const f32x4 a) { return (a[0] * a[0] + a[1] * a[1]) + (a[2] * a[2] + a[3] * a[3]); }
#define XEPI_ARGS const f32x4 (&ax)[2], const Unit& u, int wr, int wc, int fr, int fq

struct EpiZ { static constexpr bool MIDK = false;
    bf16_t* U; bf16_t* GATES; float* out;
    __device__ __forceinline__ void operator()(EPI_ARGS) const {
        const int colh = wc * 32 + 8 * fq;
        if (u.pn < 8) {
            EPI_FOR_ROWS { const int row = EPI_ROW;
#pragma unroll
                for (int bj = 0; bj < 2; ++bj) { const int col = u.pn * 256 + bj * 128 + colh;
                    *(u32x4*)(U + (size_t)row * 2048 + col) = pack8(acc[ai][bj][m][0], acc[ai][bj][m][1]);
                    if (u.pn < 4) { const int t = row & 2047;
                        if (t >= 2033) { float* q = out + OFF_POOL_P + ((size_t)((row >> 11) * 15 + (t - 2033))) * 1024 + col; *(f32x4*)q = acc[ai][bj][m][0]; *(f32x4*)(q + 4) = acc[ai][bj][m][1]; } } } }
        } else {
            EPI_FOR_ROWS { const int row = EPI_ROW;
#pragma unroll
                for (int bj = 0; bj < 2; ++bj) { const int col = (u.pn - 8) * 256 + bj * 128 + colh; f32x4 v0 = acc[ai][bj][m][0], v1 = acc[ai][bj][m][1];
#pragma unroll
                    for (int j = 0; j < 4; ++j) { v0[j] = sigmoid_f(v0[j]); v1[j] = sigmoid_f(v1[j]); }
                    *(u32x4*)(GATES + (size_t)row * 4096 + col) = pack8(v0, v1); } }
        }
    }
    __device__ __forceinline__ void x(XEPI_ARGS) const { XROW_SETUP
        if (!valid) return;
#pragma unroll
        for (int bj = 0; bj < 2; ++bj) { const int col = u.pn * 256 + bj * 128 + cq;
            if (u.pn < 8) { *(u32x2*)(U + (size_t)row * 2048 + col) = pack4(ax[bj]); if (u.pn < 4) *(f32x4*)(out + OFF_POOL_S + ((size_t)(row - MPR) * 15 + 14) * 1024 + col) = ax[bj]; }
            else { f32x4 v = ax[bj];
#pragma unroll
                for (int j = 0; j < 4; ++j) v[j] = sigmoid_f(v[j]);
                *(u32x2*)(GATES + (size_t)row * 4096 + col - 2048) = pack4(v); } }
    }
};
struct EpiBf { static constexpr bool MIDK = false;
    bf16_t* O; int ldo; const float* cscale;
    __device__ __forceinline__ void operator()(EPI_ARGS) const {
        const int colh = wc * 32 + 8 * fq;
#pragma unroll
        for (int bj = 0; bj < 2; ++bj) { const int col = u.pn * 256 + bj * 128 + colh;
            f32x4 s0 = (f32x4){1.f, 1.f, 1.f, 1.f}, s1 = s0; if (cscale) { s0 = *(const f32x4*)(cscale + col); s1 = *(const f32x4*)(cscale + col + 4); }
            EPI_FOR_ROWS { const int row = EPI_ROW; *(u32x4*)(O + (size_t)row * ldo + col) = pack8(acc[ai][bj][m][0] * s0, acc[ai][bj][m][1] * s1); } }
    }
    __device__ __forceinline__ void x(XEPI_ARGS) const { XROW_SETUP
        if (!valid) return;
#pragma unroll
        for (int bj = 0; bj < 2; ++bj) { const int col = u.pn * 256 + bj * 128 + cq; f32x4 v = ax[bj]; if (cscale) v = v * *(const f32x4*)(cscale + col);
            *(u32x2*)(O + (size_t)row * ldo + col) = pack4(v); }
    }
};
struct EpiGlu { static constexpr bool MIDK = false;
    bf16_t* O; int ldo; int coff;
    __device__ __forceinline__ void operator()(EPI_ARGS) const {
        const int col = coff + u.pn * 128 + wc * 32 + 8 * fq;
        EPI_FOR_ROWS { const int row = EPI_ROW; f32x4 v0 = acc[ai][0][m][0], v1 = acc[ai][0][m][1]; const f32x4 g0 = acc[ai][1][m][0], g1 = acc[ai][1][m][1];
#pragma unroll
            for (int j = 0; j < 4; ++j) { v0[j] *= sigmoid_f(g0[j]); v1[j] *= sigmoid_f(g1[j]); }
            *(u32x4*)(O + (size_t)row * ldo + col) = pack8(v0, v1); }
    }
    __device__ __forceinline__ void x(XEPI_ARGS) const { XROW_SETUP
        if (!valid) return;
        f32x4 v = ax[0];
#pragma unroll
        for (int j = 0; j < 4; ++j) v[j] *= sigmoid_f(ax[1][j]);
        *(u32x2*)(O + (size_t)row * ldo + coff + u.pn * 128 + cq) = pack4(v);
    }
};
struct EpiMerge { static constexpr bool MIDK = true;
    const bf16_t* GATES; bf16_t* MERGED;
    static __device__ __forceinline__ f32x4 clampg(f32x4 g) { return (f32x4){fmaxf(g[0], 1e-20f), fmaxf(g[1], 1e-20f), fmaxf(g[2], 1e-20f), fmaxf(g[3], 1e-20f)}; }
    static __device__ __forceinline__ f32x4 rcp4(f32x4 g) { return (f32x4){__builtin_amdgcn_rcpf(g[0]), __builtin_amdgcn_rcpf(g[1]), __builtin_amdgcn_rcpf(g[2]), __builtin_amdgcn_rcpf(g[3])}; }
    __device__ __forceinline__ void mid(f32x4 (&acc)[2][2][4][2], f32x4 (&ax)[4], const Unit& u, int wr, int wc, int fr0, int fq) const {
        int fr = fr0; asm volatile("" : "+v"(fr));
        const int colh = wc * 32 + 8 * fq;
#pragma unroll
        for (int ai = 0; ai < 2; ++ai)
#pragma unroll
            for (int m = 0; m < 4; ++m) { u32x4 gp[2], gs[2];
#pragma unroll
                for (int bj = 0; bj < 2; ++bj) { const bf16_t* gr = GATES + (size_t)EPI_ROW * 4096 + u.pn * 256 + bj * 128 + colh; gp[bj] = *(const u32x4*)gr; gs[bj] = *(const u32x4*)(gr + 2048); }
#pragma unroll
                for (int bj = 0; bj < 2; ++bj) { f32x4 p0, p1, s0, s1; unpack8(gp[bj], p0, p1); unpack8(gs[bj], s0, s1);
                    acc[ai][bj][m][0] = acc[ai][bj][m][0] * (p0 * rcp4(clampg(s0))); acc[ai][bj][m][1] = acc[ai][bj][m][1] * (p1 * rcp4(clampg(s1))); }
                if (m & 1) asm volatile("" ::: "memory"); }
        if (wr == 0) return;
        const int row = MPR + 4 * u.pm + (fr & 3);
#pragma unroll
        for (int bj = 0; bj < 2; ++bj)
#pragma unroll
            for (int n = 0; n < 2; ++n) { const bf16_t* gr = GATES + (size_t)row * 4096 + u.pn * 256 + bj * 128 + wc * 32 + 8 * fq + 4 * n;
                ax[2 * bj + n] = ax[2 * bj + n] * (unpack4(*(const u32x2*)gr) * rcp4(clampg(unpack4(*(const u32x2*)(gr + 2048))))); }
    }
    __device__ __forceinline__ void operator()(EPI_ARGS) const {
        const int colh = wc * 32 + 8 * fq;
#pragma unroll
        for (int ai = 0; ai < 2; ++ai) { u32x4 gs[4][2];
#pragma unroll
            for (int m = 0; m < 4; ++m)
#pragma unroll
                for (int bj = 0; bj < 2; ++bj) gs[m][bj] = *(const u32x4*)(GATES + (size_t)EPI_ROW * 4096 + 2048 + u.pn * 256 + bj * 128 + colh);
#pragma unroll
            for (int m = 0; m < 4; ++m) { const int row = EPI_ROW;
#pragma unroll
                for (int bj = 0; bj < 2; ++bj) { const int col = u.pn * 256 + bj * 128 + colh; f32x4 s0, s1; unpack8(gs[m][bj], s0, s1);
                    *(u32x4*)(MERGED + (size_t)row * 2048 + col) = pack8(acc[ai][bj][m][0] * clampg(s0), acc[ai][bj][m][1] * clampg(s1)); } }
            asm volatile("" ::: "memory"); }
    }
    __device__ __forceinline__ void x(XEPI_ARGS) const { XROW_SETUP
        if (!valid) return;
#pragma unroll
        for (int bj = 0; bj < 2; ++bj) { const int col = u.pn * 256 + bj * 128 + cq; const f32x4 g = clampg(unpack4(*(const u32x2*)(GATES + (size_t)row * 4096 + 2048 + col)));
            *(u32x2*)(MERGED + (size_t)row * 2048 + col) = pack4(ax[bj] * g); }
    }
};
template <bool SRC_BF16> struct EpiRes { static constexpr bool MIDK = false;
    const float* xp; const float* xs; const bf16_t* XS; bf16_t* XB; float* rs;
    __device__ __forceinline__ void operator()(EPI_ARGS) const {
        const int colh = wc * 32 + 8 * fq;
#pragma unroll
        for (int ai = 0; ai < 2; ++ai) { f32x4 xr[4][2][2];
#pragma unroll
            for (int m = 0; m < 4; ++m)
#pragma unroll
                for (int bj = 0; bj < 2; ++bj) { const size_t off = (size_t)EPI_ROW * 2048 + u.pn * 256 + bj * 128 + colh;
                    if (SRC_BF16) unpack8(*(const u32x4*)(XS + off), xr[m][bj][0], xr[m][bj][1]); else { xr[m][bj][0] = *(const f32x4*)(xp + off); xr[m][bj][1] = *(const f32x4*)(xp + off + 4); } }
#pragma unroll
            for (int m = 0; m < 4; ++m) { const int row = EPI_ROW; float ss = 0.f;
#pragma unroll
                for (int bj = 0; bj < 2; ++bj) { const int col = u.pn * 256 + bj * 128 + colh;
                    const f32x4 v0 = acc[ai][bj][m][0] + xr[m][bj][0], v1 = acc[ai][bj][m][1] + xr[m][bj][1];
                    *(u32x4*)(XB + (size_t)row * 2048 + col) = pack8(v0, v1); ss += sumsq8(v0, v1); }
                put_rowss(rs, row, u.pn * 4 + wc, ss, fr, fq, true); }
            asm volatile("" ::: "memory"); }
    }
    __device__ __forceinline__ void x(XEPI_ARGS) const { XROW_SETUP
        float ss = 0.f;
        if (valid) {
#pragma unroll
            for (int bj = 0; bj < 2; ++bj) { const int col = u.pn * 256 + bj * 128 + cq;
                const f32x4 xo = SRC_BF16 ? unpack4(*(const u32x2*)(XS + (size_t)row * 2048 + col)) : *(const f32x4*)(xs + (size_t)(row - MPR) * 2048 + col);
                const f32x4 v = ax[bj] + xo; *(u32x2*)(XB + (size_t)row * 2048 + col) = pack4(v); ss += sumsq4(v); } }
        put_rowss(rs, row, u.pn * 8 + wr * 4 + wc, ss, fr, fq, valid);
    }
};
__device__ __forceinline__ float dpp_prev1(float cur, float prevgrp) { const int o = __builtin_amdgcn_update_dpp(0, __float_as_int(prevgrp), 0x121, 0xf, 0xf, false);
    return __int_as_float(__builtin_amdgcn_update_dpp(o, __float_as_int(cur), 0x111, 0xf, 0xf, false)); }
__device__ __forceinline__ float dpp_prev2(float cur, float prevgrp) { const int o = __builtin_amdgcn_update_dpp(0, __float_as_int(prevgrp), 0x122, 0xf, 0xf, false);
    return __int_as_float(__builtin_amdgcn_update_dpp(o, __float_as_int(cur), 0x112, 0xf, 0xf, false)); }
constexpr size_t SA_BLK = (size_t)4 * 6144;
struct EpiUp { static constexpr bool MIDK = false;
    const float* rs; bf16_t* VB; float* SA; float* SAS; float* out; const float* WC; const float* BC;
    __device__ __forceinline__ void operator()(const f32x4 (&acc)[2][2][4][2], const Unit& u, int wr, int wc, int fr0, int fq0) const {
        int fr = fr0, fq = fq0; asm volatile("" : "+v"(fr), "+v"(fq));
        const int col = u.pn * 128 + wc * 32 + 8 * fq;
        const f32x4 w0a = *(const f32x4*)(WC + col), w0b = *(const f32x4*)(WC + col + 4), w1a = *(const f32x4*)(WC + 6144 + col), w1b = *(const f32x4*)(WC + 6144 + col + 4);
        const f32x4 w2a = *(const f32x4*)(WC + 12288 + col), w2b = *(const f32x4*)(WC + 12288 + col + 4), bca = *(const f32x4*)(BC + col), bcb = *(const f32x4*)(BC + col + 4);
        bf16_t* vbase = VB + (size_t)(u.pn >> 4) * ((size_t)MPAD * 2048) + (col & 2047);
#pragma unroll
        for (int ai = 0; ai < 2; ++ai) { f32x4 pa0, pa1; float rr[4];
#pragma unroll
            for (int m = 0; m < 4; ++m) rr[m] = rs_rstd_main(rs, EPI_ROW, fr, fq);
            float* sa = SA + (size_t)(4 * u.pm + 2 * ai + wr) * SA_BLK + col;
#pragma unroll
            for (int m = 0; m < 4; ++m) { const int row = EPI_ROW; const float r = rr[m];
                const f32x4 a0 = acc[ai][0][m][0] * r, a1 = acc[ai][0][m][1] * r, v0 = acc[ai][1][m][0] * r, v1 = acc[ai][1][m][1] * r;
                if (m == 0) { pa0 = a0; pa1 = a1; }
                f32x4 o0, o1;
#pragma unroll
                for (int j = 0; j < 4; ++j) {
                    const float c0 = bca[j] + w0a[j] * dpp_prev2(a0[j], pa0[j]) + w1a[j] * dpp_prev1(a0[j], pa0[j]) + w2a[j] * a0[j];
                    const float c1 = bcb[j] + w0b[j] * dpp_prev2(a1[j], pa1[j]) + w1b[j] * dpp_prev1(a1[j], pa1[j]) + w2b[j] * a1[j];
                    o0[j] = gelu_tanh_f(c0) * v0[j]; o1[j] = gelu_tanh_f(c1) * v1[j]; }
                if (m == 0 && fr < 2) { o0 = v0; o1 = v1; float* q = sa + (size_t)fr * 6144; *(f32x4*)q = a0; *(f32x4*)(q + 4) = a1; }
                if (m == 3 && fr >= 14) { float* q = sa + (size_t)(fr - 12) * 6144; *(f32x4*)q = a0; *(f32x4*)(q + 4) = a1;
                    const int t = row & 2047; if (t >= 2046) { float* q2 = out + OFF_CONV_P + ((size_t)((row >> 11) * 2 + (t - 2046))) * 6144 + col; *(f32x4*)q2 = a0; *(f32x4*)(q2 + 4) = a1; } }
                *(u32x4*)(vbase + (size_t)row * 2048) = pack8(o0, o1);
                pa0 = a0; pa1 = a1; }
            asm volatile("" ::: "memory"); }
    }
    __device__ __forceinline__ void x(XEPI_ARGS) const { XROW_SETUP
        const float r = rs_rstd_x(rs, valid ? row : MPR, fr, fq);
        if (!valid) return;
        const int col = u.pn * 128 + cq; const f32x4 av = ax[0] * r, vv = ax[1] * r;
        *(f32x4*)(SAS + (size_t)(row - MPR) * 6144 + col) = av;
        *(u32x2*)(VB + (size_t)(u.pn >> 4) * ((size_t)MPAD * 2048) + (size_t)row * 2048 + (col & 2047)) = pack4(vv);
        *(f32x4*)(out + OFF_CONV_S + ((size_t)(row - MPR) * 2 + 1) * 6144 + col) = av;
    }
};
struct EpiPle { static constexpr bool MIDK = false;
    const float* rs2; const bf16_t* P; const bf16_t* X2; float* rs3; bf16_t* wout;
    __device__ __forceinline__ void operator()(EPI_ARGS) const {
        const int colh = wc * 32 + 8 * fq;
#pragma unroll
        for (int ai = 0; ai < 2; ++ai)
#pragma unroll
            for (int mp = 0; mp < 2; ++mp) { u32x4 pt[2][2], xt[2][2]; float rr[2];
#pragma unroll
                for (int mm = 0; mm < 2; ++mm) { const int m = 2 * mp + mm; rr[mm] = rs_rstd_main(rs2, EPI_ROW, fr, fq);
#pragma unroll
                    for (int bj = 0; bj < 2; ++bj) { const int col = u.pn * 256 + bj * 128 + colh; pt[mm][bj] = *(const u32x4*)(P + (size_t)EPI_ROW * 2048 + col);
                        xt[mm][bj] = *(const u32x4*)(X2 + (size_t)EPI_ROW * 2048 + col); } }
#pragma unroll
                for (int mm = 0; mm < 2; ++mm) { const int m = 2 * mp + mm; const int row = EPI_ROW; float ss = 0.f; const float r = rr[mm];
#pragma unroll
                    for (int bj = 0; bj < 2; ++bj) { const int col = u.pn * 256 + bj * 128 + colh; f32x4 p0, p1; unpack8(pt[mm][bj], p0, p1);
                        f32x4 v0, v1; unpack8(xt[mm][bj], v0, v1);
#pragma unroll
                        for (int j = 0; j < 4; ++j) { v0[j] += sigmoid_f(r * acc[ai][bj][m][0][j]) * p0[j]; v1[j] += sigmoid_f(r * acc[ai][bj][m][1][j]) * p1[j]; }
                        *(u32x4*)(wout + (size_t)row * 2048 + col) = pack8(v0, v1); ss += sumsq8(v0, v1); }
                    put_rowss(rs3, row, u.pn * 4 + wc, ss, fr, fq, true); }
                asm volatile("" ::: "memory"); }
    }
    __device__ __forceinline__ void x(XEPI_ARGS) const { XROW_SETUP
        float ss = 0.f; const float r = rs_rstd_x(rs2, valid ? row : MPR, fr, fq);
        if (valid) {
#pragma unroll
            for (int bj = 0; bj < 2; ++bj) { const int col = u.pn * 256 + bj * 128 + cq; const f32x4 p = unpack4(*(const u32x2*)(P + (size_t)row * 2048 + col));
                f32x4 v = unpack4(*(const u32x2*)(X2 + (size_t)row * 2048 + col));
#pragma unroll
                for (int j = 0; j < 4; ++j) v[j] += sigmoid_f(r * ax[bj][j]) * p[j];
                *(u32x2*)(wout + (size_t)row * 2048 + col) = pack4(v); ss += sumsq4(v); } }
        put_rowss(rs3, row, u.pn * 8 + wr * 4 + wc, ss, fr, fq, valid);
    }
};

#define XB_TMO      128
#define XB_XCNT(j)  (256  + 64 * (j))
#define XB_XSUB(j)  (1280 + 64 * (j))
#define XB_XGEN(j)  (2304 + 64 * (j))
#define XB_TOP      3328
#define XB_TOPGEN   3392
#define XCD_BAR_WORDS 3456
#define XB_SPIN_CAP (1u << 22)
__device__ __forceinline__ unsigned xb_ld(unsigned* p)              { return __hip_atomic_load(p, __ATOMIC_RELAXED, __HIP_MEMORY_SCOPE_AGENT); }
__device__ __forceinline__ unsigned xb_add(unsigned* p, unsigned v) { return __hip_atomic_fetch_add(p, v, __ATOMIC_RELAXED, __HIP_MEMORY_SCOPE_AGENT); }
__device__ __forceinline__ unsigned xb_xcc_id() { return (unsigned)__builtin_amdgcn_s_getreg((3 << 11) | 20) & 0xFu; }
#define XB_SPIN(cond, bar) do { unsigned _sp = 0; while (cond) { __builtin_amdgcn_s_sleep(1); \
    if ((++_sp & 255u) == 0u) { if (xb_ld(&(bar)[XB_TMO])) break; if (_sp > XB_SPIN_CAP) { atomicAdd(&(bar)[XB_TMO], 1u); break; } } } } while (0)
struct XcdBarrier { unsigned* bar; unsigned x; volatile LAS unsigned* st; };
__device__ __forceinline__ void xcd_barrier_complete(unsigned* bar, unsigned x, unsigned G, unsigned& nloc, unsigned& nx) {
    unsigned sum, cnt, mine, sp = 0u;
    for (;;) {
        sum = 0u; cnt = 0u; mine = 0u;
#pragma unroll
        for (unsigned j = 0; j < 16; ++j) { const unsigned c = xb_ld(&bar[XB_XCNT(j)]); sum += c; cnt += (c > 0u) ? 1u : 0u; mine = (j == x) ? c : mine; }
        if (sum == G) break;
        __builtin_amdgcn_s_sleep(1);
        if ((++sp & 255u) == 0u) { if (xb_ld(&bar[XB_TMO])) break; if (sp > XB_SPIN_CAP) { atomicAdd(&bar[XB_TMO], 1u); break; } }
    }
    nloc = mine > 0u ? mine : 1u; nx = cnt > 0u ? cnt : 1u;
}
__device__ __forceinline__ void xcd_barrier(const XcdBarrier& b, bool leader, unsigned G) {
    asm volatile("s_waitcnt vmcnt(0)" ::: "memory");
    __syncthreads();
    if (leader) {
        unsigned* bar = b.bar;
        __builtin_amdgcn_s_waitcnt(0);
        unsigned nloc = b.st[0], nx = b.st[1];
        if (nloc == 0u) { xcd_barrier_complete(bar, b.x, G, nloc, nx); b.st[0] = nloc; b.st[1] = nx; }
        const unsigned old = xb_add(&bar[XB_XSUB(b.x)], 1u);
        const unsigned gen = old / nloc;
        if (old + 1u == (gen + 1u) * nloc) {
            __builtin_amdgcn_fence(__ATOMIC_RELEASE, "agent");
            asm volatile("s_waitcnt vmcnt(0)" ::: "memory");
            const unsigned og = xb_add(&bar[XB_TOP], 1u);
            const unsigned tg = og / nx;
            if (og + 1u == (tg + 1u) * nx) xb_add(&bar[XB_TOPGEN], 1u);
            else XB_SPIN(xb_ld(&bar[XB_TOPGEN]) == tg, bar);
            __builtin_amdgcn_fence(__ATOMIC_ACQUIRE, "agent");
            xb_add(&bar[XB_XGEN(b.x)], 1u);
            asm volatile("s_waitcnt vmcnt(0)" ::: "memory");
        } else {
            XB_SPIN(xb_ld(&bar[XB_XGEN(b.x)]) == gen, bar);
            __builtin_amdgcn_fence(__ATOMIC_ACQUIRE, "agent");
            asm volatile("s_waitcnt vmcnt(0)" ::: "memory");
        }
    }
    __syncthreads();
}

struct Args { const float* in[33]; float* out; unsigned char* ws; };
enum { I_XP = 0, I_XS, I_CPOOL, I_SRE, I_SIM, I_CCONV, I_PP, I_PS, I_GMIX, I_WIN, I_WPOOL, I_PSCALE, I_LRE, I_LIM, I_LOGDT, I_BRE, I_BIM, I_CRE, I_CIM, I_D,
       I_WGLU, I_WBP, I_WBS, I_WOUT, I_GFFN, I_WUP, I_WCONV, I_BCONV, I_WDOWN, I_GPLE, I_WPG, I_WPLE, I_GFINAL };

__device__ __forceinline__ void transpose_item(const float* W, int K, int N, bf16_t* WT, const float* kscale, LAS float* scr, int item, int lane, int ldw = 0) {
    if (ldw == 0) ldw = K;
    const int nblk = N >> 6, kb = item / nblk, nb = item - kb * nblk, k0 = kb * 64, n0 = nb * 64;
    const int c4 = (lane & 15) * 4, kr = lane >> 4;
    f32x4 v[16];
#pragma unroll
    for (int i = 0; i < 16; ++i) v[i] = __builtin_nontemporal_load((const f32x4*)(W + (size_t)(k0 + 4 * i + kr) * N + n0 + c4));
    if (kscale) {
#pragma unroll
        for (int i = 0; i < 16; ++i) v[i] = v[i] * kscale[k0 + 4 * i + kr]; }
#pragma unroll
    for (int i = 0; i < 16; ++i) { LAS float* s = scr + (4 * i + kr) * 65 + c4; s[0] = v[i][0]; s[1] = v[i][1]; s[2] = v[i][2]; s[3] = v[i][3]; }
    asm volatile("s_waitcnt lgkmcnt(0)" ::: "memory");
    const int c = lane & 7;
#pragma unroll
    for (int j = 0; j < 8; ++j) { const int n = (lane >> 3) + 8 * j; const LAS float* s = scr + (8 * c) * 65 + n;
        u32x4 o; o.x = cvt_pk_bf16(s[0 * 65], s[1 * 65]); o.y = cvt_pk_bf16(s[2 * 65], s[3 * 65]); o.z = cvt_pk_bf16(s[4 * 65], s[5 * 65]); o.w = cvt_pk_bf16(s[6 * 65], s[7 * 65]);
        *(u32x4*)(WT + (size_t)(n0 + n) * ldw + k0 + 8 * c) = o; }
    asm volatile("s_waitcnt lgkmcnt(0)" ::: "memory");
}


constexpr int TI_IN = 32 * 96, TI_LE = 4 * 32, TI_EARLY = TI_IN + TI_LE, TI_PL = 4 * 4 * 4, TI_G = 16 * 32, TI_O = 32 * 32, TI_U = 32 * 192, TI_DN = 96 * 32;
constexpr int TI_ALL = TI_EARLY + TI_PL + 3 * TI_G + TI_O + TI_U + TI_DN + TI_O;
#define TRANSPOSE_ITEMS(first, last) do { for (int it = (first) + gw; it < (last); it += NGW) { int r = it; \
        if (r < TI_IN) { transpose_item(a.in[I_WIN], 2048, 6144, W_IN, nullptr, scr, r, lane); continue; } r -= TI_IN; \
        if (r < TI_LE) { transpose_item(a.in[I_WPLE], 256, 2048, W_PLE, nullptr, scr, r, lane); continue; } r -= TI_LE; \
        if (r < TI_PL) { const int k = r >> 4; transpose_item(a.in[I_WPOOL] + (size_t)k * 65536, 256, 256, W_POOL + (size_t)k * 65536, nullptr, scr, r & 15, lane); continue; } r -= TI_PL; \
        if (r < TI_G) { transpose_item(a.in[I_WGLU], 1024, 2048, W_GLU, nullptr, scr, r, lane); continue; } r -= TI_G; \
        if (r < TI_G) { transpose_item(a.in[I_WBP], 1024, 2048, W_BP, nullptr, scr, r, lane, 2048); continue; } r -= TI_G; \
        if (r < TI_G) { transpose_item(a.in[I_WBS], 1024, 2048, W_BP + 1024, nullptr, scr, r, lane, 2048); continue; } r -= TI_G; \
        if (r < TI_O) { transpose_item(a.in[I_WOUT], 2048, 2048, W_OUT, nullptr, scr, r, lane); continue; } r -= TI_O; \
        if (r < TI_U) { transpose_item(a.in[I_WUP], 2048, 12288, W_UP, a.in[I_GFFN], scr, r, lane); continue; } r -= TI_U; \
        if (r < TI_DN) { const int pnl = r >> 10; transpose_item(a.in[I_WDOWN] + (size_t)pnl * 2048 * 2048, 2048, 2048, W_DOWN + (size_t)pnl * 2048 * 2048, nullptr, scr, r & 1023, lane); continue; } r -= TI_DN; \
        transpose_item(a.in[I_WPG], 2048, 2048, W_PG, a.in[I_GPLE], scr, r, lane); } } while (0)

__global__ void __launch_bounds__(512, 2) fwd_kernel(Args a) {
    extern __shared__ __attribute__((aligned(16))) unsigned char smem[];
    cg::grid_group grid = cg::this_grid();
    LAS unsigned char* lds = (LAS unsigned char*)smem;
    const int G = gridDim.x, bid = blockIdx.x;
    const int wave_s = __builtin_amdgcn_readfirstlane((int)(threadIdx.x >> 6));
#define GRID_SYNC() do { const bool _ld = (wave_s == 0) && (lane_id() == 0); xcd_barrier(xbar, _ld, (unsigned)G); } while (0)
#define FRESH_IDS const int lane = lane_id(); const int wave = wave_s, tid = wave * 64 + lane; (void)tid;
    unsigned char* ws = a.ws; float* out = a.out;
    bf16_t* W_UP = (bf16_t*)(ws + WS_WUP); bf16_t* W_DOWN = (bf16_t*)(ws + WS_WDOWN); bf16_t* W_PG = (bf16_t*)(ws + WS_WPG); bf16_t* W_PLE = (bf16_t*)(ws + WS_WPLE);
    bf16_t* W_OUT = (bf16_t*)(ws + WS_WOUT); bf16_t* W_IN = (bf16_t*)(ws + WS_WIN); bf16_t* W_GLU = (bf16_t*)(ws + WS_WGLU); bf16_t* W_BP = (bf16_t*)(ws + WS_WBP);
    bf16_t* W_BS = (bf16_t*)(ws + WS_WBS); bf16_t* W_POOL = (bf16_t*)(ws + WS_WPOOL);
    bf16_t* Hb = (bf16_t*)(ws + WS_H); bf16_t* PBb = (bf16_t*)(ws + WS_PB); bf16_t* Pb = (bf16_t*)(ws + WS_P);
    bf16_t* Ub = (bf16_t*)(ws + WS_U); bf16_t* GATES = (bf16_t*)(ws + WS_GATES);
    bf16_t* DIFF = (bf16_t*)(ws + WS_DIFF); bf16_t* SSMACT = (bf16_t*)(ws + WS_SSMACT); bf16_t* YCAT = (bf16_t*)(ws + WS_YCAT);
 bf16_t* MERGED = (bf16_t*)(ws + WS_MERGED); bf16_t* X1B = (bf16_t*)(ws + WS_X1B);
    float* SAb = (float*)(ws + WS_ABUF + 40 * MiB);
    bf16_t* VBUF = (bf16_t*)(ws + WS_VBUF); bf16_t* X2B = (bf16_t*)(ws + WS_X2B);
    float* RS1 = (float*)(ws + WS_ROWSS); float* RS2 = RS1 + (size_t)MPAD * RS_SLOTS; float* RS3 = RS2 + (size_t)MPAD * RS_SLOTS;

    XcdBarrier xbar; xbar.bar = (unsigned*)(ws + WS_CTL); xbar.st = (volatile LAS unsigned*)(lds + LDS_BYTES - 16);
    { const int t0 = threadIdx.x; if (t0 < 2) xbar.st[t0] = 0u;
      if (gridDim.y == 0x7fffu) grid.sync();
      xbar.x = xb_xcc_id(); if (t0 == 0) (void)xb_add(&xbar.bar[XB_XCNT(xbar.x)], 1u); }
    {
    {
        FRESH_IDS
        const int gtid = bid * 512 + tid, GT = G * 512;
        if (bid < 256) {
            const int g = bid >> 2, q = bid & 3;
            LAS float* La = (LAS float*)lds;
            LAS float* Lap = (LAS float*)(lds + 512);
            LAS float* Lbb = (LAS float*)(lds + 9216);
            LAS float* Lcc = (LAS float*)(lds + 17408);
            bf16_t* PM = (bf16_t*)(ws + WS_PM) + (size_t)g * 128 * 256; bf16_t* QM = (bf16_t*)(ws + WS_QM) + (size_t)g * 256 * 128; bf16_t* KT = (bf16_t*)(ws + WS_KT) + (size_t)g * 4096;
            if (tid < 64) { const int p = tid;
                const float dt = expf(a.in[I_LOGDT][g]), lr = a.in[I_LRE][g * 64 + p], li = a.in[I_LIM][g * 64 + p];
                const float mag = expf(lr * dt), ar = mag * cosf(li * dt), ai = mag * sinf(li * dt);
                const float nr = ar - 1.0f, ni = ai, den = lr * lr + li * li, cr = (nr * lr + ni * li) / den, ci = (ni * lr - nr * li) / den;
                La[p * 2] = ar; La[p * 2 + 1] = ai;
                float wr_ = 1.f, wi_ = 0.f;
                for (int d = 0; d <= 16; ++d) { Lap[(d * 64 + p) * 2] = wr_; Lap[(d * 64 + p) * 2 + 1] = wi_; const float tr = wr_ * ar - wi_ * ai, ti = wr_ * ai + wi_ * ar; wr_ = tr; wi_ = ti; }
                for (int h = 0; h < 16; ++h) { const float br = a.in[I_BRE][(size_t)(g * 64 + p) * 16 + h], bi = a.in[I_BIM][(size_t)(g * 64 + p) * 16 + h];
                    Lbb[(p * 16 + h) * 2] = cr * br - ci * bi; Lbb[(p * 16 + h) * 2 + 1] = cr * bi + ci * br; } }
            for (int i = tid; i < 1024; i += 512) { Lcc[i * 2] = a.in[I_CRE][(size_t)g * 1024 + i]; Lcc[i * 2 + 1] = a.in[I_CIM][(size_t)g * 1024 + i]; }
            __syncthreads();
            if (tid < 256) {
                const int hp = tid >> 4, h = tid & 15; float acc0 = 0.f, acc1 = 0.f, acc2 = 0.f, acc3 = 0.f;
                for (int p = 0; p < 64; ++p) { const f32x2 c = *(const LAS f32x2*)(Lcc + (hp * 64 + p) * 2), b = *(const LAS f32x2*)(Lbb + (p * 16 + h) * 2), w = *(const LAS f32x2*)(Lap + (4 * q * 64 + p) * 2), av = *(const LAS f32x2*)(La + p * 2);
                    const float mr = c[0] * b[0] - c[1] * b[1], mi = c[0] * b[1] + c[1] * b[0];
                    float zr = mr * w[0] - mi * w[1], zi = mr * w[1] + mi * w[0]; float t_;
                    acc0 += zr; t_ = zr * av[0] - zi * av[1]; zi = zr * av[1] + zi * av[0]; zr = t_;
                    acc1 += zr; t_ = zr * av[0] - zi * av[1]; zi = zr * av[1] + zi * av[0]; zr = t_;
                    acc2 += zr; t_ = zr * av[0] - zi * av[1]; zi = zr * av[1] + zi * av[0]; zr = t_;
                    acc3 += zr; }
                if (q == 0 && h == hp) acc0 += a.in[I_D][g * 16 + hp];
                bf16_t* k = KT + (size_t)(4 * q) * 256 + hp * 16 + h;
                k[0] = (bf16_t)(cvt_pk_bf16(acc0, 0.f) & 0xffffu); k[256] = (bf16_t)(cvt_pk_bf16(acc1, 0.f) & 0xffffu); k[512] = (bf16_t)(cvt_pk_bf16(acc2, 0.f) & 0xffffu); k[768] = (bf16_t)(cvt_pk_bf16(acc3, 0.f) & 0xffffu);
            }
            {
                const int pr = 32 * q + (tid >> 4), h = tid & 15, part = pr >> 6, p = pr & 63;
                const f32x2 b = *(const LAS f32x2*)(Lbb + (p * 16 + h) * 2);
                for (int s_ = 0; s_ < 16; ++s_) { const f32x2 w = *(const LAS f32x2*)(Lap + ((15 - s_) * 64 + p) * 2);
                    const float v = part ? (w[0] * b[1] + w[1] * b[0]) : (w[0] * b[0] - w[1] * b[1]);
                    PM[(size_t)pr * 256 + s_ * 16 + h] = (bf16_t)(cvt_pk_bf16(v, 0.f) & 0xffffu); } }
            {
                const int rloc = tid >> 3, tq = 4 * q + (rloc >> 4), hp = rloc & 15, pg = tid & 7; float vr[8], vi[8];
#pragma unroll
                for (int e = 0; e < 8; ++e) { const int p = pg * 8 + e; const f32x2 c = *(const LAS f32x2*)(Lcc + (hp * 64 + p) * 2), w = *(const LAS f32x2*)(Lap + ((tq + 1) * 64 + p) * 2);
                    vr[e] = c[0] * w[0] - c[1] * w[1]; vi[e] = -(c[0] * w[1] + c[1] * w[0]); }
                bf16_t* qrow = QM + (size_t)(tq * 16 + hp) * 128 + pg * 8;
                *(u32x4*)qrow = pack8((f32x4){vr[0], vr[1], vr[2], vr[3]}, (f32x4){vr[4], vr[5], vr[6], vr[7]});
                *(u32x4*)(qrow + 64) = pack8((f32x4){vi[0], vi[1], vi[2], vi[3]}, (f32x4){vi[4], vi[5], vi[6], vi[7]}); }
            __syncthreads();
        }
        LAS float* scr = (LAS float*)(lds + wave * 16640);
        const int gw = bid * 8 + wave, NGW = G * 8;
        TRANSPOSE_ITEMS(0, TI_EARLY);
        for (int row = gw; row < MPAD; row += NGW) {
            u32x2* o = (u32x2*)(Hb + (size_t)row * 2048) + lane;
            if (row < MT) {
                const float* xr = row < MPR ? a.in[I_XP] + (size_t)row * 2048 : a.in[I_XS] + (size_t)(row - MPR) * 2048;
                f32x4 v[8]; float s = 0.f;
#pragma unroll
                for (int j = 0; j < 8; ++j) { v[j] = *((const f32x4*)xr + lane + 64 * j); s += (v[j][0] * v[j][0] + v[j][1] * v[j][1]) + (v[j][2] * v[j][2] + v[j][3] * v[j][3]); }
                const float r = rsqrtf(wave_sum(s, lane) * (1.0f / 2048.0f) + EPS);
#pragma unroll
                for (int j = 0; j < 8; ++j) { const f32x4 gm = *((const f32x4*)a.in[I_GMIX] + lane + 64 * j); const f32x4 y = v[j] * r * gm; u32x2 w; w.x = cvt_pk_bf16(y[0], y[1]); w.y = cvt_pk_bf16(y[2], y[3]); o[64 * j] = w; }
            } else {
#pragma unroll
                for (int j = 0; j < 8; ++j) o[64 * j] = (u32x2){0u, 0u};
            }
        }
        for (int i = gtid; i < MPAD * 64; i += GT) { const int row = i >> 6, c4 = (i & 63) * 4; u32x2 w = (u32x2){0u, 0u};
            if (row < MT) { const float* pr = row < MPR ? a.in[I_PP] + (size_t)row * 256 : a.in[I_PS] + (size_t)(row - MPR) * 256; const f32x4 v = *(const f32x4*)(pr + c4); w.x = cvt_pk_bf16(v[0], v[1]); w.y = cvt_pk_bf16(v[2], v[3]); }
            *(u32x2*)(PBb + (size_t)row * 256 + c4) = w; }
    }
    GRID_SYNC();
    }

    {
    { pg8::Gemm g{Hb, W_IN, 2048, 2048, 2048, 32, 24, 0, 128, 256}; EpiZ E{Ub, GATES, out}; pg8::gemm_phase(lds, g, G, bid, wave_s, E); }
    { pg8::Gemm g{PBb, W_PLE, 256, 256, 256, 32, 8, 0, 128, 256}; EpiBf E{Pb, 2048, nullptr}; pg8::gemm_phase(lds, g, G, bid, wave_s, E); }
    GRID_SYNC();
    }

    {
    {
        FRESH_IDS
#define POOL_TILE(W) do { \
            if (tile < 512) { const int r0 = tile * 16, t0 = r0 & 2047; const bf16_t* up = Ub + (size_t)r0 * 2048 + c; f32x2 v[15 + W]; \
                _Pragma("unroll") for (int j = 0; j < 15 + W; ++j) { const int dr = j - (W - 1); unsigned w_ = 0u; if (t0 + dr >= 0) w_ = *(const unsigned*)(up + (long)dr * 2048); v[j] = (f32x2){bf_lo(w_), bf_hi(w_)}; } \
                f32x2 sum = (f32x2){0.f, 0.f}; _Pragma("unroll") for (int j = 0; j < W - 1; ++j) sum += v[j]; \
                _Pragma("unroll") for (int i = 0; i < 16; ++i) { const int t = t0 + i; const f32x2 cur = v[W - 1 + i]; sum += cur; \
                    const float inv = 1.0f / (float)((t + 1) < W ? (t + 1) : W); const f32x2 d = sum * inv - cur; \
                    *(unsigned*)(DIFF + (size_t)(r0 + i) * 1024 + c) = cvt_pk_bf16(d[0], d[1]); sum -= v[i]; } \
            } else { \
                { const int ns = tile - 512; const float* cp = a.in[I_CPOOL] + (size_t)ns * 15 * 1024 + c; f32x2 cr[15]; \
                    _Pragma("unroll") for (int j = 0; j < 15; ++j) cr[j] = *(const f32x2*)(cp + (size_t)j * 1024); \
                    const unsigned wc_ = *(const unsigned*)(Ub + (size_t)(MPR + ns) * 2048 + c); const f32x2 cur = (f32x2){bf_lo(wc_), bf_hi(wc_)}; f32x2 sum = cur; \
                    _Pragma("unroll") for (int j = 16 - W; j <= 14; ++j) sum += cr[j]; \
                    const f32x2 d = sum * (1.0f / (float)W) - cur; \
                    *(unsigned*)(DIFF + (size_t)(MPR + ns) * 1024 + c) = cvt_pk_bf16(d[0], d[1]); \
                    float* po = out + OFF_POOL_S + (size_t)ns * 15 * 1024 + c; \
                    _Pragma("unroll") for (int j = 0; j < 14; ++j) *(f32x2*)(po + (size_t)j * 1024) = cr[j + 1]; } \
            } } while (0)
        for (int tile = bid; tile < 512 + 128; tile += G) {
            const int c = 2 * tid, wsel = wave >> 1;
            if (wsel == 0) POOL_TILE(2); else if (wsel == 1) POOL_TILE(4); else if (wsel == 2) POOL_TILE(8); else POOL_TILE(16);
        }
#undef POOL_TILE
        LAS float* Hl = (LAS float*)(lds + 131072) + wave * 512;
        const float* LRE = a.in[I_LRE]; const float* LIM = a.in[I_LIM]; const float* LOGDT = a.in[I_LOGDT];
        typedef float f32x16 __attribute__((ext_vector_type(16)));
        constexpr int UROW = 528;
        LAS unsigned char* UL = lds;
        LAS unsigned char* SL = lds + 128 * UROW;
        LAS unsigned char* KL = lds + 256 * UROW;
        for (int item = bid; item < 256; item += G) {
            const int n = item >> 6, g = item & 63;
            const bf16_t* PM = (const bf16_t*)(ws + WS_PM) + (size_t)g * 128 * 256; const bf16_t* QM = (const bf16_t*)(ws + WS_QM) + (size_t)g * 256 * 128; const bf16_t* KT = (const bf16_t*)(ws + WS_KT) + (size_t)g * 4096;
            const int li_ = lane & 31, kq = lane >> 5;
            u32x2 ut[16];
#pragma unroll
            for (int i = 0; i < 16; ++i) { const int idx = tid + 512 * i, t = idx >> 2, qd = idx & 3; ut[i] = *(const u32x2*)(Ub + (size_t)(n * 2048 + t) * 2048 + 1024 + g * 16 + qd * 4); }
            const u32x4 ktv = *(const u32x4*)(KT + tid * 8);
            bf16x8 pmf[16], qmf[8];
            { const bf16_t* pa = PM + (size_t)(32 * (wave & 3) + li_) * 256 + 8 * kq;
#pragma unroll
              for (int ks = 0; ks < 16; ++ks) pmf[ks] = *(const bf16x8*)(pa + 16 * ks); }
            float a16r = 0.f, a16i = 0.f;
            if (wave == 0) { const float dt = expf(LOGDT[g]), lr = LRE[g * 64 + lane], li = LIM[g * 64 + lane]; const float mag = expf(lr * dt); a16r = mag * cosf(li * dt); a16i = mag * sinf(li * dt);
#pragma unroll
                for (int sq = 0; sq < 4; ++sq) { const float tr = a16r * a16r - a16i * a16i, ti = 2.0f * a16r * a16i; a16r = tr; a16i = ti; } }
            __syncthreads();
#pragma unroll
            for (int i = 0; i < 16; ++i) { const int idx = tid + 512 * i, t = idx >> 2, qd = idx & 3; *(LAS u32x2*)(UL + (t >> 4) * UROW + ((t & 15) * 16 + qd * 4) * 2) = ut[i]; }
            *(LAS u32x4*)(KL + tid * 16) = ktv;
            __syncthreads();
            {
                const int rb = wave & 3, cbp = wave >> 2; f32x16 s0, s1;
#pragma unroll
                for (int r = 0; r < 16; ++r) { s0[r] = 0.f; s1[r] = 0.f; }
                const LAS unsigned char* ub0 = UL + (64 * cbp + li_) * UROW + 16 * kq, * ub1 = ub0 + 32 * UROW;
#pragma unroll
                for (int ks = 0; ks < 16; ++ks) { const bf16x8 af = pmf[ks];
                    s0 = __builtin_amdgcn_mfma_f32_32x32x16_bf16(af, *(const LAS bf16x8*)(ub0 + 32 * ks), s0, 0, 0, 0);
                    s1 = __builtin_amdgcn_mfma_f32_32x32x16_bf16(af, *(const LAS bf16x8*)(ub1 + 32 * ks), s1, 0, 0, 0); }
                LAS unsigned char* sr0 = SL + (64 * cbp + li_) * UROW + (32 * rb + 4 * kq) * 4, * sr1 = sr0 + 32 * UROW;
#pragma unroll
                for (int rq = 0; rq < 4; ++rq) { *(LAS f32x4*)(sr0 + rq * 32) = (f32x4){s0[4 * rq], s0[4 * rq + 1], s0[4 * rq + 2], s0[4 * rq + 3]};
                                                 *(LAS f32x4*)(sr1 + rq * 32) = (f32x4){s1[4 * rq], s1[4 * rq + 1], s1[4 * rq + 2], s1[4 * rq + 3]}; }
            }
            { const bf16_t* qa = QM + (size_t)(32 * wave + li_) * 128 + 8 * kq;
#pragma unroll
              for (int kc = 0; kc < 8; ++kc) qmf[kc] = *(const bf16x8*)(qa + 16 * kc); }
            __syncthreads();
            if (wave == 0) {
                const int p = lane;
                float hr = 0.f, hi = 0.f;
#pragma unroll 8
                for (int c = 0; c < 128; ++c) { LAS unsigned char* row = SL + c * UROW;
                    const float sr = *(const LAS float*)(row + p * 4), si = *(const LAS float*)(row + 256 + p * 4);
                    const unsigned hb = cvt_pk_bf16(hr, hi);
                    *(LAS bf16_t*)(row + p * 2) = (bf16_t)(hb & 0xffffu); *(LAS bf16_t*)(row + 128 + p * 2) = (bf16_t)(hb >> 16);
                    const float nhr = a16r * hr - a16i * hi + sr, nhi = a16r * hi + a16i * hr + si; hr = nhr; hi = nhi; }
                out[OFF_RE_P + (size_t)(n * 64 + g) * 64 + p] = hr; out[OFF_IM_P + (size_t)(n * 64 + g) * 64 + p] = hi;
            }
            __syncthreads();
            {
                f32x16 y0, y1, y2, y3;
#pragma unroll
                for (int r = 0; r < 16; ++r) { y0[r] = 0.f; y1[r] = 0.f; y2[r] = 0.f; y3[r] = 0.f; }
                const int tq = 2 * wave + (li_ >> 4), hp = li_ & 15;
                const LAS unsigned char* ub = UL + li_ * UROW + 16 * kq;
                for (int ks = 0; ks <= 2 * wave + 1; ++ks) { const int d = tq - ks;
                    bf16x8 af = (bf16x8){0, 0, 0, 0, 0, 0, 0, 0}; if (d >= 0) af = *(const LAS bf16x8*)(KL + ((d * 16 + hp) * 16 + 8 * kq) * 2);
                    y0 = __builtin_amdgcn_mfma_f32_32x32x16_bf16(af, *(const LAS bf16x8*)(ub + 32 * ks), y0, 0, 0, 0);
                    y1 = __builtin_amdgcn_mfma_f32_32x32x16_bf16(af, *(const LAS bf16x8*)(ub + 32 * UROW + 32 * ks), y1, 0, 0, 0);
                    y2 = __builtin_amdgcn_mfma_f32_32x32x16_bf16(af, *(const LAS bf16x8*)(ub + 64 * UROW + 32 * ks), y2, 0, 0, 0);
                    y3 = __builtin_amdgcn_mfma_f32_32x32x16_bf16(af, *(const LAS bf16x8*)(ub + 96 * UROW + 32 * ks), y3, 0, 0, 0); }
                const LAS unsigned char* hb = SL + li_ * UROW + 16 * kq;
#pragma unroll
                for (int kc = 0; kc < 8; ++kc) { const bf16x8 af = qmf[kc];
                    y0 = __builtin_amdgcn_mfma_f32_32x32x16_bf16(af, *(const LAS bf16x8*)(hb + 32 * kc), y0, 0, 0, 0);
                    y1 = __builtin_amdgcn_mfma_f32_32x32x16_bf16(af, *(const LAS bf16x8*)(hb + 32 * UROW + 32 * kc), y1, 0, 0, 0);
                    y2 = __builtin_amdgcn_mfma_f32_32x32x16_bf16(af, *(const LAS bf16x8*)(hb + 64 * UROW + 32 * kc), y2, 0, 0, 0);
                    y3 = __builtin_amdgcn_mfma_f32_32x32x16_bf16(af, *(const LAS bf16x8*)(hb + 96 * UROW + 32 * kc), y3, 0, 0, 0); }
#define SSM_STORE(yv, cb) do { _Pragma("unroll") for (int rq = 0; rq < 4; ++rq) { f32x4 v = (f32x4){yv[4 * rq], yv[4 * rq + 1], yv[4 * rq + 2], yv[4 * rq + 3]}; \
                    _Pragma("unroll") for (int j = 0; j < 4; ++j) v[j] = gelu_tanh_f(v[j]); \
                    const int tok = 16 * (32 * (cb) + li_) + 2 * wave + (rq >> 1); \
                    *(u32x2*)(SSMACT + (size_t)(n * 2048 + tok) * 1024 + g * 16 + 8 * (rq & 1) + 4 * kq) = pack4(v); } } while (0)
                SSM_STORE(y0, 0); SSM_STORE(y1, 1); SSM_STORE(y2, 2); SSM_STORE(y3, 3);
#undef SSM_STORE
            }
        }
        __syncthreads();
        {
            const int lane = lane_id();
            const int gwv = bid * 8 + wave, g = gwv & 63, ns0 = (gwv >> 6) * 4, p = lane;
            if (gwv < 2048) {
                const float dt = expf(LOGDT[g]), lr = LRE[g * 64 + p], li = LIM[g * 64 + p];
                const float mag = expf(lr * dt), ar = mag * cosf(li * dt), ai = mag * sinf(li * dt);
                const float nr = ar - 1.0f, ni = ai, den = lr * lr + li * li, cr = (nr * lr + ni * li) / den, ci = (ni * lr - nr * li) / den;
                float Br[16], Bi[16];
#pragma unroll
                for (int q = 0; q < 4; ++q) { const f32x4 br = *(const f32x4*)(a.in[I_BRE] + (size_t)(g * 64 + p) * 16 + q * 4), bi = *(const f32x4*)(a.in[I_BIM] + (size_t)(g * 64 + p) * 16 + q * 4);
#pragma unroll
                    for (int jj = 0; jj < 4; ++jj) { Br[q * 4 + jj] = cr * br[jj] - ci * bi[jj]; Bi[q * 4 + jj] = cr * bi[jj] + ci * br[jj]; } }
                const int hp = lane & 15, pq = lane >> 4;
                f32x4 Cr[4], Ci[4];
#pragma unroll
                for (int q = 0; q < 4; ++q) { Cr[q] = *(const f32x4*)(a.in[I_CRE] + (size_t)(g * 16 + hp) * 64 + pq * 16 + q * 4); Ci[q] = *(const f32x4*)(a.in[I_CIM] + (size_t)(g * 16 + hp) * 64 + pq * 16 + q * 4); }
                const float dsk = a.in[I_D][g * 16 + hp];
#pragma unroll
                for (int k = 0; k < 4; ++k) { const int ns = ns0 + k;
                    const bf16_t* ur = Ub + (size_t)(MPR + ns) * 2048 + 1024 + g * 16; float bur = 0.f, bui = 0.f;
#pragma unroll
                    for (int q = 0; q < 4; ++q) { const f32x4 uv = unpack4(*(const u32x2*)(ur + q * 4));
#pragma unroll
                        for (int jj = 0; jj < 4; ++jj) { bur += Br[q * 4 + jj] * uv[jj]; bui += Bi[q * 4 + jj] * uv[jj]; } }
                    const float h0r = a.in[I_SRE][(size_t)(ns * 64 + g) * 64 + p], h0i = a.in[I_SIM][(size_t)(ns * 64 + g) * 64 + p];
                    const float hr = ar * h0r - ai * h0i + bur, hi = ar * h0i + ai * h0r + bui;
                    out[OFF_RE_S + (size_t)(ns * 64 + g) * 64 + p] = hr; out[OFF_IM_S + (size_t)(ns * 64 + g) * 64 + p] = hi;
                    *(LAS f32x2*)(Hl + k * 128 + p * 2) = (f32x2){hr, hi};
                    float y = 0.f;
#pragma unroll
                    for (int q = 0; q < 4; ++q)
#pragma unroll
                        for (int jj = 0; jj < 4; ++jj) { const f32x2 hv = *(const LAS f32x2*)(Hl + k * 128 + (pq * 16 + q * 4 + jj) * 2); y += Cr[q][jj] * hv[0] - Ci[q][jj] * hv[1]; }
                    y += shfl_xor_f(y, lane, 16); y += shfl_xor_f(y, lane, 32);
                    if (pq == 0) { y = gelu_tanh_f(y + dsk * bf_lo((unsigned)ur[hp])); SSMACT[(size_t)(MPR + ns) * 1024 + g * 16 + hp] = (bf16_t)(cvt_pk_bf16(y, 0.f) & 0xffffu); }
                }
            }
        }
        __syncthreads();
        { const int lane = lane_id(); LAS float* scr = (LAS float*)(lds + wave * 16640); const int gw = bid * 8 + wave, NGW = G * 8; TRANSPOSE_ITEMS(TI_EARLY, TI_ALL); }
}
    GRID_SYNC();
    }

    {
    { pg8::Gemm g{DIFF, W_POOL, 1024, 256, 256, 32, 4, 256, 128, 256}; EpiBf E{YCAT, 2048, a.in[I_PSCALE]}; pg8::gemm_phase(lds, g, G, bid, wave_s, E); }
    { pg8::Gemm g{SSMACT, W_GLU, 1024, 1024, 1024, 32, 8, 0, 1024, 128}; EpiGlu E{YCAT, 2048, 1024}; pg8::gemm_phase(lds, g, G, bid, wave_s, E); }
    GRID_SYNC();
    }

    {
    { pg8::Gemm g{YCAT, W_BP, 2048, 2048, 2048, 32, 8, 0, 128, 256}; EpiMerge E{GATES, MERGED}; pg8::gemm_phase(lds, g, G, bid, wave_s, E); }
    GRID_SYNC();
    }

    {
    { pg8::Gemm g{MERGED, W_OUT, 2048, 2048, 2048, 32, 8, 0, 128, 256}; EpiRes<false> E{a.in[I_XP], a.in[I_XS], nullptr, X1B, RS1}; pg8::gemm_phase(lds, g, G, bid, wave_s, E); }
    GRID_SYNC();
    }

    {
    { pg8::Gemm g{X1B, W_UP, 2048, 2048, 2048, 32, 48, 0, 6144, 128}; EpiUp E{RS1, VBUF, SAb, SAb + 128 * SA_BLK, out, a.in[I_WCONV], a.in[I_BCONV]}; pg8::gemm_phase(lds, g, G, bid, wave_s, E); }
    GRID_SYNC();
    }

    {
    {
        FRESH_IDS
        const float* WC = a.in[I_WCONV]; const float* BC = a.in[I_BCONV]; const float* CC = a.in[I_CCONV]; const float* SAS = SAb + 128 * SA_BLK;
        for (int id = bid * 512 + tid; id < (256 + 128) * 768; id += G * 512) {
            const int ri = id / 768, c0 = (id - ri * 768) * 8;
            const f32x4 w0a = *(const f32x4*)(WC + c0), w0b = *(const f32x4*)(WC + c0 + 4), w1a = *(const f32x4*)(WC + 6144 + c0), w1b = *(const f32x4*)(WC + 6144 + c0 + 4);
            const f32x4 w2a = *(const f32x4*)(WC + 12288 + c0), w2b = *(const f32x4*)(WC + 12288 + c0 + 4), bca = *(const f32x4*)(BC + c0), bcb = *(const f32x4*)(BC + c0 + 4);
            const f32x4 z4 = (f32x4){0.f, 0.f, 0.f, 0.f};
            f32x4 a0, a1, m1a = z4, m1b = z4, m2a = z4, m2b = z4; int row;
            if (ri < 256) { const int blk = ri >> 1, j = ri & 1; row = 64 * blk + j; const bool first = (blk & 31) == 0;
                const float* sb = SAb + (size_t)blk * SA_BLK + c0; a0 = *(const f32x4*)(sb + (size_t)j * 6144); a1 = *(const f32x4*)(sb + (size_t)j * 6144 + 4);
                const float* sp = sb - SA_BLK;
                if (j == 0) { if (!first) { m1a = *(const f32x4*)(sp + 3 * 6144); m1b = *(const f32x4*)(sp + 3 * 6144 + 4); m2a = *(const f32x4*)(sp + 2 * 6144); m2b = *(const f32x4*)(sp + 2 * 6144 + 4); } }
                else { m1a = *(const f32x4*)sb; m1b = *(const f32x4*)(sb + 4); if (!first) { m2a = *(const f32x4*)(sp + 3 * 6144); m2b = *(const f32x4*)(sp + 3 * 6144 + 4); } }
            } else { const int ns = ri - 256; row = MPR + ns; const float* c = CC + (size_t)ns * 2 * 6144 + c0;
                m2a = *(const f32x4*)c; m2b = *(const f32x4*)(c + 4); m1a = *(const f32x4*)(c + 6144); m1b = *(const f32x4*)(c + 6144 + 4);
                a0 = *(const f32x4*)(SAS + (size_t)ns * 6144 + c0); a1 = *(const f32x4*)(SAS + (size_t)ns * 6144 + c0 + 4);
                float* q = out + OFF_CONV_S + (size_t)ns * 2 * 6144 + c0; *(f32x4*)q = m1a; *(f32x4*)(q + 4) = m1b; }
            bf16_t* vp = VBUF + (size_t)(c0 >> 11) * ((size_t)MPAD * 2048) + (size_t)row * 2048 + (c0 & 2047); f32x4 v0, v1; unpack8(*(const u32x4*)vp, v0, v1);
            f32x4 ca = bca + w0a * m2a + w1a * m1a + w2a * a0, cb = bcb + w0b * m2b + w1b * m1b + w2b * a1;
#pragma unroll
            for (int j = 0; j < 4; ++j) { ca[j] = gelu_tanh_f(ca[j]) * v0[j]; cb[j] = gelu_tanh_f(cb[j]) * v1[j]; }
            *(u32x4*)vp = pack8(ca, cb);
        }
    }
    GRID_SYNC();
    }

    {
    { pg8::Gemm g{VBUF, W_DOWN, 2048, 2048, 6144, 32, 8, 0, 128, 256, 5, (unsigned)((size_t)MPAD * 2048 * 2), (unsigned)(2048u * 2048u * 2u)}; EpiRes<true> E{nullptr, nullptr, X1B, X2B, RS2}; pg8::gemm_phase(lds, g, G, bid, wave_s, E); }
    GRID_SYNC();
    }

    {
    { pg8::Gemm g{X2B, W_PG, 2048, 2048, 2048, 32, 8, 0, 128, 256}; EpiPle E{RS2, Pb, X2B, RS3, X1B}; pg8::gemm_phase(lds, g, G, bid, wave_s, E); }
    GRID_SYNC();
    }

    { FRESH_IDS
    for (int row = bid * 8 + wave; row < MT; row += G * 8) {
        const float r = rsqrtf(wave_sum((row < MPR && lane >= 32) ? 0.f : RS3[(size_t)row * RS_SLOTS + lane], lane) * (1.0f / (float)DM) + EPS);
        const u32x4* xi = (const u32x4*)(X1B + (size_t)row * 2048) + lane; f32x4* o = (f32x4*)(out + (size_t)row * 2048) + 2 * lane;
#pragma unroll
        for (int j = 0; j < 4; ++j) { f32x4 v0, v1; unpack8(xi[64 * j], v0, v1); const f32x4 g0 = *((const f32x4*)a.in[I_GFINAL] + 2 * lane + 128 * j), g1 = *((const f32x4*)a.in[I_GFINAL] + 2 * lane + 128 * j + 1);
            o[128 * j] = v0 * r * g0; o[128 * j + 1] = v1 * r * g1; }
    } }
}

extern "C" void kernel_launch(void* const* d_in, const int* in_sizes, int n_in, void* d_out, int out_size, void* d_ws, size_t ws_size, hipStream_t stream) {
    static int grid = 0;
    if (grid == 0) {
        if (n_in != 33 || ws_size < WS_END) { fprintf(stderr, "kernel_launch: unexpected n_in %d or ws_size %zu (< %zu)\n", n_in, ws_size, (size_t)WS_END); grid = -1; return; }
        int dev = 0, cus = 0, per_cu = 0;
        (void)hipGetDevice(&dev); (void)hipDeviceGetAttribute(&cus, hipDeviceAttributeMultiprocessorCount, dev);
        if (hipFuncSetAttribute((const void*)fwd_kernel, hipFuncAttributeMaxDynamicSharedMemorySize, LDS_BYTES) != hipSuccess) { fprintf(stderr, "kernel_launch: hipFuncSetAttribute failed\n"); grid = -1; return; }
        if (hipOccupancyMaxActiveBlocksPerMultiprocessor(&per_cu, (const void*)fwd_kernel, 512, LDS_BYTES) != hipSuccess || per_cu < 1) { fprintf(stderr, "kernel_launch: occupancy query says %d blocks/CU\n", per_cu); grid = -1; return; }
        grid = cus;
        fprintf(stderr, "kernel_launch: grid %d (per_cu %d), ws %zu\n", grid, per_cu, ws_size);
    }
    if (grid < 0) return;
    if (hipMemsetAsync((char*)d_ws + WS_CTL, 0, XCD_BAR_WORDS * sizeof(unsigned), stream) != hipSuccess) { fprintf(stderr, "kernel_launch: hipMemsetAsync of the barrier words failed\n"); return; }
    Args a{};
    for (int i = 0; i < 33; ++i) a.in[i] = (const float*)d_in[i];
    a.out = (float*)d_out; a.ws = (unsigned char*)d_ws;
    void* args[] = {&a};
    hipError_t e = hipLaunchCooperativeKernel((const void*)fwd_kernel, dim3(grid), dim3(512), args, LDS_BYTES, stream);
    if (e != hipSuccess) fprintf(stderr, "kernel_launch: cooperative launch failed: %s\n", hipGetErrorString(e));
}
```

```cpp
#include <hip/hip_runtime.h>
#include <hip/hip_cooperative_groups.h>
#include <cstdio>
#include <cstdint>
namespace cg = cooperative_groups;

#define LAS __attribute__((address_space(3)))
typedef unsigned short bf16_t;
typedef short bf16x8 __attribute__((ext_vector_type(8)));
typedef float f32x4 __attribute__((ext_vector_type(4)));
typedef float f32x2 __attribute__((ext_vector_type(2)));
typedef unsigned u32x4 __attribute__((ext_vector_type(4)));
typedef unsigned u32x2 __attribute__((ext_vector_type(2)));

constexpr int DM = 2048, SEQ = 2048, NSMP = 128, MPR = 8192, MT = 8320, MPAD = 8448;
constexpr int DFF = 6144, DPLE = 256;
constexpr float EPS = 1e-6f;
constexpr size_t OFF_Y = 0;
constexpr size_t OFF_POOL_P = (size_t)MT * DM;
constexpr size_t OFF_RE_P = OFF_POOL_P + 4 * 15 * 1024;
constexpr size_t OFF_IM_P = OFF_RE_P + 4 * 64 * 64;
constexpr size_t OFF_CONV_P = OFF_IM_P + 4 * 64 * 64;
constexpr size_t OFF_POOL_S = OFF_CONV_P + 4 * 2 * 6144;
constexpr size_t OFF_RE_S = OFF_POOL_S + (size_t)128 * 15 * 1024;
constexpr size_t OFF_IM_S = OFF_RE_S + 128 * 64 * 64;
constexpr size_t OFF_CONV_S = OFF_IM_S + 128 * 64 * 64;
constexpr size_t MiB = 1u << 20;
constexpr size_t WS_WUP = 0, WS_WDOWN = 48 * MiB, WS_WPG = 72 * MiB, WS_WPLE = 80 * MiB, WS_WOUT = 81 * MiB, WS_WIN = 89 * MiB,
                 WS_WGLU = 113 * MiB, WS_WBP = 117 * MiB, WS_WBS = 121 * MiB, WS_WPOOL = 125 * MiB;
constexpr size_t WS_X1B = 89 * MiB;
constexpr size_t WS_P = 126 * MiB;
constexpr size_t WS_H = 159 * MiB, WS_PB = 192 * MiB;
constexpr size_t WS_U = 197 * MiB, WS_GATES = 263 * MiB;
constexpr size_t WS_DIFF = 329 * MiB, WS_SSMACT = WS_DIFF + (size_t)MPAD * 1024 * 2;
constexpr size_t WS_YCAT = 159 * MiB, WS_T1 = 197 * MiB, WS_MERGED = 329 * MiB;
constexpr size_t WS_ABUF = 159 * MiB, WS_VBUF = 258 * MiB, WS_X2B = 159 * MiB;
constexpr size_t WS_ROWSS = 372 * MiB, WS_CTL = 362 * MiB + 512 * 1024;
constexpr size_t WS_PM = 363 * MiB, WS_QM = 367 * MiB, WS_KT = 371 * MiB, WS_END = 379 * MiB;
constexpr int LDS_BYTES = 163840;

typedef __bf16 bf16x2_t __attribute__((ext_vector_type(2)));
__device__ __forceinline__ unsigned cvt_pk_bf16(float lo, float hi) { const f32x2 v = {lo, hi}; return __builtin_bit_cast(unsigned, __builtin_convertvector(v, bf16x2_t)); }
__device__ __forceinline__ float bf_lo(unsigned w) { return __uint_as_float(w << 16); }
__device__ __forceinline__ float bf_hi(unsigned w) { return __uint_as_float(w & 0xffff0000u); }
__device__ __forceinline__ float sigmoid_f(float x) { return __builtin_amdgcn_rcpf(1.0f + __builtin_amdgcn_exp2f(-1.4426950408889634f * x)); }
__device__ __forceinline__ float gelu_tanh_f(float x) { const float z = 1.5957691216057308f * (x + 0.044715f * x * x * x); return x * sigmoid_f(z); }
__device__ __forceinline__ u32x4 pack8(const f32x4 a, const f32x4 b) { u32x4 w; w.x = cvt_pk_bf16(a[0], a[1]); w.y = cvt_pk_bf16(a[2], a[3]); w.z = cvt_pk_bf16(b[0], b[1]); w.w = cvt_pk_bf16(b[2], b[3]); return w; }
__device__ __forceinline__ void unpack8(const u32x4 w, f32x4& a, f32x4& b) { a = (f32x4){bf_lo(w.x), bf_hi(w.x), bf_lo(w.y), bf_hi(w.y)}; b = (f32x4){bf_lo(w.z), bf_hi(w.z), bf_lo(w.w), bf_hi(w.w)}; }
__device__ __forceinline__ float sumsq8(const f32x4 a, const f32x4 b) { return (a[0] * a[0] + a[1] * a[1]) + (a[2] * a[2] + a[3] * a[3]) + (b[0] * b[0] + b[1] * b[1]) + (b[2] * b[2] + b[3] * b[3]); }
__device__ __forceinline__ int lane_id() { int l; asm volatile("v_mbcnt_lo_u32_b32 %0, -1, 0\n\tv_mbcnt_hi_u32_b32 %0, -1, %0" : "=v"(l)); return l; }
__device__ __forceinline__ float shfl_xor_f(float v, int lane, int m) { return __int_as_float(__builtin_amdgcn_ds_bpermute((lane ^ m) << 2, __float_as_int(v))); }
constexpr int RS_SLOTS = 64;
__device__ __forceinline__ void put_rowss(float* rs, int row, int slot, float s, int fr, int fq, bool valid) {
    const int lane = fq * 16 + fr; s += shfl_xor_f(s, lane, 16); s += shfl_xor_f(s, lane, 32);
    if (fq == 0 && valid) rs[(size_t)row * RS_SLOTS + slot] = s;
}
__device__ __forceinline__ float rs_rstd_main(const float* rs, int row, int fr, int fq) {
    const f32x4 a = *(const f32x4*)(rs + (size_t)row * RS_SLOTS + 8 * fq), b = *(const f32x4*)(rs + (size_t)row * RS_SLOTS + 8 * fq + 4);
    float s = (a[0] + a[1]) + (a[2] + a[3]) + (b[0] + b[1]) + (b[2] + b[3]); const int lane = fq * 16 + fr;
    s += shfl_xor_f(s, lane, 16); s += shfl_xor_f(s, lane, 32);
    return rsqrtf(s * (1.0f / (float)DM) + EPS);
}
__device__ __forceinline__ float rs_rstd_x(const float* rs, int row, int fr, int fq) {
    float s = 0.f;
#pragma unroll
    for (int q = 0; q < 4; ++q) { const f32x4 a = *(const f32x4*)(rs + (size_t)row * RS_SLOTS + 16 * fq + 4 * q); s += (a[0] + a[1]) + (a[2] + a[3]); }
    const int lane = fq * 16 + fr; s += shfl_xor_f(s, lane, 16); s += shfl_xor_f(s, lane, 32);
    return rsqrtf(s * (1.0f / (float)DM) + EPS);
}
__device__ __forceinline__ float wave_sum(float v, int lane) {
#pragma unroll
    for (int o = 1; o < 64; o <<= 1) v += shfl_xor_f(v, lane, o);
    return v;
}

namespace pg8 {
constexpr int BM = 256, BK = 64, HALF = 128, HTB = HALF * BK * 2, STAGE_BYTES = 8 * HTB, NXCD = 8, WGM = 4;
__device__ __forceinline__ int lds_byte(int r, int c) { const int st = (r >> 4) * 2 + (c >> 5), rr = r & 15, cc = c & 31, ob = rr * 64 + cc * 2; return st * 1024 + (ob ^ (((ob >> 9) & 1) << 5)); }
__device__ __forceinline__ void stage_rc(int b, int& R, int& C) { const int st = b / 1024, sb = b % 1024, swz = sb ^ (((sb >> 9) & 1) << 5); R = (st >> 1) * 16 + swz / 64; C = (st & 1) * 32 + (swz % 64) / 2; }
__device__ __forceinline__ int perm32(int rho) { const int n = rho >> 4, i = rho & 15; return 8 * (i >> 2) + 4 * n + (i & 3); }
struct Unit { int pm, pn; };
struct Gemm { const bf16_t* A; const bf16_t* B; int lda, ldb, K, nM, nN, a_koff, b_half_rows, b_tile_rows; int kp_shift; unsigned a_pstride, b_pstride; };
struct StaticOrder {
    int nM, nN, nwg, G, c;
    __device__ __forceinline__ void init(int nM_, int nN_, int G_, int c_) { nM = nM_; nN = nN_; nwg = nM * nN; G = G_; c = c_; }
    __device__ __forceinline__ bool next(int i, Unit& u) const {
        const long L = (long)i * G + c; if (L >= nwg) return false;
        int wgid = (int)L; { const int q = nwg / NXCD, r = nwg % NXCD, xcd = wgid % NXCD, off = wgid / NXCD; wgid = (xcd < r ? xcd * (q + 1) : r * (q + 1) + (xcd - r) * q) + off; }
        const int nig = WGM * nN, gid = wgid / nig, fm = gid * WGM, gsz = (nM - fm) < WGM ? (nM - fm) : WGM;
        u.pm = fm + ((wgid % nig) % gsz); u.pn = (wgid % nig) / gsz; return true;
    }
};

template <class Epi, bool XROWS_, int WR>
__device__ __forceinline__ void gemm_phase_wr(LAS unsigned char* lds, const Gemm g, int G, int cidx, int wave_s, const Epi& E) {
    const int lane = lane_id();
    constexpr int wr = WR;
    constexpr bool XROWS = XROWS_ && WR == 1;
    const int wid = wave_s, tid = wid * 64 + lane, wc = wid & 3, fr = lane & 15, fq = lane >> 4;
    int K = g.K; asm volatile("" : "+s"(K));
    const int nt = K / BK;
    StaticOrder S; S.init(g.nM, g.nN, G, cidx);
    unsigned voffA[2], voffB[2];
#pragma unroll
    for (int i = 0; i < 2; ++i) { int R, C; stage_rc(tid * 16 + i * 8192, R, C); const int Rb = (R & ~31) + perm32(R & 31);
        voffA[i] = (unsigned)(R * g.lda + C) * 2u; voffB[i] = (unsigned)(Rb * g.ldb + C) * 2u; }
    const unsigned kstep = (unsigned)(BK * 2);
    const unsigned kps = g.kp_shift > 0 ? (unsigned)g.kp_shift : 31u, kpm = (1u << kps) - 1u;
    const unsigned hstepA = (unsigned)HALF * g.lda * 2u, tstepA = 2u * hstepA, kofA = (unsigned)g.a_koff * 2u;
    const unsigned hstepB = (unsigned)g.b_half_rows * g.ldb * 2u, tstepB = (unsigned)g.b_tile_rows * g.ldb * 2u;
    const __amdgpu_buffer_rsrc_t rsA = __builtin_amdgcn_make_buffer_rsrc((void*)g.A, (short)0, 0x7fffffff, 0x00020000);
    const __amdgpu_buffer_rsrc_t rsB = __builtin_amdgcn_make_buffer_rsrc((void*)g.B, (short)0, 0x7fffffff, 0x00020000);
    const unsigned ldsw = (unsigned)wid * 1024u;
    const int aoff = lds_byte(wr * 64 + fr, fq * 8), boff = lds_byte(wc * 32 + fr, fq * 8);
    const unsigned voffX = (unsigned)(fr * g.lda + fq * 8) * 2u;
    const unsigned xrow0 = (unsigned)MPR * g.lda * 2u, xstep = 4u * g.lda * 2u;
#define PG8_SA(b, h) (((b) * 2 + (h)) * HTB)
#define PG8_SB(b, h) ((4 + (b) * 2 + (h)) * HTB)
#define PG8_STAGE(bufoff, rs, soff, voff) do { _Pragma("unroll") for (int _i = 0; _i < 2; ++_i) \
        __builtin_amdgcn_raw_ptr_buffer_load_lds(rs, (LAS unsigned*)(lds + (bufoff) + ldsw + _i * 8192), 16, (voff)[_i], (soff), 0, 0); } while (0)
#define PG8_LDA(dst, b, h) do { _Pragma("unroll") for (int m = 0; m < 4; ++m) _Pragma("unroll") for (int k = 0; k < 2; ++k) dst[m][k] = *(const LAS bf16x8*)(lds + PG8_SA(b, h) + aoff + m * 2048 + k * 1024); } while (0)
#define PG8_LDB(dst, b, h) do { _Pragma("unroll") for (int n = 0; n < 2; ++n) _Pragma("unroll") for (int k = 0; k < 2; ++k) dst[n][k] = *(const LAS bf16x8*)(lds + PG8_SB(b, h) + boff + n * 2048 + k * 1024); } while (0)
#define PG8_MMA(ai, bj, At, Bt) do { __builtin_amdgcn_s_setprio(1); _Pragma("unroll") for (int m = 0; m < 4; ++m) _Pragma("unroll") for (int n = 0; n < 2; ++n) _Pragma("unroll") for (int k = 0; k < 2; ++k) \
        acc[ai][bj][m][n] = __builtin_amdgcn_mfma_f32_16x16x32_bf16(Bt[n][k], At[m][k], acc[ai][bj][m][n], 0, 0, 0); __builtin_amdgcn_s_setprio(0); } while (0)
#define PG8_LOADX(dst, soff) do { if (XROWS) { _Pragma("unroll") for (int k = 0; k < 2; ++k) dst[k] = __builtin_bit_cast(bf16x8, __builtin_amdgcn_raw_buffer_load_b128(rsA, voffX + k * 64, (soff), 0)); } } while (0)
#define PG8_MMAX(Xf) do { if (!XROWS) break; __builtin_amdgcn_s_setprio(1); _Pragma("unroll") for (int k = 0; k < 2; ++k) _Pragma("unroll") for (int n = 0; n < 2; ++n) { \
        accX[n] = __builtin_amdgcn_mfma_f32_16x16x32_bf16(B0[n][k], Xf[k], accX[n], 0, 0, 0); accX[2 + n] = __builtin_amdgcn_mfma_f32_16x16x32_bf16(B1[n][k], Xf[k], accX[2 + n], 0, 0, 0); } __builtin_amdgcn_s_setprio(0); } while (0)
#define PG8_WAIT_V(n) asm volatile("s_waitcnt vmcnt(" #n ")" ::: "memory")
#define PG8_WAITV_SP2 do { if constexpr (XROWS) PG8_WAIT_V(10); else PG8_WAIT_V(8); } while (0)
#define PG8_WAIT_L(n) asm volatile("s_waitcnt lgkmcnt(" #n ")" ::: "memory")
#define PG8_BAR __builtin_amdgcn_s_barrier()
#define PG8_SCHED __builtin_amdgcn_sched_barrier(0)
    Unit cur, nxt; int ui = 0;
    if (!S.next(0, cur)) return;
    f32x4 acc[2][2][4][2];
#pragma unroll
    for (int a = 0; a < 2; ++a)
#pragma unroll
        for (int b = 0; b < 2; ++b)
#pragma unroll
            for (int m = 0; m < 4; ++m)
#pragma unroll
                for (int n = 0; n < 2; ++n) acc[a][b][m][n] = (f32x4){0.f, 0.f, 0.f, 0.f};
    bf16x8 At[4][2], B0[2][2], B1[2][2], XA[2];
    f32x4 accX[4]; accX[0] = (f32x4){0.f, 0.f, 0.f, 0.f}; accX[1] = accX[0]; accX[2] = accX[0]; accX[3] = accX[0];
    unsigned cA = (unsigned)cur.pm * tstepA + (unsigned)cur.pn * kofA, cB = (unsigned)cur.pn * tstepB;
    unsigned cX = xrow0 + (unsigned)cur.pm * xstep + (unsigned)cur.pn * kofA;
    PG8_LOADX(XA, cX);
    PG8_STAGE(PG8_SB(0, 0), rsB, cB, voffB); PG8_STAGE(PG8_SB(0, 1), rsB, cB + hstepB, voffB); PG8_STAGE(PG8_SA(0, 0), rsA, cA, voffA); PG8_STAGE(PG8_SA(0, 1), rsA, cA + hstepA, voffA);
    if (wr == 1) PG8_BAR;
    PG8_WAIT_V(2); PG8_BAR;
    PG8_STAGE(PG8_SB(1, 0), rsB, cB + kstep, voffB); PG8_STAGE(PG8_SA(1, 0), rsA, cA + kstep, voffA); PG8_STAGE(PG8_SB(1, 1), rsB, cB + hstepB + kstep, voffB);
    PG8_WAIT_V(6); PG8_BAR;
    for (;;) {
        const bool has_next = S.next(ui + 1, nxt);
        const unsigned nA = has_next ? (unsigned)nxt.pm * tstepA + (unsigned)nxt.pn * kofA : cA, nB = has_next ? (unsigned)nxt.pn * tstepB : cB;
        const unsigned nX = has_next ? xrow0 + (unsigned)nxt.pm * xstep + (unsigned)nxt.pn * kofA : cX;
        for (int seg = 0; seg < (Epi::MIDK ? 2 : 1); ++seg) {
        const int tbeg = (Epi::MIDK && seg == 1) ? (nt >> 1) : 0, tend = (Epi::MIDK && seg == 0) ? (nt >> 1) : nt;
        if constexpr (Epi::MIDK) { if (seg == 1) E.mid(acc, accX, cur, wr, wc, fr, fq); }
        for (int t = tbeg; t < tend; t += 2) {
            const bool last = (t == nt - 2);
            const unsigned t1 = (unsigned)(t + 1), t2 = (unsigned)(t + 2);
            const unsigned ko1 = (t1 & kpm) * kstep, ko2 = (t2 & kpm) * kstep, pa1 = (t1 >> kps) * g.a_pstride, pa2 = (t2 >> kps) * g.a_pstride, pb2 = (t2 >> kps) * g.b_pstride;
            const unsigned a1 = cA + pa1 + ko1, x1 = cX + pa1 + ko1;
            const unsigned a2 = last ? nA : cA + pa2 + ko2, b2 = last ? nB : cB + pb2 + ko2;
            const unsigned a3 = a2 + kstep, b3 = b2 + kstep, x2 = last ? nX : cX + pa2 + ko2;
            PG8_LDB(B0, 0, 0); PG8_LDB(B1, 0, 1); PG8_SCHED; PG8_LDA(At, 0, 0); PG8_STAGE(PG8_SA(1, 1), rsA, a1 + hstepA, voffA);
            PG8_WAIT_V(8); PG8_WAIT_L(0); PG8_BAR; PG8_MMA(0, 0, At, B0); PG8_MMA(0, 1, At, B1); PG8_MMAX(XA); PG8_LOADX(XA, x1); PG8_BAR; PG8_SCHED;
            PG8_LDA(At, 0, 1); PG8_STAGE(PG8_SB(0, 0), rsB, b2, voffB); PG8_STAGE(PG8_SB(0, 1), rsB, b2 + hstepB, voffB); PG8_STAGE(PG8_SA(0, 0), rsA, a2, voffA);
            PG8_WAITV_SP2; PG8_WAIT_L(0); PG8_BAR; PG8_MMA(1, 0, At, B0); PG8_MMA(1, 1, At, B1); PG8_BAR; PG8_SCHED;
            PG8_LDB(B0, 1, 0); PG8_LDB(B1, 1, 1); PG8_SCHED; PG8_LDA(At, 1, 0); PG8_STAGE(PG8_SA(0, 1), rsA, a2 + hstepA, voffA);
            PG8_WAIT_V(8); PG8_WAIT_L(0); PG8_BAR; PG8_MMA(0, 0, At, B0); PG8_MMA(0, 1, At, B1); PG8_MMAX(XA); PG8_LOADX(XA, x2); PG8_BAR; PG8_SCHED;
            PG8_LDA(At, 1, 1); PG8_STAGE(PG8_SB(1, 0), rsB, b3, voffB); PG8_STAGE(PG8_SB(1, 1), rsB, b3 + hstepB, voffB); PG8_STAGE(PG8_SA(1, 0), rsA, a3, voffA);
            PG8_WAITV_SP2; PG8_WAIT_L(0); PG8_BAR; PG8_MMA(1, 0, At, B0); PG8_MMA(1, 1, At, B1); PG8_BAR; PG8_SCHED;
        }
        }
        if (wr == 0) PG8_BAR;
        if constexpr (XROWS) { { const f32x4 ax2[2] = {accX[0], accX[2]}; E.x(ax2, cur, 0, wc, fr, fq); } { const f32x4 ax3[2] = {accX[1], accX[3]}; E.x(ax3, cur, 1, wc, fr, fq); } }
        E(acc, cur, wr, wc, fr, fq);
        if (!has_next) break;
        accX[0] = (f32x4){0.f, 0.f, 0.f, 0.f}; accX[1] = accX[0]; accX[2] = accX[0]; accX[3] = accX[0];
#pragma unroll
        for (int a = 0; a < 2; ++a)
#pragma unroll
            for (int b = 0; b < 2; ++b)
#pragma unroll
                for (int m = 0; m < 4; ++m)
#pragma unroll
                    for (int n = 0; n < 2; ++n) acc[a][b][m][n] = (f32x4){0.f, 0.f, 0.f, 0.f};
        cur = nxt; cA = nA; cB = nB; cX = nX; ++ui;
        if (wr == 1) PG8_BAR;
    }
    PG8_WAIT_V(0);
    PG8_BAR;
#undef PG8_SA
#undef PG8_SB
#undef PG8_STAGE
#undef PG8_LDA
#undef PG8_LDB
#undef PG8_MMA
#undef PG8_LOADX
#undef PG8_MMAX
#undef PG8_WAIT_V
#undef PG8_WAITV_SP2
#undef PG8_WAIT_L
#undef PG8_BAR
#undef PG8_SCHED
}
template <class Epi, bool XROWS = true>
__device__ __forceinline__ void gemm_phase(LAS unsigned char* lds, const Gemm g, int G, int cidx, int wave_s, const Epi& E) {
    if (wave_s < 4) gemm_phase_wr<Epi, XROWS, 0>(lds, g, G, cidx, wave_s, E); else gemm_phase_wr<Epi, XROWS, 1>(lds, g, G, cidx, wave_s, E);
}
}
using pg8::Unit;

#define EPI_ARGS const f32x4 (&acc)[2][2][4][2], const Unit& u, int wr, int wc, int fr, int fq
#define EPI_FOR_ROWS _Pragma("unroll") for (int ai = 0; ai < 2; ++ai) _Pragma("unroll") for (int m = 0; m < 4; ++m)
#define EPI_ROW (u.pm * 256 + ai * 128 + wr * 64 + m * 16 + fr)

#define XROW_SETUP const bool valid = fr < 4; const int row = MPR + 4 * u.pm + fr; const int cq = wc * 32 + 8 * fq + 4 * wr; (void)valid; (void)row; (void)cq;
__device__ __forceinline__ u32x2 pack4(const f32x4 a) { u32x2 w; w.x = cvt_pk_bf16(a[0], a[1]); w.y = cvt_pk_bf16(a[2], a[3]); return w; }
__device__ __forceinline__ f32x4 unpack4(const u32x2 w) { return (f32x4){bf_lo(w.x), bf_hi(w.x), bf_lo(w.y), bf_hi(w.y)}; }
__device__ __forceinline__ float sumsq4(const f32x4 a) { return (a[0] * a[0] + a[1] * a[1]) + (a[2] * a[2] + a[3] * a[3]); }
#define XEPI_ARGS const f32x4 (&ax)[2], const Unit& u, int wr, int wc, int fr, int fq

struct EpiZ { static constexpr bool MIDK = false;
    bf16_t* U; bf16_t* US; bf16_t* UX; bf16_t* GATES; float* out;
    __device__ __forceinline__ void operator()(EPI_ARGS) const {
        const int colh = wc * 32 + 8 * fq;
        if (u.pn < 8) {
            EPI_FOR_ROWS { const int row = EPI_ROW;
#pragma unroll
                for (int bj = 0; bj < 2; ++bj) { const int col = u.pn * 256 + bj * 128 + colh;
                    bf16_t* dst = u.pn < 4 ? U + (size_t)row * 1024 + col : US + (((size_t)((row >> 11) * 64 + ((col - 1024) >> 4)) * 2048 + (row & 2047)) * 16 + (col & 8));
                    *(u32x4*)dst = pack8(acc[ai][bj][m][0], acc[ai][bj][m][1]);
                    if (u.pn < 4) { const int t = row & 2047;
                        if (t >= 2033) { float* q = out + OFF_POOL_P + ((size_t)((row >> 11) * 15 + (t - 2033))) * 1024 + col; *(f32x4*)q = acc[ai][bj][m][0]; *(f32x4*)(q + 4) = acc[ai][bj][m][1]; } } } }
        } else {
            EPI_FOR_ROWS { const int row = EPI_ROW;
#pragma unroll
                for (int bj = 0; bj < 2; ++bj) { const int col = (u.pn - 8) * 256 + bj * 128 + colh; f32x4 v0 = acc[ai][bj][m][0], v1 = acc[ai][bj][m][1];
#pragma unroll
                    for (int j = 0; j < 4; ++j) { v0[j] = sigmoid_f(v0[j]); v1[j] = sigmoid_f(v1[j]); }
                    *(u32x4*)(GATES + (size_t)row * 4096 + col) = pack8(v0, v1); } }
        }
    }
    __device__ __forceinline__ void x(XEPI_ARGS) const { XROW_SETUP
        if (!valid) return;
#pragma unroll
        for (int bj = 0; bj < 2; ++bj) { const int col = u.pn * 256 + bj * 128 + cq;
            if (u.pn < 8) { *(u32x2*)(u.pn < 4 ? U + (size_t)row * 1024 + col : UX + (size_t)(row - MPR) * 1024 + (col - 1024)) = pack4(ax[bj]); if (u.pn < 4) *(f32x4*)(out + OFF_POOL_S + ((size_t)(row - MPR) * 15 + 14) * 1024 + col) = ax[bj]; }
            else { f32x4 v = ax[bj];
#pragma unroll
                for (int j = 0; j < 4; ++j) v[j] = sigmoid_f(v[j]);
                *(u32x2*)(GATES + (size_t)row * 4096 + col - 2048) = pack4(v); } }
    }
};
struct EpiBf { static constexpr bool MIDK = false;
    bf16_t* O; int ldo; const float* cscale;
    __device__ __forceinline__ void operator()(EPI_ARGS) const {
        const int colh = wc * 32 + 8 * fq;
#pragma unroll
        for (int bj = 0; bj < 2; ++bj) { const int col = u.pn * 256 + bj * 128 + colh;
            f32x4 s0 = (f32x4){1.f, 1.f, 1.f, 1.f}, s1 = s0; if (cscale) { s0 = *(const f32x4*)(cscale + col); s1 = *(const f32x4*)(cscale + col + 4); }
            EPI_FOR_ROWS { const int row = EPI_ROW; *(u32x4*)(O + (size_t)row * ldo + col) = pack8(acc[ai][bj][m][0] * s0, acc[ai][bj][m][1] * s1); } }
    }
    __device__ __forceinline__ void x(XEPI_ARGS) const { XROW_SETUP
        if (!valid) return;
#pragma unroll
        for (int bj = 0; bj < 2; ++bj) { const int col = u.pn * 256 + bj * 128 + cq; f32x4 v = ax[bj]; if (cscale) v = v * *(const f32x4*)(cscale + col);
            *(u32x2*)(O + (size_t)row * ldo + col) = pack4(v); }
    }
};
struct EpiGlu { static constexpr bool MIDK = false;
    bf16_t* O; int ldo; int coff;
    __device__ __forceinline__ void operator()(EPI_ARGS) const {
        const int col = coff + u.pn * 128 + wc * 32 + 8 * fq;
        EPI_FOR_ROWS { const int row = EPI_ROW; f32x4 v0 = acc[ai][0][m][0], v1 = acc[ai][0][m][1]; const f32x4 g0 = acc[ai][1][m][0], g1 = acc[ai][1][m][1];
#pragma unroll
            for (int j = 0; j < 4; ++j) { v0[j] *= sigmoid_f(g0[j]); v1[j] *= sigmoid_f(g1[j]); }
            *(u32x4*)(O + (size_t)row * ldo + col) = pack8(v0, v1); }
    }
    __device__ __forceinline__ void x(XEPI_ARGS) const { XROW_SETUP
        if (!valid) return;
        f32x4 v = ax[0];
#pragma unroll
        for (int j = 0; j < 4; ++j) v[j] *= sigmoid_f(ax[1][j]);
        *(u32x2*)(O + (size_t)row * ldo + coff + u.pn * 128 + cq) = pack4(v);
    }
};
struct EpiMerge { static constexpr bool MIDK = true;
    const bf16_t* GATES; bf16_t* MERGED;
    static __device__ __forceinline__ f32x4 clampg(f32x4 g) { return (f32x4){fmaxf(g[0], 1e-20f), fmaxf(g[1], 1e-20f), fmaxf(g[2], 1e-20f), fmaxf(g[3], 1e-20f)}; }
    static __device__ __forceinline__ f32x4 rcp4(f32x4 g) { return (f32x4){__builtin_amdgcn_rcpf(g[0]), __builtin_amdgcn_rcpf(g[1]), __builtin_amdgcn_rcpf(g[2]), __builtin_amdgcn_rcpf(g[3])}; }
    __device__ __forceinline__ void mid(f32x4 (&acc)[2][2][4][2], f32x4 (&ax)[4], const Unit& u, int wr, int wc, int fr0, int fq) const {
        int fr = fr0; asm volatile("" : "+v"(fr));
        const int colh = wc * 32 + 8 * fq;
#pragma unroll
        for (int ai = 0; ai < 2; ++ai)
#pragma unroll
            for (int m = 0; m < 4; ++m) { u32x4 gp[2], gs[2];
#pragma unroll
                for (int bj = 0; bj < 2; ++bj) { const bf16_t* gr = GATES + (size_t)EPI_ROW * 4096 + u.pn * 256 + bj * 128 + colh; gp[bj] = *(const u32x4*)gr; gs[bj] = *(const u32x4*)(gr + 2048); }
#pragma unroll
                for (int bj = 0; bj < 2; ++bj) { f32x4 p0, p1, s0, s1; unpack8(gp[bj], p0, p1); unpack8(gs[bj], s0, s1);
                    acc[ai][bj][m][0] = acc[ai][bj][m][0] * (p0 * rcp4(clampg(s0))); acc[ai][bj][m][1] = acc[ai][bj][m][1] * (p1 * rcp4(clampg(s1))); }
                if (m & 1) asm volatile("" ::: "memory"); }
        if (wr == 0) return;
        const int row = MPR + 4 * u.pm + (fr & 3);
#pragma unroll
        for (int bj = 0; bj < 2; ++bj)
#pragma unroll
            for (int n = 0; n < 2; ++n) { const bf16_t* gr = GATES + (size_t)row * 4096 + u.pn * 256 + bj * 128 + wc * 32 + 8 * fq + 4 * n;
                ax[2 * bj + n] = ax[2 * bj + n] * (unpack4(*(const u32x2*)gr) * rcp4(clampg(unpack4(*(const u32x2*)(gr + 2048))))); }
    }
    __device__ __forceinline__ void operator()(EPI_ARGS) const {
        const int colh = wc * 32 + 8 * fq;
#pragma unroll
        for (int ai = 0; ai < 2; ++ai) { u32x4 gs[4][2];
#pragma unroll
            for (int m = 0; m < 4; ++m)
#pragma unroll
                for (int bj = 0; bj < 2; ++bj) gs[m][bj] = *(const u32x4*)(GATES + (size_t)EPI_ROW * 4096 + 2048 + u.pn * 256 + bj * 128 + colh);
#pragma unroll
            for (int m = 0; m < 4; ++m) { const int row = EPI_ROW;
#pragma unroll
                for (int bj = 0; bj < 2; ++bj) { const int col = u.pn * 256 + bj * 128 + colh; f32x4 s0, s1; unpack8(gs[m][bj], s0, s1);
                    *(u32x4*)(MERGED + (size_t)row * 2048 + col) = pack8(acc[ai][bj][m][0] * clampg(s0), acc[ai][bj][m][1] * clampg(s1)); } }
            asm volatile("" ::: "memory"); }
    }
    __device__ __forceinline__ void x(XEPI_ARGS) const { XROW_SETUP
        if (!valid) return;
#pragma unroll
        for (int bj = 0; bj < 2; ++bj) { const int col = u.pn * 256 + bj * 128 + cq; const f32x4 g = clampg(unpack4(*(const u32x2*)(GATES + (size_t)row * 4096 + 2048 + col)));
            *(u32x2*)(MERGED + (size_t)row * 2048 + col) = pack4(ax[bj] * g); }
    }
};
template <bool SRC_BF16> struct EpiRes { static constexpr bool MIDK = false;
    const float* xp; const float* xs; const bf16_t* XS; bf16_t* XB; float* rs;
    __device__ __forceinline__ void operator()(EPI_ARGS) const {
        const int colh = wc * 32 + 8 * fq;
#pragma unroll
        for (int ai = 0; ai < 2; ++ai) { f32x4 xr[4][2][2];
#pragma unroll
            for (int m = 0; m < 4; ++m)
#pragma unroll
                for (int bj = 0; bj < 2; ++bj) { const size_t off = (size_t)EPI_ROW * 2048 + u.pn * 256 + bj * 128 + colh;
                    if (SRC_BF16) unpack8(*(const u32x4*)(XS + off), xr[m][bj][0], xr[m][bj][1]); else { xr[m][bj][0] = *(const f32x4*)(xp + off); xr[m][bj][1] = *(const f32x4*)(xp + off + 4); } }
#pragma unroll
            for (int m = 0; m < 4; ++m) { const int row = EPI_ROW; float ss = 0.f;
#pragma unroll
                for (int bj = 0; bj < 2; ++bj) { const int col = u.pn * 256 + bj * 128 + colh;
                    const f32x4 v0 = acc[ai][bj][m][0] + xr[m][bj][0], v1 = acc[ai][bj][m][1] + xr[m][bj][1];
                    *(u32x4*)(XB + (size_t)row * 2048 + col) = pack8(v0, v1); ss += sumsq8(v0, v1); }
                put_rowss(rs, row, u.pn * 4 + wc, ss, fr, fq, true); }
            asm volatile("" ::: "memory"); }
    }
    __device__ __forceinline__ void x(XEPI_ARGS) const { XROW_SETUP
        float ss = 0.f;
        if (valid) {
#pragma unroll
            for (int bj = 0; bj < 2; ++bj) { const int col = u.pn * 256 + bj * 128 + cq;
                const f32x4 xo = SRC_BF16 ? unpack4(*(const u32x2*)(XS + (size_t)row * 2048 + col)) : *(const f32x4*)(xs + (size_t)(row - MPR) * 2048 + col);
                const f32x4 v = ax[bj] + xo; *(u32x2*)(XB + (size_t)row * 2048 + col) = pack4(v); ss += sumsq4(v); } }
        put_rowss(rs, row, u.pn * 8 + wr * 4 + wc, ss, fr, fq, valid);
    }
};
__device__ __forceinline__ float dpp_prev1(float cur, float prevgrp) { const int o = __builtin_amdgcn_update_dpp(0, __float_as_int(prevgrp), 0x121, 0xf, 0xf, false);
    return __int_as_float(__builtin_amdgcn_update_dpp(o, __float_as_int(cur), 0x111, 0xf, 0xf, false)); }
__device__ __forceinline__ float dpp_prev2(float cur, float prevgrp) { const int o = __builtin_amdgcn_update_dpp(0, __float_as_int(prevgrp), 0x122, 0xf, 0xf, false);
    return __int_as_float(__builtin_amdgcn_update_dpp(o, __float_as_int(cur), 0x112, 0xf, 0xf, false)); }
constexpr size_t SA_BLK = (size_t)4 * 6144;
struct EpiUp { static constexpr bool MIDK = false;
    const float* rs; bf16_t* VB; float* SA; float* SAS; float* out; const float* WC; const float* BC;
    __device__ __forceinline__ void operator()(const f32x4 (&acc)[2][2][4][2], const Unit& u, int wr, int wc, int fr0, int fq0) const {
        int fr = fr0, fq = fq0; asm volatile("" : "+v"(fr), "+v"(fq));
        const int col = u.pn * 128 + wc * 32 + 8 * fq;
        const f32x4 w0a = *(const f32x4*)(WC + col), w0b = *(const f32x4*)(WC + col + 4), w1a = *(const f32x4*)(WC + 6144 + col), w1b = *(const f32x4*)(WC + 6144 + col + 4);
        const f32x4 w2a = *(const f32x4*)(WC + 12288 + col), w2b = *(const f32x4*)(WC + 12288 + col + 4), bca = *(const f32x4*)(BC + col), bcb = *(const f32x4*)(BC + col + 4);
        bf16_t* vbase = VB + (size_t)(u.pn >> 4) * ((size_t)MPAD * 2048) + (col & 2047);
#pragma unroll
        for (int ai = 0; ai < 2; ++ai) { f32x4 pa0, pa1; float rr[4];
#pragma unroll
            for (int m = 0; m < 4; ++m) rr[m] = rs_rstd_main(rs, EPI_ROW, fr, fq);
            float* sa = SA + (size_t)(4 * u.pm + 2 * ai + wr) * SA_BLK + col;
#pragma unroll
            for (int m = 0; m < 4; ++m) { const int row = EPI_ROW; const float r = rr[m];
                const f32x4 a0 = acc[ai][0][m][0] * r, a1 = acc[ai][0][m][1] * r, v0 = acc[ai][1][m][0] * r, v1 = acc[ai][1][m][1] * r;
                if (m == 0) { pa0 = a0; pa1 = a1; }
                f32x4 o0, o1;
#pragma unroll
                for (int j = 0; j < 4; ++j) {
                    const float c0 = bca[j] + w0a[j] * dpp_prev2(a0[j], pa0[j]) + w1a[j] * dpp_prev1(a0[j], pa0[j]) + w2a[j] * a0[j];
                    const float c1 = bcb[j] + w0b[j] * dpp_prev2(a1[j], pa1[j]) + w1b[j] * dpp_prev1(a1[j], pa1[j]) + w2b[j] * a1[j];
                    o0[j] = gelu_tanh_f(c0) * v0[j]; o1[j] = gelu_tanh_f(c1) * v1[j]; }
                if (m == 0 && fr < 2) { o0 = v0; o1 = v1; float* q = sa + (size_t)fr * 6144; *(f32x4*)q = a0; *(f32x4*)(q + 4) = a1; }
                if (m == 3 && fr >= 14) { float* q = sa + (size_t)(fr - 12) * 6144; *(f32x4*)q = a0; *(f32x4*)(q + 4) = a1;
                    const int t = row & 2047; if (t >= 2046) { float* q2 = out + OFF_CONV_P + ((size_t)((row >> 11) * 2 + (t - 2046))) * 6144 + col; *(f32x4*)q2 = a0; *(f32x4*)(q2 + 4) = a1; } }
                *(u32x4*)(vbase + (size_t)row * 2048) = pack8(o0, o1);
                pa0 = a0; pa1 = a1; }
            asm volatile("" ::: "memory"); }
    }
    __device__ __forceinline__ void x(XEPI_ARGS) const { XROW_SETUP
        const float r = rs_rstd_x(rs, valid ? row : MPR, fr, fq);
        if (!valid) return;
        const int col = u.pn * 128 + cq; const f32x4 av = ax[0] * r, vv = ax[1] * r;
        *(f32x4*)(SAS + (size_t)(row - MPR) * 6144 + col) = av;
        *(u32x2*)(VB + (size_t)(u.pn >> 4) * ((size_t)MPAD * 2048) + (size_t)row * 2048 + (col & 2047)) = pack4(vv);
        *(f32x4*)(out + OFF_CONV_S + ((size_t)(row - MPR) * 2 + 1) * 6144 + col) = av;
    }
};
struct EpiPle { static constexpr bool MIDK = false;
    const float* rs2; const bf16_t* P; const bf16_t* X2; float* rs3; bf16_t* wout;
    __device__ __forceinline__ void operator()(EPI_ARGS) const {
        const int colh = wc * 32 + 8 * fq;
#pragma unroll
        for (int ai = 0; ai < 2; ++ai)
#pragma unroll
            for (int mp = 0; mp < 2; ++mp) { u32x4 pt[2][2], xt[2][2]; float rr[2];
#pragma unroll
                for (int mm = 0; mm < 2; ++mm) { const int m = 2 * mp + mm; rr[mm] = rs_rstd_main(rs2, EPI_ROW, fr, fq);
#pragma unroll
                    for (int bj = 0; bj < 2; ++bj) { const int col = u.pn * 256 + bj * 128 + colh; pt[mm][bj] = *(const u32x4*)(P + (size_t)EPI_ROW * 2048 + col);
                        xt[mm][bj] = *(const u32x4*)(X2 + (size_t)EPI_ROW * 2048 + col); } }
#pragma unroll
                for (int mm = 0; mm < 2; ++mm) { const int m = 2 * mp + mm; const int row = EPI_ROW; float ss = 0.f; const float r = rr[mm];
#pragma unroll
                    for (int bj = 0; bj < 2; ++bj) { const int col = u.pn * 256 + bj * 128 + colh; f32x4 p0, p1; unpack8(pt[mm][bj], p0, p1);
                        f32x4 v0, v1; unpack8(xt[mm][bj], v0, v1);
#pragma unroll
                        for (int j = 0; j < 4; ++j) { v0[j] += sigmoid_f(r * acc[ai][bj][m][0][j]) * p0[j]; v1[j] += sigmoid_f(r * acc[ai][bj][m][1][j]) * p1[j]; }
                        *(u32x4*)(wout + (size_t)row * 2048 + col) = pack8(v0, v1); ss += sumsq8(v0, v1); }
                    put_rowss(rs3, row, u.pn * 4 + wc, ss, fr, fq, true); }
                asm volatile("" ::: "memory"); }
    }
    __device__ __forceinline__ void x(XEPI_ARGS) const { XROW_SETUP
        float ss = 0.f; const float r = rs_rstd_x(rs2, valid ? row : MPR, fr, fq);
        if (valid) {
#pragma unroll
            for (int bj = 0; bj < 2; ++bj) { const int col = u.pn * 256 + bj * 128 + cq; const f32x4 p = unpack4(*(const u32x2*)(P + (size_t)row * 2048 + col));
                f32x4 v = unpack4(*(const u32x2*)(X2 + (size_t)row * 2048 + col));
#pragma unroll
                for (int j = 0; j < 4; ++j) v[j] += sigmoid_f(r * ax[bj][j]) * p[j];
                *(u32x2*)(wout + (size_t)row * 2048 + col) = pack4(v); ss += sumsq4(v); } }
        put_rowss(rs3, row, u.pn * 8 + wr * 4 + wc, ss, fr, fq, valid);
    }
};

#define XB_TMO      128
#define XB_XCNT(j)  (256  + 64 * (j))
#define XB_XSUB(j)  (1280 + 64 * (j))
#define XB_XGEN(j)  (2304 + 64 * (j))
#define XB_TOP      3328
#define XB_TOPGEN   3392
#define XCD_BAR_WORDS 3456
#define XB_SPIN_CAP (1u << 22)
__device__ __forceinline__ unsigned xb_ld(unsigned* p)              { return __hip_atomic_load(p, __ATOMIC_RELAXED, __HIP_MEMORY_SCOPE_AGENT); }
__device__ __forceinline__ unsigned xb_add(unsigned* p, unsigned v) { return __hip_atomic_fetch_add(p, v, __ATOMIC_RELAXED, __HIP_MEMORY_SCOPE_AGENT); }
__device__ __forceinline__ unsigned xb_xcc_id() { return (unsigned)__builtin_amdgcn_s_getreg((3 << 11) | 20) & 0xFu; }
#define XB_SPIN(cond, bar) do { unsigned _sp = 0; while (cond) { __builtin_amdgcn_s_sleep(1); \
    if ((++_sp & 255u) == 0u) { if (xb_ld(&(bar)[XB_TMO])) break; if (_sp > XB_SPIN_CAP) { atomicAdd(&(bar)[XB_TMO], 1u); break; } } } } while (0)
struct XcdBarrier { unsigned* bar; unsigned x; volatile LAS unsigned* st; };
__device__ __forceinline__ void xcd_barrier_complete(unsigned* bar, unsigned x, unsigned G, unsigned& nloc, unsigned& nx) {
    unsigned sum, cnt, mine, sp = 0u;
    for (;;) {
        sum = 0u; cnt = 0u; mine = 0u;
#pragma unroll
        for (unsigned j = 0; j < 16; ++j) { const unsigned c = xb_ld(&bar[XB_XCNT(j)]); sum += c; cnt += (c > 0u) ? 1u : 0u; mine = (j == x) ? c : mine; }
        if (sum == G) break;
        __builtin_amdgcn_s_sleep(1);
        if ((++sp & 255u) == 0u) { if (xb_ld(&bar[XB_TMO])) break; if (sp > XB_SPIN_CAP) { atomicAdd(&bar[XB_TMO], 1u); break; } }
    }
    nloc = mine > 0u ? mine : 1u; nx = cnt > 0u ? cnt : 1u;
}
__device__ __forceinline__ void xcd_barrier(const XcdBarrier& b, bool leader, unsigned G) {
    asm volatile("s_waitcnt vmcnt(0)" ::: "memory");
    __syncthreads();
    if (leader) {
        unsigned* bar = b.bar;
        __builtin_amdgcn_s_waitcnt(0);
        unsigned nloc = b.st[0], nx = b.st[1];
        if (nloc == 0u) { xcd_barrier_complete(bar, b.x, G, nloc, nx); b.st[0] = nloc; b.st[1] = nx; }
        const unsigned old = xb_add(&bar[XB_XSUB(b.x)], 1u);
        const unsigned gen = old / nloc;
        if (old + 1u == (gen + 1u) * nloc) {
            __builtin_amdgcn_fence(__ATOMIC_RELEASE, "agent");
            asm volatile("s_waitcnt vmcnt(0)" ::: "memory");
            const unsigned og = xb_add(&bar[XB_TOP], 1u);
            const unsigned tg = og / nx;
            if (og + 1u == (tg + 1u) * nx) xb_add(&bar[XB_TOPGEN], 1u);
            else XB_SPIN(xb_ld(&bar[XB_TOPGEN]) == tg, bar);
            __builtin_amdgcn_fence(__ATOMIC_ACQUIRE, "agent");
            xb_add(&bar[XB_XGEN(b.x)], 1u);
            asm volatile("s_waitcnt vmcnt(0)" ::: "memory");
        } else {
            XB_SPIN(xb_ld(&bar[XB_XGEN(b.x)]) == gen, bar);
            __builtin_amdgcn_fence(__ATOMIC_ACQUIRE, "agent");
            asm volatile("s_waitcnt vmcnt(0)" ::: "memory");
        }
    }
    __syncthreads();
}

struct Args { const float* in[33]; float* out; unsigned char* ws; };
enum { I_XP = 0, I_XS, I_CPOOL, I_SRE, I_SIM, I_CCONV, I_PP, I_PS, I_GMIX, I_WIN, I_WPOOL, I_PSCALE, I_LRE, I_LIM, I_LOGDT, I_BRE, I_BIM, I_CRE, I_CIM, I_D,
       I_WGLU, I_WBP, I_WBS, I_WOUT, I_GFFN, I_WUP, I_WCONV, I_BCONV, I_WDOWN, I_GPLE, I_WPG, I_WPLE, I_GFINAL };

__device__ __forceinline__ void transpose_item(const float* W, int K, int N, bf16_t* WT, const float* kscale, LAS float* scr, int item, int lane, int ldw = 0) {
    if (ldw == 0) ldw = K;
    const int nblk = N >> 6, kb = item / nblk, nb = item - kb * nblk, k0 = kb * 64, n0 = nb * 64;
    const int c4 = (lane & 15) * 4, kr = lane >> 4;
    f32x4 v[16];
#pragma unroll
    for (int i = 0; i < 16; ++i) v[i] = __builtin_nontemporal_load((const f32x4*)(W + (size_t)(k0 + 4 * i + kr) * N + n0 + c4));
    if (kscale) {
#pragma unroll
        for (int i = 0; i < 16; ++i) v[i] = v[i] * kscale[k0 + 4 * i + kr]; }
#pragma unroll
    for (int i = 0; i < 16; ++i) { LAS float* s = scr + (4 * i + kr) * 65 + c4; s[0] = v[i][0]; s[1] = v[i][1]; s[2] = v[i][2]; s[3] = v[i][3]; }
    asm volatile("s_waitcnt lgkmcnt(0)" ::: "memory");
    const int c = lane & 7;
#pragma unroll
    for (int j = 0; j < 8; ++j) { const int n = (lane >> 3) + 8 * j; const LAS float* s = scr + (8 * c) * 65 + n;
        u32x4 o; o.x = cvt_pk_bf16(s[0 * 65], s[1 * 65]); o.y = cvt_pk_bf16(s[2 * 65], s[3 * 65]); o.z = cvt_pk_bf16(s[4 * 65], s[5 * 65]); o.w = cvt_pk_bf16(s[6 * 65], s[7 * 65]);
        *(u32x4*)(WT + (size_t)(n0 + n) * ldw + k0 + 8 * c) = o; }
    asm volatile("s_waitcnt lgkmcnt(0)" ::: "memory");
}


constexpr int TI_IN = 32 * 96, TI_LE = 4 * 32, TI_EARLY = TI_IN + TI_LE, TI_PL = 4 * 4 * 4, TI_G = 16 * 32, TI_O = 32 * 32, TI_U = 32 * 192, TI_DN = 96 * 32;
constexpr int TI_ALL = TI_EARLY + TI_PL + 3 * TI_G + TI_O + TI_U + TI_DN + TI_O;
#define TRANSPOSE_ITEMS(first, last) do { for (int it = (first) + gw; it < (last); it += NGW) { int r = it; \
        if (r < TI_IN) { transpose_item(a.in[I_WIN], 2048, 6144, W_IN, nullptr, scr, r, lane); continue; } r -= TI_IN; \
        if (r < TI_LE) { transpose_item(a.in[I_WPLE], 256, 2048, W_PLE, nullptr, scr, r, lane); continue; } r -= TI_LE; \
        if (r < TI_PL) { const int k = r >> 4; transpose_item(a.in[I_WPOOL] + (size_t)k * 65536, 256, 256, W_POOL + (size_t)k * 65536, nullptr, scr, r & 15, lane); continue; } r -= TI_PL; \
        if (r < TI_G) { transpose_item(a.in[I_WGLU], 1024, 2048, W_GLU, nullptr, scr, r, lane); continue; } r -= TI_G; \
        if (r < TI_G) { transpose_item(a.in[I_WBP], 1024, 2048, W_BP, nullptr, scr, r, lane, 2048); continue; } r -= TI_G; \
        if (r < TI_G) { transpose_item(a.in[I_WBS], 1024, 2048, W_BP + 1024, nullptr, scr, r, lane, 2048); continue; } r -= TI_G; \
        if (r < TI_O) { transpose_item(a.in[I_WOUT], 2048, 2048, W_OUT, nullptr, scr, r, lane); continue; } r -= TI_O; \
        if (r < TI_U) { transpose_item(a.in[I_WUP], 2048, 12288, W_UP, a.in[I_GFFN], scr, r, lane); continue; } r -= TI_U; \
        if (r < TI_DN) { const int pnl = r >> 10; transpose_item(a.in[I_WDOWN] + (size_t)pnl * 2048 * 2048, 2048, 2048, W_DOWN + (size_t)pnl * 2048 * 2048, nullptr, scr, r & 1023, lane); continue; } r -= TI_DN; \
        transpose_item(a.in[I_WPG], 2048, 2048, W_PG, a.in[I_GPLE], scr, r, lane); } } while (0)

__global__ void __launch_bounds__(512, 2) fwd_kernel(Args a) {
    extern __shared__ __attribute__((aligned(16))) unsigned char smem[];
    cg::grid_group grid = cg::this_grid();
    LAS unsigned char* lds = (LAS unsigned char*)smem;
    const int G = gridDim.x, bid = blockIdx.x;
    const int wave_s = __builtin_amdgcn_readfirstlane((int)(threadIdx.x >> 6));
#define GRID_SYNC() do { const bool _ld = (wave_s == 0) && (lane_id() == 0); xcd_barrier(xbar, _ld, (unsigned)G); } while (0)
#define FRESH_IDS const int lane = lane_id(); const int wave = wave_s, tid = wave * 64 + lane; (void)tid;
    unsigned char* ws = a.ws; float* out = a.out;
    bf16_t* W_UP = (bf16_t*)(ws + WS_WUP); bf16_t* W_DOWN = (bf16_t*)(ws + WS_WDOWN); bf16_t* W_PG = (bf16_t*)(ws + WS_WPG); bf16_t* W_PLE = (bf16_t*)(ws + WS_WPLE);
    bf16_t* W_OUT = (bf16_t*)(ws + WS_WOUT); bf16_t* W_IN = (bf16_t*)(ws + WS_WIN); bf16_t* W_GLU = (bf16_t*)(ws + WS_WGLU); bf16_t* W_BP = (bf16_t*)(ws + WS_WBP);
    bf16_t* W_BS = (bf16_t*)(ws + WS_WBS); bf16_t* W_POOL = (bf16_t*)(ws + WS_WPOOL);
    bf16_t* Hb = (bf16_t*)(ws + WS_H); bf16_t* PBb = (bf16_t*)(ws + WS_PB); bf16_t* Pb = (bf16_t*)(ws + WS_P);
    bf16_t* Ub = (bf16_t*)(ws + WS_U); bf16_t* GATES = (bf16_t*)(ws + WS_GATES);
    bf16_t* Ussm = (bf16_t*)(ws + WS_U + 20 * MiB); bf16_t* Usam = (bf16_t*)(ws + WS_U + 40 * MiB);
    bf16_t* DIFF = (bf16_t*)(ws + WS_DIFF); bf16_t* SSMACT = (bf16_t*)(ws + WS_SSMACT); bf16_t* YCAT = (bf16_t*)(ws + WS_YCAT);
 bf16_t* MERGED = (bf16_t*)(ws + WS_MERGED); bf16_t* X1B = (bf16_t*)(ws + WS_X1B);
    float* SAb = (float*)(ws + WS_ABUF + 40 * MiB);
    bf16_t* VBUF = (bf16_t*)(ws + WS_VBUF); bf16_t* X2B = (bf16_t*)(ws + WS_X2B);
    float* RS1 = (float*)(ws + WS_ROWSS); float* RS2 = RS1 + (size_t)MPAD * RS_SLOTS; float* RS3 = RS2 + (size_t)MPAD * RS_SLOTS;

    XcdBarrier xbar; xbar.bar = (unsigned*)(ws + WS_CTL); xbar.st = (volatile LAS unsigned*)(lds + LDS_BYTES - 16);
    { const int t0 = threadIdx.x; if (t0 < 2) xbar.st[t0] = 0u;
      if (gridDim.y == 0x7fffu) grid.sync();
      xbar.x = xb_xcc_id(); if (t0 == 0) (void)xb_add(&xbar.bar[XB_XCNT(xbar.x)], 1u); }
    {
    {
        FRESH_IDS
        const int gtid = bid * 512 + tid, GT = G * 512;
        if (bid < 256) {
            const int g = bid >> 2, q = bid & 3;
            LAS float* La = (LAS float*)lds;
            LAS float* Lap = (LAS float*)(lds + 512);
            LAS float* Lbb = (LAS float*)(lds + 9216);
            LAS float* Lcc = (LAS float*)(lds + 17408);
            bf16_t* PM = (bf16_t*)(ws + WS_PM) + (size_t)g * 128 * 256; bf16_t* QM = (bf16_t*)(ws + WS_QM) + (size_t)g * 256 * 128; bf16_t* KT = (bf16_t*)(ws + WS_KT) + (size_t)g * 4096;
            if (tid < 64) { const int p = tid;
                const float dt = expf(a.in[I_LOGDT][g]), lr = a.in[I_LRE][g * 64 + p], li = a.in[I_LIM][g * 64 + p];
                const float mag = expf(lr * dt), ar = mag * cosf(li * dt), ai = mag * sinf(li * dt);
                const float nr = ar - 1.0f, ni = ai, den = lr * lr + li * li, cr = (nr * lr + ni * li) / den, ci = (ni * lr - nr * li) / den;
                La[p * 2] = ar; La[p * 2 + 1] = ai;
                float wr_ = 1.f, wi_ = 0.f;
                for (int d = 0; d <= 16; ++d) { Lap[(d * 64 + p) * 2] = wr_; Lap[(d * 64 + p) * 2 + 1] = wi_; const float tr = wr_ * ar - wi_ * ai, ti = wr_ * ai + wi_ * ar; wr_ = tr; wi_ = ti; }
                for (int h = 0; h < 16; ++h) { const float br = a.in[I_BRE][(size_t)(g * 64 + p) * 16 + h], bi = a.in[I_BIM][(size_t)(g * 64 + p) * 16 + h];
                    Lbb[(p * 16 + h) * 2] = cr * br - ci * bi; Lbb[(p * 16 + h) * 2 + 1] = cr * bi + ci * br; } }
            for (int i = tid; i < 1024; i += 512) { Lcc[i * 2] = a.in[I_CRE][(size_t)g * 1024 + i]; Lcc[i * 2 + 1] = a.in[I_CIM][(size_t)g * 1024 + i]; }
            __syncthreads();
            if (tid < 256) {
                const int hp = tid >> 4, h = tid & 15; float acc0 = 0.f, acc1 = 0.f, acc2 = 0.f, acc3 = 0.f;
                for (int p = 0; p < 64; ++p) { const f32x2 c = *(const LAS f32x2*)(Lcc + (hp * 64 + p) * 2), b = *(const LAS f32x2*)(Lbb + (p * 16 + h) * 2), w = *(const LAS f32x2*)(Lap + (4 * q * 64 + p) * 2), av = *(const LAS f32x2*)(La + p * 2);
                    const float mr = c[0] * b[0] - c[1] * b[1], mi = c[0] * b[1] + c[1] * b[0];
                    float zr = mr * w[0] - mi * w[1], zi = mr * w[1] + mi * w[0]; float t_;
                    acc0 += zr; t_ = zr * av[0] - zi * av[1]; zi = zr * av[1] + zi * av[0]; zr = t_;
                    acc1 += zr; t_ = zr * av[0] - zi * av[1]; zi = zr * av[1] + zi * av[0]; zr = t_;
                    acc2 += zr; t_ = zr * av[0] - zi * av[1]; zi = zr * av[1] + zi * av[0]; zr = t_;
                    acc3 += zr; }
                if (q == 0 && h == hp) acc0 += a.in[I_D][g * 16 + hp];
                bf16_t* k = KT + (size_t)(4 * q) * 256 + hp * 16 + h;
                k[0] = (bf16_t)(cvt_pk_bf16(acc0, 0.f) & 0xffffu); k[256] = (bf16_t)(cvt_pk_bf16(acc1, 0.f) & 0xffffu); k[512] = (bf16_t)(cvt_pk_bf16(acc2, 0.f) & 0xffffu); k[768] = (bf16_t)(cvt_pk_bf16(acc3, 0.f) & 0xffffu);
            }
            {
                const int pr = 32 * q + (tid >> 4), h = tid & 15, part = pr >> 6, p = pr & 63;
                const f32x2 b = *(const LAS f32x2*)(Lbb + (p * 16 + h) * 2);
                for (int s_ = 0; s_ < 16; ++s_) { const f32x2 w = *(const LAS f32x2*)(Lap + ((15 - s_) * 64 + p) * 2);
                    const float v = part ? (w[0] * b[1] + w[1] * b[0]) : (w[0] * b[0] - w[1] * b[1]);
                    PM[(size_t)pr * 256 + s_ * 16 + h] = (bf16_t)(cvt_pk_bf16(v, 0.f) & 0xffffu); } }
            {
                const int rloc = tid >> 3, tq = 4 * q + (rloc >> 4), hp = rloc & 15, pg = tid & 7; float vr[8], vi[8];
#pragma unroll
                for (int e = 0; e < 8; ++e) { const int p = pg * 8 + e; const f32x2 c = *(const LAS f32x2*)(Lcc + (hp * 64 + p) * 2), w = *(const LAS f32x2*)(Lap + ((tq + 1) * 64 + p) * 2);
                    vr[e] = c[0] * w[0] - c[1] * w[1]; vi[e] = -(c[0] * w[1] + c[1] * w[0]); }
                bf16_t* qrow = QM + (size_t)(tq * 16 + hp) * 128 + pg * 8;
                *(u32x4*)qrow = pack8((f32x4){vr[0], vr[1], vr[2], vr[3]}, (f32x4){vr[4], vr[5], vr[6], vr[7]});
                *(u32x4*)(qrow + 64) = pack8((f32x4){vi[0], vi[1], vi[2], vi[3]}, (f32x4){vi[4], vi[5], vi[6], vi[7]}); }
            __syncthreads();
        }
        LAS float* scr = (LAS float*)(lds + wave * 16640);
        const int gw = bid * 8 + wave, NGW = G * 8;
        TRANSPOSE_ITEMS(0, TI_EARLY);
        for (int row = gw; row < MPAD; row += NGW) {
            u32x2* o = (u32x2*)(Hb + (size_t)row * 2048) + lane;
            if (row < MT) {
                const float* xr = row < MPR ? a.in[I_XP] + (size_t)row * 2048 : a.in[I_XS] + (size_t)(row - MPR) * 2048;
                f32x4 v[8]; float s = 0.f;
#pragma unroll
                for (int j = 0; j < 8; ++j) { v[j] = *((const f32x4*)xr + lane + 64 * j); s += (v[j][0] * v[j][0] + v[j][1] * v[j][1]) + (v[j][2] * v[j][2] + v[j][3] * v[j][3]); }
                const float r = rsqrtf(wave_sum(s, lane) * (1.0f / 2048.0f) + EPS);
#pragma unroll
                for (int j = 0; j < 8; ++j) { const f32x4 gm = *((const f32x4*)a.in[I_GMIX] + lane + 64 * j); const f32x4 y = v[j] * r * gm; u32x2 w; w.x = cvt_pk_bf16(y[0], y[1]); w.y = cvt_pk_bf16(y[2], y[3]); o[64 * j] = w; }
            } else {
#pragma unroll
                for (int j = 0; j < 8; ++j) o[64 * j] = (u32x2){0u, 0u};
            }
        }
        for (int i = gtid; i < MPAD * 64; i += GT) { const int row = i >> 6, c4 = (i & 63) * 4; u32x2 w = (u32x2){0u, 0u};
            if (row < MT) { const float* pr = row < MPR ? a.in[I_PP] + (size_t)row * 256 : a.in[I_PS] + (size_t)(row - MPR) * 256; const f32x4 v = *(const f32x4*)(pr + c4); w.x = cvt_pk_bf16(v[0], v[1]); w.y = cvt_pk_bf16(v[2], v[3]); }
            *(u32x2*)(PBb + (size_t)row * 256 + c4) = w; }
    }
    GRID_SYNC();
    }

    {
    { pg8::Gemm g{Hb, W_IN, 2048, 2048, 2048, 32, 24, 0, 128, 256}; EpiZ E{Ub, Ussm, Usam, GATES, out}; pg8::gemm_phase(lds, g, G, bid, wave_s, E); }
    { pg8::Gemm g{PBb, W_PLE, 256, 256, 256, 32, 8, 0, 128, 256}; EpiBf E{Pb, 2048, nullptr}; pg8::gemm_phase(lds, g, G, bid, wave_s, E); }
    GRID_SYNC();
    }

    {
    {
        FRESH_IDS
#define POOL_LOADS(W, tile_, raw) do { const int r0_ = (tile_) * 16, t0_ = r0_ & 2047; const bf16_t* up_ = Ub + (size_t)r0_ * 1024 + c; \
            _Pragma("unroll") for (int j = 0; j < 15 + W; ++j) { const int dr = j - (W - 1); unsigned w_ = 0u; if (t0_ + dr >= 0) w_ = *(const unsigned*)(up_ + (long)dr * 1024); raw[j] = w_; } } while (0)
#define POOL_COMP(W, tile_, raw) do { const int r0_ = (tile_) * 16, t0_ = r0_ & 2047; f32x2 v[15 + W]; \
            _Pragma("unroll") for (int j = 0; j < 15 + W; ++j) v[j] = (f32x2){bf_lo(raw[j]), bf_hi(raw[j])}; \
            f32x2 sum = (f32x2){0.f, 0.f}; _Pragma("unroll") for (int j = 0; j < W - 1; ++j) sum += v[j]; \
            _Pragma("unroll") for (int i = 0; i < 16; ++i) { const int t = t0_ + i; const f32x2 cur = v[W - 1 + i]; sum += cur; \
                const float inv = 1.0f / (float)((t + 1) < W ? (t + 1) : W); const f32x2 d = sum * inv - cur; \
                *(unsigned*)(DIFF + (size_t)(r0_ + i) * 1024 + c) = cvt_pk_bf16(d[0], d[1]); sum -= v[i]; } } while (0)
#define POOL_ALL(W) do { \
            const bool has_s = bid < 128; const int ns = has_s ? bid : 0; f32x2 cr[15]; unsigned wc_ = 0u; \
            { const float* cp = a.in[I_CPOOL] + (size_t)ns * 15 * 1024 + c; \
              _Pragma("unroll") for (int j = 0; j < 15; ++j) cr[j] = has_s ? *(const f32x2*)(cp + (size_t)j * 1024) : (f32x2){0.f, 0.f}; \
              if (has_s) wc_ = *(const unsigned*)(Ub + (size_t)(MPR + ns) * 1024 + c); } \
            for (int tA = bid; tA < 512; tA += 2 * G) { const int tB = tA + G; const bool hasB = tB < 512; unsigned rawA[15 + W], rawB[15 + W]; \
                POOL_LOADS(W, tA, rawA); POOL_LOADS(W, hasB ? tB : tA, rawB); \
                POOL_COMP(W, tA, rawA); if (hasB) POOL_COMP(W, tB, rawB); } \
            if (has_s) { const f32x2 cur = (f32x2){bf_lo(wc_), bf_hi(wc_)}; f32x2 sum = cur; \
                _Pragma("unroll") for (int j = 16 - W; j <= 14; ++j) sum += cr[j]; \
                const f32x2 d = sum * (1.0f / (float)W) - cur; \
                *(unsigned*)(DIFF + (size_t)(MPR + ns) * 1024 + c) = cvt_pk_bf16(d[0], d[1]); \
                float* po = out + OFF_POOL_S + (size_t)ns * 15 * 1024 + c; \
                _Pragma("unroll") for (int j = 0; j < 14; ++j) *(f32x2*)(po + (size_t)j * 1024) = cr[j + 1]; } \
            for (int ns2 = bid + G; ns2 < 128; ns2 += G) {   \
                const float* cp = a.in[I_CPOOL] + (size_t)ns2 * 15 * 1024 + c; f32x2 c2[15]; \
                _Pragma("unroll") for (int j = 0; j < 15; ++j) c2[j] = *(const f32x2*)(cp + (size_t)j * 1024); \
                const unsigned w2 = *(const unsigned*)(Ub + (size_t)(MPR + ns2) * 1024 + c); const f32x2 cur = (f32x2){bf_lo(w2), bf_hi(w2)}; f32x2 sum = cur; \
                _Pragma("unroll") for (int j = 16 - W; j <= 14; ++j) sum += c2[j]; \
                const f32x2 d = sum * (1.0f / (float)W) - cur; \
                *(unsigned*)(DIFF + (size_t)(MPR + ns2) * 1024 + c) = cvt_pk_bf16(d[0], d[1]); \
                float* po = out + OFF_POOL_S + (size_t)ns2 * 15 * 1024 + c; \
                _Pragma("unroll") for (int j = 0; j < 14; ++j) *(f32x2*)(po + (size_t)j * 1024) = c2[j + 1]; } \
            } while (0)
        const bool conv_first = ((bid >> 3) & 1) != 0;
        if (conv_first) { const int lane = lane_id(); LAS float* scr = (LAS float*)(lds + wave * 16640); const int gw = bid * 8 + wave, NGW = G * 8; TRANSPOSE_ITEMS(TI_EARLY, TI_ALL); }
        __syncthreads();
        { const int c = 2 * tid, wsel = wave >> 1;
          if (wsel == 0) POOL_ALL(2); else if (wsel == 1) POOL_ALL(4); else if (wsel == 2) POOL_ALL(8); else POOL_ALL(16); }
#undef POOL_ALL
#undef POOL_COMP
#undef POOL_LOADS
        LAS float* Hl = (LAS float*)(lds + 131072) + wave * 512;
        const float* LRE = a.in[I_LRE]; const float* LIM = a.in[I_LIM]; const float* LOGDT = a.in[I_LOGDT];
        typedef float f32x16 __attribute__((ext_vector_type(16)));
        constexpr int UROW = 528;
        LAS unsigned char* UL = lds;
        LAS unsigned char* SL = lds + 128 * UROW;
        LAS unsigned char* KL = lds + 256 * UROW;
        for (int item = bid; item < 256; item += G) {
            const int n = item >> 6, g = item & 63;
            const bf16_t* PM = (const bf16_t*)(ws + WS_PM) + (size_t)g * 128 * 256; const bf16_t* QM = (const bf16_t*)(ws + WS_QM) + (size_t)g * 256 * 128; const bf16_t* KT = (const bf16_t*)(ws + WS_KT) + (size_t)g * 4096;
            const int li_ = lane & 31, kq = lane >> 5;
            u32x4 ut[8];
#pragma unroll
            for (int i = 0; i < 8; ++i) ut[i] = *((const u32x4*)(Ussm + (size_t)item * 2048 * 16) + tid + 512 * i);
            const u32x4 ktv = *(const u32x4*)(KT + tid * 8);
            bf16x8 pmf[16], qmf[8];
            { const bf16_t* pa = PM + (size_t)(32 * (wave & 3) + li_) * 256 + 8 * kq;
#pragma unroll
              for (int ks = 0; ks < 16; ++ks) pmf[ks] = *(const bf16x8*)(pa + 16 * ks); }
            float a16r = 0.f, a16i = 0.f;
            if (wave == 0) { const float dt = expf(LOGDT[g]), lr = LRE[g * 64 + lane], li = LIM[g * 64 + lane]; const float mag = expf(lr * dt); a16r = mag * cosf(li * dt); a16i = mag * sinf(li * dt);
#pragma unroll
                for (int sq = 0; sq < 4; ++sq) { const float tr = a16r * a16r - a16i * a16i, ti = 2.0f * a16r * a16i; a16r = tr; a16i = ti; } }
            __syncthreads();
#pragma unroll
            for (int i = 0; i < 8; ++i) { const int idx = tid + 512 * i; *(LAS u32x4*)(UL + (idx >> 5) * UROW + (idx & 31) * 16) = ut[i]; }
            *(LAS u32x4*)(KL + tid * 16) = ktv;
            __syncthreads();
            {
                const int rb = wave & 3, cbp = wave >> 2; f32x16 s0, s1;
#pragma unroll
                for (int r = 0; r < 16; ++r) { s0[r] = 0.f; s1[r] = 0.f; }
                const LAS unsigned char* ub0 = UL + (64 * cbp + li_) * UROW + 16 * kq, * ub1 = ub0 + 32 * UROW;
#pragma unroll
                for (int ks = 0; ks < 16; ++ks) { const bf16x8 af = pmf[ks];
                    s0 = __builtin_amdgcn_mfma_f32_32x32x16_bf16(af, *(const LAS bf16x8*)(ub0 + 32 * ks), s0, 0, 0, 0);
                    s1 = __builtin_amdgcn_mfma_f32_32x32x16_bf16(af, *(const LAS bf16x8*)(ub1 + 32 * ks), s1, 0, 0, 0); }
                LAS unsigned char* sr0 = SL + (64 * cbp + li_) * UROW + (32 * rb + 4 * kq) * 4, * sr1 = sr0 + 32 * UROW;
#pragma unroll
                for (int rq = 0; rq < 4; ++rq) { *(LAS f32x4*)(sr0 + rq * 32) = (f32x4){s0[4 * rq], s0[4 * rq + 1], s0[4 * rq + 2], s0[4 * rq + 3]};
                                                 *(LAS f32x4*)(sr1 + rq * 32) = (f32x4){s1[4 * rq], s1[4 * rq + 1], s1[4 * rq + 2], s1[4 * rq + 3]}; }
            }
            { const bf16_t* qa = QM + (size_t)(32 * wave + li_) * 128 + 8 * kq;
#pragma unroll
              for (int kc = 0; kc < 8; ++kc) qmf[kc] = *(const bf16x8*)(qa + 16 * kc); }
            __syncthreads();
            if (wave == 0) {
                const int p = lane;
                float hr = 0.f, hi = 0.f;
#pragma unroll 8
                for (int c = 0; c < 128; ++c) { LAS unsigned char* row = SL + c * UROW;
                    const float sr = *(const LAS float*)(row + p * 4), si = *(const LAS float*)(row + 256 + p * 4);
                    const unsigned hb = cvt_pk_bf16(hr, hi);
                    *(LAS bf16_t*)(row + p * 2) = (bf16_t)(hb & 0xffffu); *(LAS bf16_t*)(row + 128 + p * 2) = (bf16_t)(hb >> 16);
                    const float nhr = a16r * hr - a16i * hi + sr, nhi = a16r * hi + a16i * hr + si; hr = nhr; hi = nhi; }
                out[OFF_RE_P + (size_t)(n * 64 + g) * 64 + p] = hr; out[OFF_IM_P + (size_t)(n * 64 + g) * 64 + p] = hi;
            }
            __syncthreads();
            {
                f32x16 y0, y1, y2, y3;
#pragma unroll
                for (int r = 0; r < 16; ++r) { y0[r] = 0.f; y1[r] = 0.f; y2[r] = 0.f; y3[r] = 0.f; }
                const int tq = 2 * wave + (li_ >> 4), hp = li_ & 15;
                const LAS unsigned char* ub = UL + li_ * UROW + 16 * kq;
                for (int ks = 0; ks <= 2 * wave + 1; ++ks) { const int d = tq - ks;
                    bf16x8 af = (bf16x8){0, 0, 0, 0, 0, 0, 0, 0}; if (d >= 0) af = *(const LAS bf16x8*)(KL + ((d * 16 + hp) * 16 + 8 * kq) * 2);
                    y0 = __builtin_amdgcn_mfma_f32_32x32x16_bf16(af, *(const LAS bf16x8*)(ub + 32 * ks), y0, 0, 0, 0);
                    y1 = __builtin_amdgcn_mfma_f32_32x32x16_bf16(af, *(const LAS bf16x8*)(ub + 32 * UROW + 32 * ks), y1, 0, 0, 0);
                    y2 = __builtin_amdgcn_mfma_f32_32x32x16_bf16(af, *(const LAS bf16x8*)(ub + 64 * UROW + 32 * ks), y2, 0, 0, 0);
                    y3 = __builtin_amdgcn_mfma_f32_32x32x16_bf16(af, *(const LAS bf16x8*)(ub + 96 * UROW + 32 * ks), y3, 0, 0, 0); }
                const LAS unsigned char* hb = SL + li_ * UROW + 16 * kq;
#pragma unroll
                for (int kc = 0; kc < 8; ++kc) { const bf16x8 af = qmf[kc];
                    y0 = __builtin_amdgcn_mfma_f32_32x32x16_bf16(af, *(const LAS bf16x8*)(hb + 32 * kc), y0, 0, 0, 0);
                    y1 = __builtin_amdgcn_mfma_f32_32x32x16_bf16(af, *(const LAS bf16x8*)(hb + 32 * UROW + 32 * kc), y1, 0, 0, 0);
                    y2 = __builtin_amdgcn_mfma_f32_32x32x16_bf16(af, *(const LAS bf16x8*)(hb + 64 * UROW + 32 * kc), y2, 0, 0, 0);
                    y3 = __builtin_amdgcn_mfma_f32_32x32x16_bf16(af, *(const LAS bf16x8*)(hb + 96 * UROW + 32 * kc), y3, 0, 0, 0); }
#define SSM_STORE(yv, cb) do { _Pragma("unroll") for (int rq = 0; rq < 4; ++rq) { f32x4 v = (f32x4){yv[4 * rq], yv[4 * rq + 1], yv[4 * rq + 2], yv[4 * rq + 3]}; \
                    _Pragma("unroll") for (int j = 0; j < 4; ++j) v[j] = gelu_tanh_f(v[j]); \
                    const int tok = 16 * (32 * (cb) + li_) + 2 * wave + (rq >> 1); \
                    *(u32x2*)(SSMACT + (size_t)(n * 2048 + tok) * 1024 + g * 16 + 8 * (rq & 1) + 4 * kq) = pack4(v); } } while (0)
                SSM_STORE(y0, 0); SSM_STORE(y1, 1); SSM_STORE(y2, 2); SSM_STORE(y3, 3);
#undef SSM_STORE
            }
        }
        __syncthreads();
        {
            const int lane = lane_id();
            const int gwv = bid * 8 + wave, g = gwv & 63, ns0 = (gwv >> 6) * 4, p = lane;
            if (gwv < 2048) {
                const float dt = expf(LOGDT[g]), lr = LRE[g * 64 + p], li = LIM[g * 64 + p];
                const float mag = expf(lr * dt), ar = mag * cosf(li * dt), ai = mag * sinf(li * dt);
                const float nr = ar - 1.0f, ni = ai, den = lr * lr + li * li, cr = (nr * lr + ni * li) / den, ci = (ni * lr - nr * li) / den;
                float Br[16], Bi[16];
#pragma unroll
                for (int q = 0; q < 4; ++q) { const f32x4 br = *(const f32x4*)(a.in[I_BRE] + (size_t)(g * 64 + p) * 16 + q * 4), bi = *(const f32x4*)(a.in[I_BIM] + (size_t)(g * 64 + p) * 16 + q * 4);
#pragma unroll
                    for (int jj = 0; jj < 4; ++jj) { Br[q * 4 + jj] = cr * br[jj] - ci * bi[jj]; Bi[q * 4 + jj] = cr * bi[jj] + ci * br[jj]; } }
                const int hp = lane & 15, pq = lane >> 4;
                f32x4 Cr[4], Ci[4];
#pragma unroll
                for (int q = 0; q < 4; ++q) { Cr[q] = *(const f32x4*)(a.in[I_CRE] + (size_t)(g * 16 + hp) * 64 + pq * 16 + q * 4); Ci[q] = *(const f32x4*)(a.in[I_CIM] + (size_t)(g * 16 + hp) * 64 + pq * 16 + q * 4); }
                const float dsk = a.in[I_D][g * 16 + hp];
#pragma unroll
                for (int k = 0; k < 4; ++k) { const int ns = ns0 + k;
                    const bf16_t* ur = Usam + (size_t)ns * 1024 + g * 16; float bur = 0.f, bui = 0.f;
#pragma unroll
                    for (int q = 0; q < 4; ++q) { const f32x4 uv = unpack4(*(const u32x2*)(ur + q * 4));
#pragma unroll
                        for (int jj = 0; jj < 4; ++jj) { bur += Br[q * 4 + jj] * uv[jj]; bui += Bi[q * 4 + jj] * uv[jj]; } }
                    const float h0r = a.in[I_SRE][(size_t)(ns * 64 + g) * 64 + p], h0i = a.in[I_SIM][(size_t)(ns * 64 + g) * 64 + p];
                    const float hr = ar * h0r - ai * h0i + bur, hi = ar * h0i + ai * h0r + bui;
                    out[OFF_RE_S + (size_t)(ns * 64 + g) * 64 + p] = hr; out[OFF_IM_S + (size_t)(ns * 64 + g) * 64 + p] = hi;
                    *(LAS f32x2*)(Hl + k * 128 + p * 2) = (f32x2){hr, hi};
                    float y = 0.f;
#pragma unroll
                    for (int q = 0; q < 4; ++q)
#pragma unroll
                        for (int jj = 0; jj < 4; ++jj) { const f32x2 hv = *(const LAS f32x2*)(Hl + k * 128 + (pq * 16 + q * 4 + jj) * 2); y += Cr[q][jj] * hv[0] - Ci[q][jj] * hv[1]; }
                    y += shfl_xor_f(y, lane, 16); y += shfl_xor_f(y, lane, 32);
                    if (pq == 0) { y = gelu_tanh_f(y + dsk * bf_lo((unsigned)ur[hp])); SSMACT[(size_t)(MPR + ns) * 1024 + g * 16 + hp] = (bf16_t)(cvt_pk_bf16(y, 0.f) & 0xffffu); }
                }
            }
        }
        __syncthreads();
        if (!conv_first) { const int lane = lane_id(); LAS float* scr = (LAS float*)(lds + wave * 16640); const int gw = bid * 8 + wave, NGW = G * 8; TRANSPOSE_ITEMS(TI_EARLY, TI_ALL); }
}
    GRID_SYNC();
    }

    {
    { pg8::Gemm g{DIFF, W_POOL, 1024, 256, 256, 32, 4, 256, 128, 256}; EpiBf E{YCAT, 2048, a.in[I_PSCALE]}; pg8::gemm_phase(lds, g, G, bid, wave_s, E); }
    { pg8::Gemm g{SSMACT, W_GLU, 1024, 1024, 1024, 32, 8, 0, 1024, 128}; EpiGlu E{YCAT, 2048, 1024}; pg8::gemm_phase(lds, g, G, bid, wave_s, E); }
    GRID_SYNC();
    }

    {
    { pg8::Gemm g{YCAT, W_BP, 2048, 2048, 2048, 32, 8, 0, 128, 256}; EpiMerge E{GATES, MERGED}; pg8::gemm_phase(lds, g, G, bid, wave_s, E); }
    GRID_SYNC();
    }

    {
    { pg8::Gemm g{MERGED, W_OUT, 2048, 2048, 2048, 32, 8, 0, 128, 256}; EpiRes<false> E{a.in[I_XP], a.in[I_XS], nullptr, X1B, RS1}; pg8::gemm_phase(lds, g, G, bid, wave_s, E); }
    GRID_SYNC();
    }

    {
    { pg8::Gemm g{X1B, W_UP, 2048, 2048, 2048, 32, 48, 0, 6144, 128}; EpiUp E{RS1, VBUF, SAb, SAb + 128 * SA_BLK, out, a.in[I_WCONV], a.in[I_BCONV]}; pg8::gemm_phase(lds, g, G, bid, wave_s, E); }
    GRID_SYNC();
    }

    {
    {
        FRESH_IDS
        const float* WC = a.in[I_WCONV]; const float* BC = a.in[I_BCONV]; const float* CC = a.in[I_CCONV]; const float* SAS = SAb + 128 * SA_BLK;
        for (int id = bid * 512 + tid; id < (256 + 128) * 768; id += G * 512) {
            const int ri = id / 768, c0 = (id - ri * 768) * 8;
            const f32x4 w0a = *(const f32x4*)(WC + c0), w0b = *(const f32x4*)(WC + c0 + 4), w1a = *(const f32x4*)(WC + 6144 + c0), w1b = *(const f32x4*)(WC + 6144 + c0 + 4);
            const f32x4 w2a = *(const f32x4*)(WC + 12288 + c0), w2b = *(const f32x4*)(WC + 12288 + c0 + 4), bca = *(const f32x4*)(BC + c0), bcb = *(const f32x4*)(BC + c0 + 4);
            const f32x4 z4 = (f32x4){0.f, 0.f, 0.f, 0.f};
            f32x4 a0, a1, m1a = z4, m1b = z4, m2a = z4, m2b = z4; int row;
            if (ri < 256) { const int blk = ri >> 1, j = ri & 1; row = 64 * blk + j; const bool first = (blk & 31) == 0;
                const float* sb = SAb + (size_t)blk * SA_BLK + c0; a0 = *(const f32x4*)(sb + (size_t)j * 6144); a1 = *(const f32x4*)(sb + (size_t)j * 6144 + 4);
                const float* sp = sb - SA_BLK;
                if (j == 0) { if (!first) { m1a = *(const f32x4*)(sp + 3 * 6144); m1b = *(const f32x4*)(sp + 3 * 6144 + 4); m2a = *(const f32x4*)(sp + 2 * 6144); m2b = *(const f32x4*)(sp + 2 * 6144 + 4); } }
                else { m1a = *(const f32x4*)sb; m1b = *(const f32x4*)(sb + 4); if (!first) { m2a = *(const f32x4*)(sp + 3 * 6144); m2b = *(const f32x4*)(sp + 3 * 6144 + 4); } }
            } else { const int ns = ri - 256; row = MPR + ns; const float* c = CC + (size_t)ns * 2 * 6144 + c0;
                m2a = *(const f32x4*)c; m2b = *(const f32x4*)(c + 4); m1a = *(const f32x4*)(c + 6144); m1b = *(const f32x4*)(c + 6144 + 4);
                a0 = *(const f32x4*)(SAS + (size_t)ns * 6144 + c0); a1 = *(const f32x4*)(SAS + (size_t)ns * 6144 + c0 + 4);
                float* q = out + OFF_CONV_S + (size_t)ns * 2 * 6144 + c0; *(f32x4*)q = m1a; *(f32x4*)(q + 4) = m1b; }
            bf16_t* vp = VBUF + (size_t)(c0 >> 11) * ((size_t)MPAD * 2048) + (size_t)row * 2048 + (c0 & 2047); f32x4 v0, v1; unpack8(*(const u32x4*)vp, v0, v1);
            f32x4 ca = bca + w0a * m2a + w1a * m1a + w2a * a0, cb = bcb + w0b * m2b + w1b * m1b + w2b * a1;
#pragma unroll
            for (int j = 0; j < 4; ++j) { ca[j] = gelu_tanh_f(ca[j]) * v0[j]; cb[j] = gelu_tanh_f(cb[j]) * v1[j]; }
            *(u32x4*)vp = pack8(ca, cb);
        }
    }
    GRID_SYNC();
    }

    {
    { pg8::Gemm g{VBUF, W_DOWN, 2048, 2048, 6144, 32, 8, 0, 128, 256, 5, (unsigned)((size_t)MPAD * 2048 * 2), (unsigned)(2048u * 2048u * 2u)}; EpiRes<true> E{nullptr, nullptr, X1B, X2B, RS2}; pg8::gemm_phase(lds, g, G, bid, wave_s, E); }
    GRID_SYNC();
    }

    {
    { pg8::Gemm g{X2B, W_PG, 2048, 2048, 2048, 32, 8, 0, 128, 256}; EpiPle E{RS2, Pb, X2B, RS3, X1B}; pg8::gemm_phase(lds, g, G, bid, wave_s, E); }
    GRID_SYNC();
    }

    { FRESH_IDS
    for (int row = bid * 8 + wave; row < MT; row += G * 8) {
        const float r = rsqrtf(wave_sum((row < MPR && lane >= 32) ? 0.f : RS3[(size_t)row * RS_SLOTS + lane], lane) * (1.0f / (float)DM) + EPS);
        const u32x4* xi = (const u32x4*)(X1B + (size_t)row * 2048) + lane; f32x4* o = (f32x4*)(out + (size_t)row * 2048) + 2 * lane;
#pragma unroll
        for (int j = 0; j < 4; ++j) { f32x4 v0, v1; unpack8(xi[64 * j], v0, v1); const f32x4 g0 = *((const f32x4*)a.in[I_GFINAL] + 2 * lane + 128 * j), g1 = *((const f32x4*)a.in[I_GFINAL] + 2 * lane + 128 * j + 1);
            o[128 * j] = v0 * r * g0; o[128 * j + 1] = v1 * r * g1; }
    } }
}

extern "C" void kernel_launch(void* const* d_in, const int* in_sizes, int n_in, void* d_out, int out_size, void* d_ws, size_t ws_size, hipStream_t stream) {
    static int grid = 0;
    if (grid == 0) {
        if (n_in != 33 || ws_size < WS_END) { fprintf(stderr, "kernel_launch: unexpected n_in %d or ws_size %zu (< %zu)\n", n_in, ws_size, (size_t)WS_END); grid = -1; return; }
        int dev = 0, cus = 0, per_cu = 0;
        (void)hipGetDevice(&dev); (void)hipDeviceGetAttribute(&cus, hipDeviceAttributeMultiprocessorCount, dev);
        if (hipFuncSetAttribute((const void*)fwd_kernel, hipFuncAttributeMaxDynamicSharedMemorySize, LDS_BYTES) != hipSuccess) { fprintf(stderr, "kernel_launch: hipFuncSetAttribute failed\n"); grid = -1; return; }
        if (hipOccupancyMaxActiveBlocksPerMultiprocessor(&per_cu, (const void*)fwd_kernel, 512, LDS_BYTES) != hipSuccess || per_cu < 1) { fprintf(stderr, "kernel_launch: occupancy query says %d blocks/CU\n", per_cu); grid = -1; return; }
        grid = cus;
        fprintf(stderr, "kernel_launch: grid %d (per_cu %d), ws %zu\n", grid, per_cu, ws_size);
    }
    if (grid < 0) return;
    if (hipMemsetAsync((char*)d_ws + WS_CTL, 0, XCD_BAR_WORDS * sizeof(unsigned), stream) != hipSuccess) { fprintf(stderr, "kernel_launch: hipMemsetAsync of the barrier words failed\n"); return; }
    Args a{};
    for (int i = 0; i < 33; ++i) a.in[i] = (const float*)d_in[i];
    a.out = (float*)d_out; a.ws = (unsigned char*)d_ws;
    void* args[] = {&a};
    hipError_t e = hipLaunchCooperativeKernel((const void*)fwd_kernel, dim3(grid), dim3(512), args, LDS_BYTES, stream);
    if (e != hipSuccess) fprintf(stderr, "kernel_launch: cooperative launch failed: %s\n", hipGetErrorString(e));
}
```

```cpp
#include <hip/hip_runtime.h>
#include <hip/hip_cooperative_groups.h>
#include <cstdio>
#include <cstdint>
namespace cg = cooperative_groups;

#define LAS __attribute__((address_space(3)))
typedef unsigned short bf16_t;
typedef short bf16x8 __attribute__((ext_vector_type(8)));
typedef float f32x4 __attribute__((ext_vector_type(4)));
typedef float f32x2 __attribute__((ext_vector_type(2)));
typedef unsigned u32x4 __attribute__((ext_vector_type(4)));
typedef unsigned u32x2 __attribute__((ext_vector_type(2)));

constexpr int DM = 2048, SEQ = 2048, NSMP = 128, MPR = 8192, MT = 8320, MPAD = 8448;
constexpr int DFF = 6144, DPLE = 256;
constexpr float EPS = 1e-6f;
constexpr size_t OFF_Y = 0;
constexpr size_t OFF_POOL_P = (size_t)MT * DM;
constexpr size_t OFF_RE_P = OFF_POOL_P + 4 * 15 * 1024;
constexpr size_t OFF_IM_P = OFF_RE_P + 4 * 64 * 64;
constexpr size_t OFF_CONV_P = OFF_IM_P + 4 * 64 * 64;
constexpr size_t OFF_POOL_S = OFF_CONV_P + 4 * 2 * 6144;
constexpr size_t OFF_RE_S = OFF_POOL_S + (size_t)128 * 15 * 1024;
constexpr size_t OFF_IM_S = OFF_RE_S + 128 * 64 * 64;
constexpr size_t OFF_CONV_S = OFF_IM_S + 128 * 64 * 64;
constexpr size_t MiB = 1u << 20;
constexpr size_t WS_WUP = 0, WS_WDOWN = 48 * MiB, WS_WPG = 72 * MiB, WS_WPLE = 80 * MiB, WS_WOUT = 81 * MiB, WS_WIN = 89 * MiB,
                 WS_WGLU = 113 * MiB, WS_WBP = 117 * MiB, WS_WBS = 121 * MiB, WS_WPOOL = 125 * MiB;
constexpr size_t WS_X1B = 89 * MiB;
constexpr size_t WS_P = 126 * MiB;
constexpr size_t WS_H = 159 * MiB, WS_PB = 192 * MiB;
constexpr size_t WS_U = 197 * MiB, WS_GATES = 263 * MiB;
constexpr size_t WS_DIFF = 329 * MiB, WS_SSMACT = WS_DIFF + (size_t)MPAD * 1024 * 2;
constexpr size_t WS_YCAT = 159 * MiB, WS_T1 = 197 * MiB, WS_MERGED = 329 * MiB;
constexpr size_t WS_ABUF = 159 * MiB, WS_VBUF = 258 * MiB, WS_X2B = 159 * MiB;
constexpr size_t WS_ROWSS = 372 * MiB, WS_CTL = 362 * MiB + 512 * 1024;
constexpr size_t WS_PM = 363 * MiB, WS_QM = 367 * MiB, WS_KT = 371 * MiB, WS_END = 379 * MiB;
constexpr int LDS_BYTES = 163840;

typedef __bf16 bf16x2_t __attribute__((ext_vector_type(2)));
__device__ __forceinline__ unsigned cvt_pk_bf16(float lo, float hi) { const f32x2 v = {lo, hi}; return __builtin_bit_cast(unsigned, __builtin_convertvector(v, bf16x2_t)); }
__device__ __forceinline__ float bf_lo(unsigned w) { return __uint_as_float(w << 16); }
__device__ __forceinline__ float bf_hi(unsigned w) { return __uint_as_float(w & 0xffff0000u); }
__device__ __forceinline__ float sigmoid_f(float x) { return __builtin_amdgcn_rcpf(1.0f + __builtin_amdgcn_exp2f(-1.4426950408889634f * x)); }
__device__ __forceinline__ float gelu_tanh_f(float x) { const float z = 1.5957691216057308f * (x + 0.044715f * x * x * x); return x * sigmoid_f(z); }
__device__ __forceinline__ u32x4 pack8(const f32x4 a, const f32x4 b) { u32x4 w; w.x = cvt_pk_bf16(a[0], a[1]); w.y = cvt_pk_bf16(a[2], a[3]); w.z = cvt_pk_bf16(b[0], b[1]); w.w = cvt_pk_bf16(b[2], b[3]); return w; }
__device__ __forceinline__ void unpack8(const u32x4 w, f32x4& a, f32x4& b) { a = (f32x4){bf_lo(w.x), bf_hi(w.x), bf_lo(w.y), bf_hi(w.y)}; b = (f32x4){bf_lo(w.z), bf_hi(w.z), bf_lo(w.w), bf_hi(w.w)}; }
__device__ __forceinline__ float sumsq8(const f32x4 a, const f32x4 b) { return (a[0] * a[0] + a[1] * a[1]) + (a[2] * a[2] + a[3] * a[3]) + (b[0] * b[0] + b[1] * b[1]) + (b[2] * b[2] + b[3] * b[3]); }
__device__ __forceinline__ int lane_id() { int l; asm volatile("v_mbcnt_lo_u32_b32 %0, -1, 0\n\tv_mbcnt_hi_u32_b32 %0, -1, %0" : "=v"(l)); return l; }
__device__ __forceinline__ float shfl_xor_f(float v, int lane, int m) { return __int_as_float(__builtin_amdgcn_ds_bpermute((lane ^ m) << 2, __float_as_int(v))); }
constexpr int RS_SLOTS = 64;
__device__ __forceinline__ void put_rowss(float* rs, int row, int slot, float s, int fr, int fq, bool valid) {
    const int lane = fq * 16 + fr; s += shfl_xor_f(s, lane, 16); s += shfl_xor_f(s, lane, 32);
    if (fq == 0 && valid) rs[(size_t)row * RS_SLOTS + slot] = s;
}
__device__ __forceinline__ float rs_rstd_main(const float* rs, int row, int fr, int fq) {
    const f32x4 a = *(const f32x4*)(rs + (size_t)row * RS_SLOTS + 8 * fq), b = *(const f32x4*)(rs + (size_t)row * RS_SLOTS + 8 * fq + 4);
    float s = (a[0] + a[1]) + (a[2] + a[3]) + (b[0] + b[1]) + (b[2] + b[3]); const int lane = fq * 16 + fr;
    s += shfl_xor_f(s, lane, 16); s += shfl_xor_f(s, lane, 32);
    return rsqrtf(s * (1.0f / (float)DM) + EPS);
}
__device__ __forceinline__ float rs_rstd_x(const float* rs, int row, int fr, int fq) {
    float s = 0.f;
#pragma unroll
    for (int q = 0; q < 4; ++q) { const f32x4 a = *(const f32x4*)(rs + (size_t)row * RS_SLOTS + 16 * fq + 4 * q); s += (a[0] + a[1]) + (a[2] + a[3]); }
    const int lane = fq * 16 + fr; s += shfl_xor_f(s, lane, 16); s += shfl_xor_f(s, lane, 32);
    return rsqrtf(s * (1.0f / (float)DM) + EPS);
}
__device__ __forceinline__ float wave_sum(float v, int lane) {
#pragma unroll
    for (int o = 1; o < 64; o <<= 1) v += shfl_xor_f(v, lane, o);
    return v;
}

namespace pg8 {
constexpr int BM = 256, BK = 64, HALF = 128, HTB = HALF * BK * 2, STAGE_BYTES = 8 * HTB, NXCD = 8, WGM = 4;
__device__ __forceinline__ int lds_byte(int r, int c) { const int st = (r >> 4) * 2 + (c >> 5), rr = r & 15, cc = c & 31, ob = rr * 64 + cc * 2; return st * 1024 + (ob ^ (((ob >> 9) & 1) << 5)); }
__device__ __forceinline__ void stage_rc(int b, int& R, int& C) { const int st = b / 1024, sb = b % 1024, swz = sb ^ (((sb >> 9) & 1) << 5); R = (st >> 1) * 16 + swz / 64; C = (st & 1) * 32 + (swz % 64) / 2; }
__device__ __forceinline__ int perm32(int rho) { const int n = rho >> 4, i = rho & 15; return 8 * (i >> 2) + 4 * n + (i & 3); }
struct Unit { int pm, pn; };
struct Gemm { const bf16_t* A; const bf16_t* B; int lda, ldb, K, nM, nN, a_koff, b_half_rows, b_tile_rows; int kp_shift; unsigned a_pstride, b_pstride; };
struct StaticOrder {
    int nM, nN, nwg, G, c;
    __device__ __forceinline__ void init(int nM_, int nN_, int G_, int c_) { nM = nM_; nN = nN_; nwg = nM * nN; G = G_; c = c_; }
    __device__ __forceinline__ bool next(int i, Unit& u) const {
        const long L = (long)i * G + c; if (L >= nwg) return false;
        int wgid = (int)L; { const int q = nwg / NXCD, r = nwg % NXCD, xcd = wgid % NXCD, off = wgid / NXCD; wgid = (xcd < r ? xcd * (q + 1) : r * (q + 1) + (xcd - r) * q) + off; }
        const int nig = WGM * nN, gid = wgid / nig, fm = gid * WGM, gsz = (nM - fm) < WGM ? (nM - fm) : WGM;
        u.pm = fm + ((wgid % nig) % gsz); u.pn = (wgid % nig) / gsz; return true;
    }
};

template <class Epi, bool XROWS_, int WR>
__device__ __forceinline__ void gemm_phase_wr(LAS unsigned char* lds, const Gemm g, int G, int cidx, int wave_s, const Epi& E) {
    const int lane = lane_id();
    constexpr int wr = WR;
    constexpr bool XROWS = XROWS_ && WR == 1;
    const int wid = wave_s, tid = wid * 64 + lane, wc = wid & 3, fr = lane & 15, fq = lane >> 4;
    int K = g.K; asm volatile("" : "+s"(K));
    const int nt = K / BK;
    StaticOrder S; S.init(g.nM, g.nN, G, cidx);
    unsigned voffA[2], voffB[2];
#pragma unroll
    for (int i = 0; i < 2; ++i) { int R, C; stage_rc(tid * 16 + i * 8192, R, C); const int Rb = (R & ~31) + perm32(R & 31);
        voffA[i] = (unsigned)(R * g.lda + C) * 2u; voffB[i] = (unsigned)(Rb * g.ldb + C) * 2u; }
    const unsigned kstep = (unsigned)(BK * 2);
    const unsigned kps = g.kp_shift > 0 ? (unsigned)g.kp_shift : 31u, kpm = (1u << kps) - 1u;
    const unsigned hstepA = (unsigned)HALF * g.lda * 2u, tstepA = 2u * hstepA, kofA = (unsigned)g.a_koff * 2u;
    const unsigned hstepB = (unsigned)g.b_half_rows * g.ldb * 2u, tstepB = (unsigned)g.b_tile_rows * g.ldb * 2u;
    const __amdgpu_buffer_rsrc_t rsA = __builtin_amdgcn_make_buffer_rsrc((void*)g.A, (short)0, 0x7fffffff, 0x00020000);
    const __amdgpu_buffer_rsrc_t rsB = __builtin_amdgcn_make_buffer_rsrc((void*)g.B, (short)0, 0x7fffffff, 0x00020000);
    const unsigned ldsw = (unsigned)wid * 1024u;
    const int aoff = lds_byte(wr * 64 + fr, fq * 8), boff = lds_byte(wc * 32 + fr, fq * 8);
    const unsigned voffX = (unsigned)(fr * g.lda + fq * 8) * 2u;
    const unsigned xrow0 = (unsigned)MPR * g.lda * 2u, xstep = 4u * g.lda * 2u;
#define PG8_SA(b, h) (((b) * 2 + (h)) * HTB)
#define PG8_SB(b, h) ((4 + (b) * 2 + (h)) * HTB)
#define PG8_STAGE(bufoff, rs, soff, voff) do { _Pragma("unroll") for (int _i = 0; _i < 2; ++_i) \
        __builtin_amdgcn_raw_ptr_buffer_load_lds(rs, (LAS unsigned*)(lds + (bufoff) + ldsw + _i * 8192), 16, (voff)[_i], (soff), 0, 0); } while (0)
#define PG8_LDA(dst, b, h) do { _Pragma("unroll") for (int m = 0; m < 4; ++m) _Pragma("unroll") for (int k = 0; k < 2; ++k) dst[m][k] = *(const LAS bf16x8*)(lds + PG8_SA(b, h) + aoff + m * 2048 + k * 1024); } while (0)
#define PG8_LDB(dst, b, h) do { _Pragma("unroll") for (int n = 0; n < 2; ++n) _Pragma("unroll") for (int k = 0; k < 2; ++k) dst[n][k] = *(const LAS bf16x8*)(lds + PG8_SB(b, h) + boff + n * 2048 + k * 1024); } while (0)
#define PG8_MMA(ai, bj, At, Bt) do { __builtin_amdgcn_s_setprio(1); _Pragma("unroll") for (int m = 0; m < 4; ++m) _Pragma("unroll") for (int n = 0; n < 2; ++n) _Pragma("unroll") for (int k = 0; k < 2; ++k) \
        acc[ai][bj][m][n] = __builtin_amdgcn_mfma_f32_16x16x32_bf16(Bt[n][k], At[m][k], acc[ai][bj][m][n], 0, 0, 0); __builtin_amdgcn_s_setprio(0); } while (0)
#define PG8_LOADX(dst, soff) do { if (XROWS) { _Pragma("unroll") for (int k = 0; k < 2; ++k) dst[k] = __builtin_bit_cast(bf16x8, __builtin_amdgcn_raw_buffer_load_b128(rsA, voffX + k * 64, (soff), 0)); } } while (0)
#define PG8_MMAX(Xf) do { if (!XROWS) break; __builtin_amdgcn_s_setprio(1); _Pragma("unroll") for (int k = 0; k < 2; ++k) _Pragma("unroll") for (int n = 0; n < 2; ++n) { \
        accX[n] = __builtin_amdgcn_mfma_f32_16x16x32_bf16(B0[n][k], Xf[k], accX[n], 0, 0, 0); accX[2 + n] = __builtin_amdgcn_mfma_f32_16x16x32_bf16(B1[n][k], Xf[k], accX[2 + n], 0, 0, 0); } __builtin_amdgcn_s_setprio(0); } while (0)
#define PG8_WAIT_V(n) asm volatile("s_waitcnt vmcnt(" #n ")" ::: "memory")
#define PG8_WAITV_SP2 do { if constexpr (XROWS) PG8_WAIT_V(10); else PG8_WAIT_V(8); } while (0)
#define PG8_WAIT_L(n) asm volatile("s_waitcnt lgkmcnt(" #n ")" ::: "memory")
#define PG8_BAR __builtin_amdgcn_s_barrier()
#define PG8_SCHED __builtin_amdgcn_sched_barrier(0)
    Unit cur, nxt; int ui = 0;
    if (!S.next(0, cur)) return;
    f32x4 acc[2][2][4][2];
#pragma unroll
    for (int a = 0; a < 2; ++a)
#pragma unroll
        for (int b = 0; b < 2; ++b)
#pragma unroll
            for (int m = 0; m < 4; ++m)
#pragma unroll
                for (int n = 0; n < 2; ++n) acc[a][b][m][n] = (f32x4){0.f, 0.f, 0.f, 0.f};
    bf16x8 At[4][2], B0[2][2], B1[2][2], XA[2];
    f32x4 accX[4]; accX[0] = (f32x4){0.f, 0.f, 0.f, 0.f}; accX[1] = accX[0]; accX[2] = accX[0]; accX[3] = accX[0];
    unsigned cA = (unsigned)cur.pm * tstepA + (unsigned)cur.pn * kofA, cB = (unsigned)cur.pn * tstepB;
    unsigned cX = xrow0 + (unsigned)cur.pm * xstep + (unsigned)cur.pn * kofA;
    PG8_LOADX(XA, cX);
    PG8_STAGE(PG8_SB(0, 0), rsB, cB, voffB); PG8_STAGE(PG8_SB(0, 1), rsB, cB + hstepB, voffB); PG8_STAGE(PG8_SA(0, 0), rsA, cA, voffA); PG8_STAGE(PG8_SA(0, 1), rsA, cA + hstepA, voffA);
    if (wr == 1) PG8_BAR;
    PG8_WAIT_V(2); PG8_BAR;
    PG8_STAGE(PG8_SB(1, 0), rsB, cB + kstep, voffB); PG8_STAGE(PG8_SA(1, 0), rsA, cA + kstep, voffA); PG8_STAGE(PG8_SB(1, 1), rsB, cB + hstepB + kstep, voffB);
    PG8_WAIT_V(6); PG8_BAR;
    for (;;) {
        const bool has_next = S.next(ui + 1, nxt);
        const unsigned nA = has_next ? (unsigned)nxt.pm * tstepA + (unsigned)nxt.pn * kofA : cA, nB = has_next ? (unsigned)nxt.pn * tstepB : cB;
        const unsigned nX = has_next ? xrow0 + (unsigned)nxt.pm * xstep + (unsigned)nxt.pn * kofA : cX;
        for (int seg = 0; seg < (Epi::MIDK ? 2 : 1); ++seg) {
        const int tbeg = (Epi::MIDK && seg == 1) ? (nt >> 1) : 0, tend = (Epi::MIDK && seg == 0) ? (nt >> 1) : nt;
        if constexpr (Epi::MIDK) { if (seg == 1) E.mid(acc, accX, cur, wr, wc, fr, fq); }
        for (int t = tbeg; t < tend; t += 2) {
            const bool last = (t == nt - 2);
            const unsigned t1 = (unsigned)(t + 1), t2 = (unsigned)(t + 2);
            const unsigned ko1 = (t1 & kpm) * kstep, ko2 = (t2 & kpm) * kstep, pa1 = (t1 >> kps) * g.a_pstride, pa2 = (t2 >> kps) * g.a_pstride, pb2 = (t2 >> kps) * g.b_pstride;
            const unsigned a1 = cA + pa1 + ko1, x1 = cX + pa1 + ko1;
            const unsigned a2 = last ? nA : cA + pa2 + ko2, b2 = last ? nB : cB + pb2 + ko2;
            const unsigned a3 = a2 + kstep, b3 = b2 + kstep, x2 = last ? nX : cX + pa2 + ko2;
            PG8_LDB(B0, 0, 0); PG8_LDB(B1, 0, 1); PG8_SCHED; PG8_LDA(At, 0, 0); PG8_STAGE(PG8_SA(1, 1), rsA, a1 + hstepA, voffA);
            PG8_WAIT_V(8); PG8_WAIT_L(0); PG8_BAR; PG8_MMA(0, 0, At, B0); PG8_MMA(0, 1, At, B1); PG8_MMAX(XA); PG8_LOADX(XA, x1); PG8_BAR; PG8_SCHED;
            PG8_LDA(At, 0, 1); PG8_STAGE(PG8_SB(0, 0), rsB, b2, voffB); PG8_STAGE(PG8_SB(0, 1), rsB, b2 + hstepB, voffB); PG8_STAGE(PG8_SA(0, 0), rsA, a2, voffA);
            PG8_WAITV_SP2; PG8_WAIT_L(0); PG8_BAR; PG8_MMA(1, 0, At, B0); PG8_MMA(1, 1, At, B1); PG8_BAR; PG8_SCHED;
            PG8_LDB(B0, 1, 0); PG8_LDB(B1, 1, 1); PG8_SCHED; PG8_LDA(At, 1, 0); PG8_STAGE(PG8_SA(0, 1), rsA, a2 + hstepA, voffA);
            PG8_WAIT_V(8); PG8_WAIT_L(0); PG8_BAR; PG8_MMA(0, 0, At, B0); PG8_MMA(0, 1, At, B1); PG8_MMAX(XA); PG8_LOADX(XA, x2); PG8_BAR; PG8_SCHED;
            PG8_LDA(At, 1, 1); PG8_STAGE(PG8_SB(1, 0), rsB, b3, voffB); PG8_STAGE(PG8_SB(1, 1), rsB, b3 + hstepB, voffB); PG8_STAGE(PG8_SA(1, 0), rsA, a3, voffA);
            PG8_WAITV_SP2; PG8_WAIT_L(0); PG8_BAR; PG8_MMA(1, 0, At, B0); PG8_MMA(1, 1, At, B1); PG8_BAR; PG8_SCHED;
        }
        }
        if (wr == 0) PG8_BAR;
        if constexpr (XROWS) { { const f32x4 ax2[2] = {accX[0], accX[2]}; E.x(ax2, cur, 0, wc, fr, fq); } { const f32x4 ax3[2] = {accX[1], accX[3]}; E.x(ax3, cur, 1, wc, fr, fq); } }
        E(acc, cur, wr, wc, fr, fq);
        if (!has_next) break;
        accX[0] = (f32x4){0.f, 0.f, 0.f, 0.f}; accX[1] = accX[0]; accX[2] = accX[0]; accX[3] = accX[0];
#pragma unroll
        for (int a = 0; a < 2; ++a)
#pragma unroll
            for (int b = 0; b < 2; ++b)
#pragma unroll
                for (int m = 0; m < 4; ++m)
#pragma unroll
                    for (int n = 0; n < 2; ++n) acc[a][b][m][n] = (f32x4){0.f, 0.f, 0.f, 0.f};
        cur = nxt; cA = nA; cB = nB; cX = nX; ++ui;
        if (wr == 1) PG8_BAR;
    }
    PG8_WAIT_V(0);
    PG8_BAR;
#undef PG8_SA
#undef PG8_SB
#undef PG8_STAGE
#undef PG8_LDA
#undef PG8_LDB
#undef PG8_MMA
#undef PG8_LOADX
#undef PG8_MMAX
#undef PG8_WAIT_V
#undef PG8_WAITV_SP2
#undef PG8_WAIT_L
#undef PG8_BAR
#undef PG8_SCHED
}
template <class Epi, bool XROWS = true>
__device__ __forceinline__ void gemm_phase(LAS unsigned char* lds, const Gemm g, int G, int cidx, int wave_s, const Epi& E) {
    if (wave_s < 4) gemm_phase_wr<Epi, XROWS, 0>(lds, g, G, cidx, wave_s, E); else gemm_phase_wr<Epi, XROWS, 1>(lds, g, G, cidx, wave_s, E);
}
}
using pg8::Unit;

#define EPI_ARGS const f32x4 (&acc)[2][2][4][2], const Unit& u, int wr, int wc, int fr, int fq
#define EPI_FOR_ROWS _Pragma("unroll") for (int ai = 0; ai < 2; ++ai) _Pragma("unroll") for (int m = 0; m < 4; ++m)
#define EPI_ROW (u.pm * 256 + ai * 128 + wr * 64 + m * 16 + fr)

#define XROW_SETUP const bool valid = fr < 4; const int row = MPR + 4 * u.pm + fr; const int cq = wc * 32 + 8 * fq + 4 * wr; (void)valid; (void)row; (void)cq;
__device__ __forceinline__ u32x2 pack4(const f32x4 a) { u32x2 w; w.x = cvt_pk_bf16(a[0], a[1]); w.y = cvt_pk_bf16(a[2], a[3]); return w; }
__device__ __forceinline__ f32x4 unpack4(const u32x2 w) { return (f32x4){bf_lo(w.x), bf_hi(w.x), bf_lo(w.y), bf_hi(w.y)}; }
__device__ __forceinline__ float sumsq4(const f32x4 a) { return (a[0] * a[0] + a[1] * a[1]) + (a[2] * a[2] + a[3] * a[3]); }
#define XEPI_ARGS const f32x4 (&ax)[2], const Unit& u, int wr, int wc, int fr, int fq

struct EpiZ { static constexpr bool MIDK = false;
    bf16_t* U; bf16_t* US; bf16_t* UX; bf16_t* GATES; float* out;
    __device__ __forceinline__ void operator()(EPI_ARGS) const {
        const int colh = wc * 32 + 8 * fq;
        if (u.pn < 8) {
            EPI_FOR_ROWS { const int row = EPI_ROW;
#pragma unroll
                for (int bj = 0; bj < 2; ++bj) { const int col = u.pn * 256 + bj * 128 + colh;
                    bf16_t* dst = u.pn < 4 ? U + (size_t)row * 1024 + col : US + (((size_t)((row >> 11) * 64 + ((col - 1024) >> 4)) * 2048 + (row & 2047)) * 16 + (col & 8));
                    *(u32x4*)dst = pack8(acc[ai][bj][m][0], acc[ai][bj][m][1]);
                    if (u.pn < 4) { const int t = row & 2047;
                        if (t >= 2033) { float* q = out + OFF_POOL_P + ((size_t)((row >> 11) * 15 + (t - 2033))) * 1024 + col; *(f32x4*)q = acc[ai][bj][m][0]; *(f32x4*)(q + 4) = acc[ai][bj][m][1]; } } } }
        } else {
            EPI_FOR_ROWS { const int row = EPI_ROW;
#pragma unroll
                for (int bj = 0; bj < 2; ++bj) { const int col = (u.pn - 8) * 256 + bj * 128 + colh; f32x4 v0 = acc[ai][bj][m][0], v1 = acc[ai][bj][m][1];
#pragma unroll
                    for (int j = 0; j < 4; ++j) { v0[j] = sigmoid_f(v0[j]); v1[j] = sigmoid_f(v1[j]); }
                    *(u32x4*)(GATES + (size_t)row * 4096 + col) = pack8(v0, v1); } }
        }
    }
    __device__ __forceinline__ void x(XEPI_ARGS) const { XROW_SETUP
        if (!valid) return;
#pragma unroll
        for (int bj = 0; bj < 2; ++bj) { const int col = u.pn * 256 + bj * 128 + cq;
            if (u.pn < 8) { *(u32x2*)(u.pn < 4 ? U + (size_t)row * 1024 + col : UX + (size_t)(row - MPR) * 1024 + (col - 1024)) = pack4(ax[bj]); if (u.pn < 4) *(f32x4*)(out + OFF_POOL_S + ((size_t)(row - MPR) * 15 + 14) * 1024 + col) = ax[bj]; }
            else { f32x4 v = ax[bj];
#pragma unroll
                for (int j = 0; j < 4; ++j) v[j] = sigmoid_f(v[j]);
                *(u32x2*)(GATES + (size_t)row * 4096 + col - 2048) = pack4(v); } }
    }
};
struct EpiBf { static constexpr bool MIDK = false;
    bf16_t* O; int ldo; const float* cscale;
    __device__ __forceinline__ void operator()(EPI_ARGS) const {
        const int colh = wc * 32 + 8 * fq;
#pragma unroll
        for (int bj = 0; bj < 2; ++bj) { const int col = u.pn * 256 + bj * 128 + colh;
            f32x4 s0 = (f32x4){1.f, 1.f, 1.f, 1.f}, s1 = s0; if (cscale) { s0 = *(const f32x4*)(cscale + col); s1 = *(const f32x4*)(cscale + col + 4); }
            EPI_FOR_ROWS { const int row = EPI_ROW; *(u32x4*)(O + (size_t)row * ldo + col) = pack8(acc[ai][bj][m][0] * s0, acc[ai][bj][m][1] * s1); } }
    }
    __device__ __forceinline__ void x(XEPI_ARGS) const { XROW_SETUP
        if (!valid) return;
#pragma unroll
        for (int bj = 0; bj < 2; ++bj) { const int col = u.pn * 256 + bj * 128 + cq; f32x4 v = ax[bj]; if (cscale) v = v * *(const f32x4*)(cscale + col);
            *(u32x2*)(O + (size_t)row * ldo + col) = pack4(v); }
    }
};
struct EpiGlu { static constexpr bool MIDK = false;
    bf16_t* O; int ldo; int coff;
    __device__ __forceinline__ void operator()(EPI_ARGS) const {
        const int col = coff + u.pn * 128 + wc * 32 + 8 * fq;
        EPI_FOR_ROWS { const int row = EPI_ROW; f32x4 v0 = acc[ai][0][m][0], v1 = acc[ai][0][m][1]; const f32x4 g0 = acc[ai][1][m][0], g1 = acc[ai][1][m][1];
#pragma unroll
            for (int j = 0; j < 4; ++j) { v0[j] *= sigmoid_f(g0[j]); v1[j] *= sigmoid_f(g1[j]); }
            *(u32x4*)(O + (size_t)row * ldo + col) = pack8(v0, v1); }
    }
    __device__ __forceinline__ void x(XEPI_ARGS) const { XROW_SETUP
        if (!valid) return;
        f32x4 v = ax[0];
#pragma unroll
        for (int j = 0; j < 4; ++j) v[j] *= sigmoid_f(ax[1][j]);
        *(u32x2*)(O + (size_t)row * ldo + coff + u.pn * 128 + cq) = pack4(v);
    }
};
struct EpiMerge { static constexpr bool MIDK = true;
    const bf16_t* GATES; bf16_t* MERGED;
    static __device__ __forceinline__ f32x4 clampg(f32x4 g) { return (f32x4){fmaxf(g[0], 1e-20f), fmaxf(g[1], 1e-20f), fmaxf(g[2], 1e-20f), fmaxf(g[3], 1e-20f)}; }
    static __device__ __forceinline__ f32x4 rcp4(f32x4 g) { return (f32x4){__builtin_amdgcn_rcpf(g[0]), __builtin_amdgcn_rcpf(g[1]), __builtin_amdgcn_rcpf(g[2]), __builtin_amdgcn_rcpf(g[3])}; }
    __device__ __forceinline__ void mid(f32x4 (&acc)[2][2][4][2], f32x4 (&ax)[4], const Unit& u, int wr, int wc, int fr0, int fq) const {
        int fr = fr0; asm volatile("" : "+v"(fr));
        const int colh = wc * 32 + 8 * fq;
#pragma unroll
        for (int ai = 0; ai < 2; ++ai)
#pragma unroll
            for (int m = 0; m < 4; ++m) { u32x4 gp[2], gs[2];
#pragma unroll
                for (int bj = 0; bj < 2; ++bj) { const bf16_t* gr = GATES + (size_t)EPI_ROW * 4096 + u.pn * 256 + bj * 128 + colh; gp[bj] = *(const u32x4*)gr; gs[bj] = *(const u32x4*)(gr + 2048); }
#pragma unroll
                for (int bj = 0; bj < 2; ++bj) { f32x4 p0, p1, s0, s1; unpack8(gp[bj], p0, p1); unpack8(gs[bj], s0, s1);
                    acc[ai][bj][m][0] = acc[ai][bj][m][0] * (p0 * rcp4(clampg(s0))); acc[ai][bj][m][1] = acc[ai][bj][m][1] * (p1 * rcp4(clampg(s1))); }
                if (m & 1) asm volatile("" ::: "memory"); }
        if (wr == 0) return;
        const int row = MPR + 4 * u.pm + (fr & 3);
#pragma unroll
        for (int bj = 0; bj < 2; ++bj)
#pragma unroll
            for (int n = 0; n < 2; ++n) { const bf16_t* gr = GATES + (size_t)row * 4096 + u.pn * 256 + bj * 128 + wc * 32 + 8 * fq + 4 * n;
                ax[2 * bj + n] = ax[2 * bj + n] * (unpack4(*(const u32x2*)gr) * rcp4(clampg(unpack4(*(const u32x2*)(gr + 2048))))); }
    }
    __device__ __forceinline__ void operator()(EPI_ARGS) const {
        const int colh = wc * 32 + 8 * fq;
#pragma unroll
        for (int ai = 0; ai < 2; ++ai) { u32x4 gs[4][2];
#pragma unroll
            for (int m = 0; m < 4; ++m)
#pragma unroll
                for (int bj = 0; bj < 2; ++bj) gs[m][bj] = *(const u32x4*)(GATES + (size_t)EPI_ROW * 4096 + 2048 + u.pn * 256 + bj * 128 + colh);
#pragma unroll
            for (int m = 0; m < 4; ++m) { const int row = EPI_ROW;
#pragma unroll
                for (int bj = 0; bj < 2; ++bj) { const int col = u.pn * 256 + bj * 128 + colh; f32x4 s0, s1; unpack8(gs[m][bj], s0, s1);
                    *(u32x4*)(MERGED + (size_t)row * 2048 + col) = pack8(acc[ai][bj][m][0] * clampg(s0), acc[ai][bj][m][1] * clampg(s1)); } }
            asm volatile("" ::: "memory"); }
    }
    __device__ __forceinline__ void x(XEPI_ARGS) const { XROW_SETUP
        if (!valid) return;
#pragma unroll
        for (int bj = 0; bj < 2; ++bj) { const int col = u.pn * 256 + bj * 128 + cq; const f32x4 g = clampg(unpack4(*(const u32x2*)(GATES + (size_t)row * 4096 + 2048 + col)));
            *(u32x2*)(MERGED + (size_t)row * 2048 + col) = pack4(ax[bj] * g); }
    }
};
template <bool SRC_BF16> struct EpiRes { static constexpr bool MIDK = false;
    const float* xp; const float* xs; const bf16_t* XS; bf16_t* XB; float* rs;
    __device__ __forceinline__ void operator()(EPI_ARGS) const {
        const int colh = wc * 32 + 8 * fq;
#pragma unroll
        for (int ai = 0; ai < 2; ++ai) { f32x4 xr[4][2][2];
#pragma unroll
            for (int m = 0; m < 4; ++m)
#pragma unroll
                for (int bj = 0; bj < 2; ++bj) { const size_t off = (size_t)EPI_ROW * 2048 + u.pn * 256 + bj * 128 + colh;
                    if (SRC_BF16) unpack8(*(const u32x4*)(XS + off), xr[m][bj][0], xr[m][bj][1]); else { xr[m][bj][0] = *(const f32x4*)(xp + off); xr[m][bj][1] = *(const f32x4*)(xp + off + 4); } }
#pragma unroll
            for (int m = 0; m < 4; ++m) { const int row = EPI_ROW; float ss = 0.f;
#pragma unroll
                for (int bj = 0; bj < 2; ++bj) { const int col = u.pn * 256 + bj * 128 + colh;
                    const f32x4 v0 = acc[ai][bj][m][0] + xr[m][bj][0], v1 = acc[ai][bj][m][1] + xr[m][bj][1];
                    *(u32x4*)(XB + (size_t)row * 2048 + col) = pack8(v0, v1); ss += sumsq8(v0, v1); }
                put_rowss(rs, row, u.pn * 4 + wc, ss, fr, fq, true); }
            asm volatile("" ::: "memory"); }
    }
    __device__ __forceinline__ void x(XEPI_ARGS) const { XROW_SETUP
        float ss = 0.f;
        if (valid) {
#pragma unroll
            for (int bj = 0; bj < 2; ++bj) { const int col = u.pn * 256 + bj * 128 + cq;
                const f32x4 xo = SRC_BF16 ? unpack4(*(const u32x2*)(XS + (size_t)row * 2048 + col)) : *(const f32x4*)(xs + (size_t)(row - MPR) * 2048 + col);
                const f32x4 v = ax[bj] + xo; *(u32x2*)(XB + (size_t)row * 2048 + col) = pack4(v); ss += sumsq4(v); } }
        put_rowss(rs, row, u.pn * 8 + wr * 4 + wc, ss, fr, fq, valid);
    }
};
__device__ __forceinline__ float dpp_prev1(float cur, float prevgrp) { const int o = __builtin_amdgcn_update_dpp(0, __float_as_int(prevgrp), 0x121, 0xf, 0xf, false);
    return __int_as_float(__builtin_amdgcn_update_dpp(o, __float_as_int(cur), 0x111, 0xf, 0xf, false)); }
__device__ __forceinline__ float dpp_prev2(float cur, float prevgrp) { const int o = __builtin_amdgcn_update_dpp(0, __float_as_int(prevgrp), 0x122, 0xf, 0xf, false);
    return __int_as_float(__builtin_amdgcn_update_dpp(o, __float_as_int(cur), 0x112, 0xf, 0xf, false)); }
constexpr size_t SA_BLK = (size_t)4 * 6144;
struct EpiUp { static constexpr bool MIDK = false;
    const float* rs; bf16_t* VB; float* SA; float* SAS; float* out; const float* WC; const float* BC;
    __device__ __forceinline__ void operator()(const f32x4 (&acc)[2][2][4][2], const Unit& u, int wr, int wc, int fr0, int fq0) const {
        int fr = fr0, fq = fq0; asm volatile("" : "+v"(fr), "+v"(fq));
        const int col = u.pn * 128 + wc * 32 + 8 * fq;
        const f32x4 w0a = *(const f32x4*)(WC + col), w0b = *(const f32x4*)(WC + col + 4), w1a = *(const f32x4*)(WC + 6144 + col), w1b = *(const f32x4*)(WC + 6144 + col + 4);
        const f32x4 w2a = *(const f32x4*)(WC + 12288 + col), w2b = *(const f32x4*)(WC + 12288 + col + 4), bca = *(const f32x4*)(BC + col), bcb = *(const f32x4*)(BC + col + 4);
        bf16_t* vbase = VB + (size_t)(u.pn >> 4) * ((size_t)MPAD * 2048) + (col & 2047);
#pragma unroll
        for (int ai = 0; ai < 2; ++ai) { f32x4 pa0, pa1; float rr[4];
#pragma unroll
            for (int m = 0; m < 4; ++m) rr[m] = rs_rstd_main(rs, EPI_ROW, fr, fq);
            float* sa = SA + (size_t)(4 * u.pm + 2 * ai + wr) * SA_BLK + col;
#pragma unroll
            for (int m = 0; m < 4; ++m) { const int row = EPI_ROW; const float r = rr[m];
                const f32x4 a0 = acc[ai][0][m][0] * r, a1 = acc[ai][0][m][1] * r, v0 = acc[ai][1][m][0] * r, v1 = acc[ai][1][m][1] * r;
                if (m == 0) { pa0 = a0; pa1 = a1; }
                f32x4 o0, o1;
#pragma unroll
                for (int j = 0; j < 4; ++j) {
                    const float c0 = bca[j] + w0a[j] * dpp_prev2(a0[j], pa0[j]) + w1a[j] * dpp_prev1(a0[j], pa0[j]) + w2a[j] * a0[j];
                    const float c1 = bcb[j] + w0b[j] * dpp_prev2(a1[j], pa1[j]) + w1b[j] * dpp_prev1(a1[j], pa1[j]) + w2b[j] * a1[j];
                    o0[j] = gelu_tanh_f(c0) * v0[j]; o1[j] = gelu_tanh_f(c1) * v1[j]; }
                if (m == 0 && fr < 2) { o0 = v0; o1 = v1; float* q = sa + (size_t)fr * 6144; *(f32x4*)q = a0; *(f32x4*)(q + 4) = a1; }
                if (m == 3 && fr >= 14) { float* q = sa + (size_t)(fr - 12) * 6144; *(f32x4*)q = a0; *(f32x4*)(q + 4) = a1;
                    const int t = row & 2047; if (t >= 2046) { float* q2 = out + OFF_CONV_P + ((size_t)((row >> 11) * 2 + (t - 2046))) * 6144 + col; *(f32x4*)q2 = a0; *(f32x4*)(q2 + 4) = a1; } }
                *(u32x4*)(vbase + (size_t)row * 2048) = pack8(o0, o1);
                pa0 = a0; pa1 = a1; }
            asm volatile("" ::: "memory"); }
    }
    __device__ __forceinline__ void x(XEPI_ARGS) const { XROW_SETUP
        const float r = rs_rstd_x(rs, valid ? row : MPR, fr, fq);
        if (!valid) return;
        const int col = u.pn * 128 + cq; const f32x4 av = ax[0] * r, vv = ax[1] * r;
        *(f32x4*)(SAS + (size_t)(row - MPR) * 6144 + col) = av;
        *(u32x2*)(VB + (size_t)(u.pn >> 4) * ((size_t)MPAD * 2048) + (size_t)row * 2048 + (col & 2047)) = pack4(vv);
        *(f32x4*)(out + OFF_CONV_S + ((size_t)(row - MPR) * 2 + 1) * 6144 + col) = av;
    }
};
struct EpiPle { static constexpr bool MIDK = false;
    const float* rs2; const bf16_t* P; const bf16_t* X2; float* rs3; bf16_t* wout;
    __device__ __forceinline__ void operator()(EPI_ARGS) const {
        const int colh = wc * 32 + 8 * fq;
#pragma unroll
        for (int ai = 0; ai < 2; ++ai)
#pragma unroll
            for (int mp = 0; mp < 2; ++mp) { u32x4 pt[2][2], xt[2][2]; float rr[2];
#pragma unroll
                for (int mm = 0; mm < 2; ++mm) { const int m = 2 * mp + mm; rr[mm] = rs_rstd_main(rs2, EPI_ROW, fr, fq);
#pragma unroll
                    for (int bj = 0; bj < 2; ++bj) { const int col = u.pn * 256 + bj * 128 + colh; pt[mm][bj] = *(const u32x4*)(P + (size_t)EPI_ROW * 2048 + col);
                        xt[mm][bj] = *(const u32x4*)(X2 + (size_t)EPI_ROW * 2048 + col); } }
#pragma unroll
                for (int mm = 0; mm < 2; ++mm) { const int m = 2 * mp + mm; const int row = EPI_ROW; float ss = 0.f; const float r = rr[mm];
#pragma unroll
                    for (int bj = 0; bj < 2; ++bj) { const int col = u.pn * 256 + bj * 128 + colh; f32x4 p0, p1; unpack8(pt[mm][bj], p0, p1);
                        f32x4 v0, v1; unpack8(xt[mm][bj], v0, v1);
#pragma unroll
                        for (int j = 0; j < 4; ++j) { v0[j] += sigmoid_f(r * acc[ai][bj][m][0][j]) * p0[j]; v1[j] += sigmoid_f(r * acc[ai][bj][m][1][j]) * p1[j]; }
                        *(u32x4*)(wout + (size_t)row * 2048 + col) = pack8(v0, v1); ss += sumsq8(v0, v1); }
                    put_rowss(rs3, row, u.pn * 4 + wc, ss, fr, fq, true); }
                asm volatile("" ::: "memory"); }
    }
    __device__ __forceinline__ void x(XEPI_ARGS) const { XROW_SETUP
        float ss = 0.f; const float r = rs_rstd_x(rs2, valid ? row : MPR, fr, fq);
        if (valid) {
#pragma unroll
            for (int bj = 0; bj < 2; ++bj) { const int col = u.pn * 256 + bj * 128 + cq; const f32x4 p = unpack4(*(const u32x2*)(P + (size_t)row * 2048 + col));
                f32x4 v = unpack4(*(const u32x2*)(X2 + (size_t)row * 2048 + col));
#pragma unroll
                for (int j = 0; j < 4; ++j) v[j] += sigmoid_f(r * ax[bj][j]) * p[j];
                *(u32x2*)(wout + (size_t)row * 2048 + col) = pack4(v); ss += sumsq4(v); } }
        put_rowss(rs3, row, u.pn * 8 + wr * 4 + wc, ss, fr, fq, valid);
    }
};

#define XB_TMO      128
#define XB_XCNT(j)  (256  + 64 * (j))
#define XB_XSUB(j)  (1280 + 64 * (j))
#define XB_XGEN(j)  (2304 + 64 * (j))
#define XB_TOP      3328
#define XB_TOPGEN   3392
#define XCD_BAR_WORDS 3456
#define XB_SPIN_CAP (1u << 22)
__device__ __forceinline__ unsigned xb_ld(unsigned* p)              { return __hip_atomic_load(p, __ATOMIC_RELAXED, __HIP_MEMORY_SCOPE_AGENT); }
__device__ __forceinline__ unsigned xb_add(unsigned* p, unsigned v) { return __hip_atomic_fetch_add(p, v, __ATOMIC_RELAXED, __HIP_MEMORY_SCOPE_AGENT); }
__device__ __forceinline__ unsigned xb_xcc_id() { return (unsigned)__builtin_amdgcn_s_getreg((3 << 11) | 20) & 0xFu; }
#define XB_SPIN(cond, bar) do { unsigned _sp = 0; while (cond) { __builtin_amdgcn_s_sleep(1); \
    if ((++_sp & 255u) == 0u) { if (xb_ld(&(bar)[XB_TMO])) break; if (_sp > XB_SPIN_CAP) { atomicAdd(&(bar)[XB_TMO], 1u); break; } } } } while (0)
struct XcdBarrier { unsigned* bar; unsigned x; volatile LAS unsigned* st; };
__device__ __forceinline__ void xcd_barrier_complete(unsigned* bar, unsigned x, unsigned G, unsigned& nloc, unsigned& nx) {
    unsigned sum, cnt, mine, sp = 0u;
    for (;;) {
        sum = 0u; cnt = 0u; mine = 0u;
#pragma unroll
        for (unsigned j = 0; j < 16; ++j) { const unsigned c = xb_ld(&bar[XB_XCNT(j)]); sum += c; cnt += (c > 0u) ? 1u : 0u; mine = (j == x) ? c : mine; }
        if (sum == G) break;
        __builtin_amdgcn_s_sleep(1);
        if ((++sp & 255u) == 0u) { if (xb_ld(&bar[XB_TMO])) break; if (sp > XB_SPIN_CAP) { atomicAdd(&bar[XB_TMO], 1u); break; } }
    }
    nloc = mine > 0u ? mine : 1u; nx = cnt > 0u ? cnt : 1u;
}
__device__ __forceinline__ void xcd_barrier(const XcdBarrier& b, bool leader, unsigned G) {
    asm volatile("s_waitcnt vmcnt(0)" ::: "memory");
    __syncthreads();
    if (leader) {
        unsigned* bar = b.bar;
        __builtin_amdgcn_s_waitcnt(0);
        unsigned nloc = b.st[0], nx = b.st[1];
        if (nloc == 0u) { xcd_barrier_complete(bar, b.x, G, nloc, nx); b.st[0] = nloc; b.st[1] = nx; }
        const unsigned old = xb_add(&bar[XB_XSUB(b.x)], 1u);
        const unsigned gen = old / nloc;
        if (old + 1u == (gen + 1u) * nloc) {
            __builtin_amdgcn_fence(__ATOMIC_RELEASE, "agent");
            asm volatile("s_waitcnt vmcnt(0)" ::: "memory");
            const unsigned og = xb_add(&bar[XB_TOP], 1u);
            const unsigned tg = og / nx;
            if (og + 1u == (tg + 1u) * nx) xb_add(&bar[XB_TOPGEN], 1u);
            else XB_SPIN(xb_ld(&bar[XB_TOPGEN]) == tg, bar);
            __builtin_amdgcn_fence(__ATOMIC_ACQUIRE, "agent");
            xb_add(&bar[XB_XGEN(b.x)], 1u);
            asm volatile("s_waitcnt vmcnt(0)" ::: "memory");
        } else {
            XB_SPIN(xb_ld(&bar[XB_XGEN(b.x)]) == gen, bar);
            __builtin_amdgcn_fence(__ATOMIC_ACQUIRE, "agent");
            asm volatile("s_waitcnt vmcnt(0)" ::: "memory");
        }
    }
    __syncthreads();
}

struct Args { const float* in[33]; float* out; unsigned char* ws; };
enum { I_XP = 0, I_XS, I_CPOOL, I_SRE, I_SIM, I_CCONV, I_PP, I_PS, I_GMIX, I_WIN, I_WPOOL, I_PSCALE, I_LRE, I_LIM, I_LOGDT, I_BRE, I_BIM, I_CRE, I_CIM, I_D,
       I_WGLU, I_WBP, I_WBS, I_WOUT, I_GFFN, I_WUP, I_WCONV, I_BCONV, I_WDOWN, I_GPLE, I_WPG, I_WPLE, I_GFINAL };

__device__ __forceinline__ void transpose_item(const float* W, int K, int N, bf16_t* WT, const float* kscale, LAS float* scr, int item, int lane, int ldw = 0) {
    if (ldw == 0) ldw = K;
    const int nblk = N >> 6, kb = item / nblk, nb = item - kb * nblk, k0 = kb * 64, n0 = nb * 64;
    const int c4 = (lane & 15) * 4, kr = lane >> 4;
    f32x4 v[16];
#pragma unroll
    for (int i = 0; i < 16; ++i) v[i] = __builtin_nontemporal_load((const f32x4*)(W + (size_t)(k0 + 4 * i + kr) * N + n0 + c4));
    if (kscale) {
#pragma unroll
        for (int i = 0; i < 16; ++i) v[i] = v[i] * kscale[k0 + 4 * i + kr]; }
#pragma unroll
    for (int i = 0; i < 16; ++i) { LAS float* s = scr + (4 * i + kr) * 65 + c4; s[0] = v[i][0]; s[1] = v[i][1]; s[2] = v[i][2]; s[3] = v[i][3]; }
    asm volatile("s_waitcnt lgkmcnt(0)" ::: "memory");
    const int c = lane & 7;
#pragma unroll
    for (int j = 0; j < 8; ++j) { const int n = (lane >> 3) + 8 * j; const LAS float* s = scr + (8 * c) * 65 + n;
        u32x4 o; o.x = cvt_pk_bf16(s[0 * 65], s[1 * 65]); o.y = cvt_pk_bf16(s[2 * 65], s[3 * 65]); o.z = cvt_pk_bf16(s[4 * 65], s[5 * 65]); o.w = cvt_pk_bf16(s[6 * 65], s[7 * 65]);
        *(u32x4*)(WT + (size_t)(n0 + n) * ldw + k0 + 8 * c) = o; }
    asm volatile("s_waitcnt lgkmcnt(0)" ::: "memory");
}


constexpr int TI_IN = 32 * 96, TI_LE = 4 * 32, TI_EARLY = TI_IN + TI_LE, TI_PL = 4 * 4 * 4, TI_G = 16 * 32, TI_O = 32 * 32, TI_U = 32 * 192, TI_DN = 96 * 32;
constexpr int TI_ALL = TI_EARLY + TI_PL + 3 * TI_G + TI_O + TI_U + TI_DN + TI_O;
#define TRANSPOSE_ITEMS(first, last) do { for (int it = (first) + gw; it < (last); it += NGW) { int r = it; \
        if (r < TI_IN) { transpose_item(a.in[I_WIN], 2048, 6144, W_IN, nullptr, scr, r, lane); continue; } r -= TI_IN; \
        if (r < TI_LE) { transpose_item(a.in[I_WPLE], 256, 2048, W_PLE, nullptr, scr, r, lane); continue; } r -= TI_LE; \
        if (r < TI_PL) { const int k = r >> 4; transpose_item(a.in[I_WPOOL] + (size_t)k * 65536, 256, 256, W_POOL + (size_t)k * 65536, nullptr, scr, r & 15, lane); continue; } r -= TI_PL; \
        if (r < TI_G) { transpose_item(a.in[I_WGLU], 1024, 2048, W_GLU, nullptr, scr, r, lane); continue; } r -= TI_G; \
        if (r < TI_G) { transpose_item(a.in[I_WBP], 1024, 2048, W_BP, nullptr, scr, r, lane, 2048); continue; } r -= TI_G; \
        if (r < TI_G) { transpose_item(a.in[I_WBS], 1024, 2048, W_BP + 1024, nullptr, scr, r, lane, 2048); continue; } r -= TI_G; \
        if (r < TI_O) { transpose_item(a.in[I_WOUT], 2048, 2048, W_OUT, nullptr, scr, r, lane); continue; } r -= TI_O; \
        if (r < TI_U) { transpose_item(a.in[I_WUP], 2048, 12288, W_UP, a.in[I_GFFN], scr, r, lane); continue; } r -= TI_U; \
        if (r < TI_DN) { const int pnl = r >> 10; transpose_item(a.in[I_WDOWN] + (size_t)pnl * 2048 * 2048, 2048, 2048, W_DOWN + (size_t)pnl * 2048 * 2048, nullptr, scr, r & 1023, lane); continue; } r -= TI_DN; \
        transpose_item(a.in[I_WPG], 2048, 2048, W_PG, a.in[I_GPLE], scr, r, lane); } } while (0)

__global__ void __launch_bounds__(512, 2) fwd_kernel(Args a) {
    extern __shared__ __attribute__((aligned(16))) unsigned char smem[];
    cg::grid_group grid = cg::this_grid();
    LAS unsigned char* lds = (LAS unsigned char*)smem;
    const int G = gridDim.x, bid = blockIdx.x;
    const int wave_s = __builtin_amdgcn_readfirstlane((int)(threadIdx.x >> 6));
#define GRID_SYNC() do { const bool _ld = (wave_s == 0) && (lane_id() == 0); xcd_barrier(xbar, _ld, (unsigned)G); } while (0)
#define FRESH_IDS const int lane = lane_id(); const int wave = wave_s, tid = wave * 64 + lane; (void)tid;
    unsigned char* ws = a.ws; float* out = a.out;
    bf16_t* W_UP = (bf16_t*)(ws + WS_WUP); bf16_t* W_DOWN = (bf16_t*)(ws + WS_WDOWN); bf16_t* W_PG = (bf16_t*)(ws + WS_WPG); bf16_t* W_PLE = (bf16_t*)(ws + WS_WPLE);
    bf16_t* W_OUT = (bf16_t*)(ws + WS_WOUT); bf16_t* W_IN = (bf16_t*)(ws + WS_WIN); bf16_t* W_GLU = (bf16_t*)(ws + WS_WGLU); bf16_t* W_BP = (bf16_t*)(ws + WS_WBP);
    bf16_t* W_BS = (bf16_t*)(ws + WS_WBS); bf16_t* W_POOL = (bf16_t*)(ws + WS_WPOOL);
    bf16_t* Hb = (bf16_t*)(ws + WS_H); bf16_t* PBb = (bf16_t*)(ws + WS_PB); bf16_t* Pb = (bf16_t*)(ws + WS_P);
    bf16_t* Ub = (bf16_t*)(ws + WS_U); bf16_t* GATES = (bf16_t*)(ws + WS_GATES);
    f32x2* ABAR = (f32x2*)(ws + WS_U + 44 * MiB); f32x2* A16T = ABAR + 4096; f32x2* BBAR = ABAR + 8192;
    bf16_t* Ussm = (bf16_t*)(ws + WS_U + 20 * MiB); bf16_t* Usam = (bf16_t*)(ws + WS_U + 40 * MiB);
    bf16_t* DIFF = (bf16_t*)(ws + WS_DIFF); bf16_t* SSMACT = (bf16_t*)(ws + WS_SSMACT); bf16_t* YCAT = (bf16_t*)(ws + WS_YCAT);
 bf16_t* MERGED = (bf16_t*)(ws + WS_MERGED); bf16_t* X1B = (bf16_t*)(ws + WS_X1B);
    float* SAb = (float*)(ws + WS_ABUF + 40 * MiB);
    bf16_t* VBUF = (bf16_t*)(ws + WS_VBUF); bf16_t* X2B = (bf16_t*)(ws + WS_X2B);
    float* RS1 = (float*)(ws + WS_ROWSS); float* RS2 = RS1 + (size_t)MPAD * RS_SLOTS; float* RS3 = RS2 + (size_t)MPAD * RS_SLOTS;

    XcdBarrier xbar; xbar.bar = (unsigned*)(ws + WS_CTL); xbar.st = (volatile LAS unsigned*)(lds + LDS_BYTES - 16);
    { const int t0 = threadIdx.x; if (t0 < 2) xbar.st[t0] = 0u;
      if (gridDim.y == 0x7fffu) grid.sync();
      xbar.x = xb_xcc_id(); if (t0 == 0) (void)xb_add(&xbar.bar[XB_XCNT(xbar.x)], 1u); }
    {
    {
        FRESH_IDS
        const int gtid = bid * 512 + tid, GT = G * 512;
        if (bid < 256) {
            const int g = bid >> 2, q = bid & 3;
            LAS float* La = (LAS float*)lds;
            LAS float* Lap = (LAS float*)(lds + 512);
            LAS float* Lbb = (LAS float*)(lds + 9216);
            LAS float* Lcc = (LAS float*)(lds + 17408);
            bf16_t* PM = (bf16_t*)(ws + WS_PM) + (size_t)g * 128 * 256; bf16_t* QM = (bf16_t*)(ws + WS_QM) + (size_t)g * 256 * 128; bf16_t* KT = (bf16_t*)(ws + WS_KT) + (size_t)g * 4096;
            if (tid < 64) { const int p = tid;
                const float dt = expf(a.in[I_LOGDT][g]), lr = a.in[I_LRE][g * 64 + p], li = a.in[I_LIM][g * 64 + p];
                const float mag = expf(lr * dt), ar = mag * cosf(li * dt), ai = mag * sinf(li * dt);
                const float nr = ar - 1.0f, ni = ai, den = lr * lr + li * li, cr = (nr * lr + ni * li) / den, ci = (ni * lr - nr * li) / den;
                La[p * 2] = ar; La[p * 2 + 1] = ai;
                float wr_ = 1.f, wi_ = 0.f;
                for (int d = 0; d <= 16; ++d) { Lap[(d * 64 + p) * 2] = wr_; Lap[(d * 64 + p) * 2 + 1] = wi_; const float tr = wr_ * ar - wi_ * ai, ti = wr_ * ai + wi_ * ar; wr_ = tr; wi_ = ti; }
                for (int h = 0; h < 16; ++h) { const float br = a.in[I_BRE][(size_t)(g * 64 + p) * 16 + h], bi = a.in[I_BIM][(size_t)(g * 64 + p) * 16 + h];
                    Lbb[(p * 16 + h) * 2] = cr * br - ci * bi; Lbb[(p * 16 + h) * 2 + 1] = cr * bi + ci * br; } }
            for (int i = tid; i < 1024; i += 512) { Lcc[i * 2] = a.in[I_CRE][(size_t)g * 1024 + i]; Lcc[i * 2 + 1] = a.in[I_CIM][(size_t)g * 1024 + i]; }
            __syncthreads();
            if (q == 0) {
                if (tid < 64) { ABAR[g * 64 + tid] = *(const LAS f32x2*)(La + tid * 2); A16T[g * 64 + tid] = *(const LAS f32x2*)(Lap + (16 * 64 + tid) * 2); }
                for (int i = tid; i < 1024; i += 512) BBAR[(size_t)g * 1024 + i] = *(const LAS f32x2*)(Lbb + i * 2); }
            if (tid < 256) {
                const int hp = tid >> 4, h = tid & 15; float acc0 = 0.f, acc1 = 0.f, acc2 = 0.f, acc3 = 0.f;
                for (int p = 0; p < 64; ++p) { const f32x2 c = *(const LAS f32x2*)(Lcc + (hp * 64 + p) * 2), b = *(const LAS f32x2*)(Lbb + (p * 16 + h) * 2), w = *(const LAS f32x2*)(Lap + (4 * q * 64 + p) * 2), av = *(const LAS f32x2*)(La + p * 2);
                    const float mr = c[0] * b[0] - c[1] * b[1], mi = c[0] * b[1] + c[1] * b[0];
                    float zr = mr * w[0] - mi * w[1], zi = mr * w[1] + mi * w[0]; float t_;
                    acc0 += zr; t_ = zr * av[0] - zi * av[1]; zi = zr * av[1] + zi * av[0]; zr = t_;
                    acc1 += zr; t_ = zr * av[0] - zi * av[1]; zi = zr * av[1] + zi * av[0]; zr = t_;
                    acc2 += zr; t_ = zr * av[0] - zi * av[1]; zi = zr * av[1] + zi * av[0]; zr = t_;
                    acc3 += zr; }
                if (q == 0 && h == hp) acc0 += a.in[I_D][g * 16 + hp];
                bf16_t* k = KT + (size_t)(4 * q) * 256 + hp * 16 + h;
                k[0] = (bf16_t)(cvt_pk_bf16(acc0, 0.f) & 0xffffu); k[256] = (bf16_t)(cvt_pk_bf16(acc1, 0.f) & 0xffffu); k[512] = (bf16_t)(cvt_pk_bf16(acc2, 0.f) & 0xffffu); k[768] = (bf16_t)(cvt_pk_bf16(acc3, 0.f) & 0xffffu);
            }
            {
                const int pr = 32 * q + (tid >> 4), h = tid & 15, part = pr >> 6, p = pr & 63;
                const f32x2 b = *(const LAS f32x2*)(Lbb + (p * 16 + h) * 2);
                for (int s_ = 0; s_ < 16; ++s_) { const f32x2 w = *(const LAS f32x2*)(Lap + ((15 - s_) * 64 + p) * 2);
                    const float v = part ? (w[0] * b[1] + w[1] * b[0]) : (w[0] * b[0] - w[1] * b[1]);
                    PM[(size_t)pr * 256 + s_ * 16 + h] = (bf16_t)(cvt_pk_bf16(v, 0.f) & 0xffffu); } }
            {
                const int rloc = tid >> 3, tq = 4 * q + (rloc >> 4), hp = rloc & 15, pg = tid & 7; float vr[8], vi[8];
#pragma unroll
                for (int e = 0; e < 8; ++e) { const int p = pg * 8 + e; const f32x2 c = *(const LAS f32x2*)(Lcc + (hp * 64 + p) * 2), w = *(const LAS f32x2*)(Lap + ((tq + 1) * 64 + p) * 2);
                    vr[e] = c[0] * w[0] - c[1] * w[1]; vi[e] = -(c[0] * w[1] + c[1] * w[0]); }
                bf16_t* qrow = QM + (size_t)(tq * 16 + hp) * 128 + pg * 8;
                *(u32x4*)qrow = pack8((f32x4){vr[0], vr[1], vr[2], vr[3]}, (f32x4){vr[4], vr[5], vr[6], vr[7]});
                *(u32x4*)(qrow + 64) = pack8((f32x4){vi[0], vi[1], vi[2], vi[3]}, (f32x4){vi[4], vi[5], vi[6], vi[7]}); }
            __syncthreads();
        }
        LAS float* scr = (LAS float*)(lds + wave * 16640);
        const int gw = bid * 8 + wave, NGW = G * 8;
        TRANSPOSE_ITEMS(0, TI_EARLY);
        for (int row = gw; row < MPAD; row += NGW) {
            u32x2* o = (u32x2*)(Hb + (size_t)row * 2048) + lane;
            if (row < MT) {
                const float* xr = row < MPR ? a.in[I_XP] + (size_t)row * 2048 : a.in[I_XS] + (size_t)(row - MPR) * 2048;
                f32x4 v[8]; float s = 0.f;
#pragma unroll
                for (int j = 0; j < 8; ++j) { v[j] = *((const f32x4*)xr + lane + 64 * j); s += (v[j][0] * v[j][0] + v[j][1] * v[j][1]) + (v[j][2] * v[j][2] + v[j][3] * v[j][3]); }
                const float r = rsqrtf(wave_sum(s, lane) * (1.0f / 2048.0f) + EPS);
#pragma unroll
                for (int j = 0; j < 8; ++j) { const f32x4 gm = *((const f32x4*)a.in[I_GMIX] + lane + 64 * j); const f32x4 y = v[j] * r * gm; u32x2 w; w.x = cvt_pk_bf16(y[0], y[1]); w.y = cvt_pk_bf16(y[2], y[3]); o[64 * j] = w; }
            } else {
#pragma unroll
                for (int j = 0; j < 8; ++j) o[64 * j] = (u32x2){0u, 0u};
            }
        }
        for (int i = gtid; i < MPAD * 64; i += GT) { const int row = i >> 6, c4 = (i & 63) * 4; u32x2 w = (u32x2){0u, 0u};
            if (row < MT) { const float* pr = row < MPR ? a.in[I_PP] + (size_t)row * 256 : a.in[I_PS] + (size_t)(row - MPR) * 256; const f32x4 v = *(const f32x4*)(pr + c4); w.x = cvt_pk_bf16(v[0], v[1]); w.y = cvt_pk_bf16(v[2], v[3]); }
            *(u32x2*)(PBb + (size_t)row * 256 + c4) = w; }
    }
    GRID_SYNC();
    }

    {
    { pg8::Gemm g{Hb, W_IN, 2048, 2048, 2048, 32, 24, 0, 128, 256}; EpiZ E{Ub, Ussm, Usam, GATES, out}; pg8::gemm_phase(lds, g, G, bid, wave_s, E); }
    { pg8::Gemm g{PBb, W_PLE, 256, 256, 256, 32, 8, 0, 128, 256}; EpiBf E{Pb, 2048, nullptr}; pg8::gemm_phase(lds, g, G, bid, wave_s, E); }
    GRID_SYNC();
    }

    {
    {
        FRESH_IDS
#define POOL_LOADS(W, tile_, raw) do { const int r0_ = (tile_) * 16, t0_ = r0_ & 2047; const bf16_t* up_ = Ub + (size_t)r0_ * 1024 + c; \
            _Pragma("unroll") for (int j = 0; j < 15 + W; ++j) { const int dr = j - (W - 1); unsigned w_ = 0u; if (t0_ + dr >= 0) w_ = *(const unsigned*)(up_ + (long)dr * 1024); raw[j] = w_; } } while (0)
#define POOL_COMP(W, tile_, raw) do { const int r0_ = (tile_) * 16, t0_ = r0_ & 2047; f32x2 v[15 + W]; \
            _Pragma("unroll") for (int j = 0; j < 15 + W; ++j) v[j] = (f32x2){bf_lo(raw[j]), bf_hi(raw[j])}; \
            f32x2 sum = (f32x2){0.f, 0.f}; _Pragma("unroll") for (int j = 0; j < W - 1; ++j) sum += v[j]; \
            _Pragma("unroll") for (int i = 0; i < 16; ++i) { const int t = t0_ + i; const f32x2 cur = v[W - 1 + i]; sum += cur; \
                const float inv = 1.0f / (float)((t + 1) < W ? (t + 1) : W); const f32x2 d = sum * inv - cur; \
                *(unsigned*)(DIFF + (size_t)(r0_ + i) * 1024 + c) = cvt_pk_bf16(d[0], d[1]); sum -= v[i]; } } while (0)
#define POOL_ALL(W) do { \
            const bool has_s = bid < 128; const int ns = has_s ? bid : 0; f32x2 cr[15]; unsigned wc_ = 0u; \
            { const float* cp = a.in[I_CPOOL] + (size_t)ns * 15 * 1024 + c; \
              _Pragma("unroll") for (int j = 0; j < 15; ++j) cr[j] = has_s ? *(const f32x2*)(cp + (size_t)j * 1024) : (f32x2){0.f, 0.f}; \
              if (has_s) wc_ = *(const unsigned*)(Ub + (size_t)(MPR + ns) * 1024 + c); } \
            for (int tA = bid; tA < 512; tA += 2 * G) { const int tB = tA + G; const bool hasB = tB < 512; unsigned rawA[15 + W], rawB[15 + W]; \
                POOL_LOADS(W, tA, rawA); POOL_LOADS(W, hasB ? tB : tA, rawB); \
                POOL_COMP(W, tA, rawA); if (hasB) POOL_COMP(W, tB, rawB); } \
            if (has_s) { const f32x2 cur = (f32x2){bf_lo(wc_), bf_hi(wc_)}; f32x2 sum = cur; \
                _Pragma("unroll") for (int j = 16 - W; j <= 14; ++j) sum += cr[j]; \
                const f32x2 d = sum * (1.0f / (float)W) - cur; \
                *(unsigned*)(DIFF + (size_t)(MPR + ns) * 1024 + c) = cvt_pk_bf16(d[0], d[1]); \
                float* po = out + OFF_POOL_S + (size_t)ns * 15 * 1024 + c; \
                _Pragma("unroll") for (int j = 0; j < 14; ++j) *(f32x2*)(po + (size_t)j * 1024) = cr[j + 1]; } \
            for (int ns2 = bid + G; ns2 < 128; ns2 += G) {   \
                const float* cp = a.in[I_CPOOL] + (size_t)ns2 * 15 * 1024 + c; f32x2 c2[15]; \
                _Pragma("unroll") for (int j = 0; j < 15; ++j) c2[j] = *(const f32x2*)(cp + (size_t)j * 1024); \
                const unsigned w2 = *(const unsigned*)(Ub + (size_t)(MPR + ns2) * 1024 + c); const f32x2 cur = (f32x2){bf_lo(w2), bf_hi(w2)}; f32x2 sum = cur; \
                _Pragma("unroll") for (int j = 16 - W; j <= 14; ++j) sum += c2[j]; \
                const f32x2 d = sum * (1.0f / (float)W) - cur; \
                *(unsigned*)(DIFF + (size_t)(MPR + ns2) * 1024 + c) = cvt_pk_bf16(d[0], d[1]); \
                float* po = out + OFF_POOL_S + (size_t)ns2 * 15 * 1024 + c; \
                _Pragma("unroll") for (int j = 0; j < 14; ++j) *(f32x2*)(po + (size_t)j * 1024) = c2[j + 1]; } \
            } while (0)
        const bool conv_first = ((bid >> 3) & 1) != 0;
        if (conv_first) { const int lane = lane_id(); LAS float* scr = (LAS float*)(lds + wave * 16640); const int gw = bid * 8 + wave, NGW = G * 8; TRANSPOSE_ITEMS(TI_EARLY, TI_ALL); }
        __syncthreads();
        { const int c = 2 * tid, wsel = wave >> 1;
          if (wsel == 0) POOL_ALL(2); else if (wsel == 1) POOL_ALL(4); else if (wsel == 2) POOL_ALL(8); else POOL_ALL(16); }
#undef POOL_ALL
#undef POOL_COMP
#undef POOL_LOADS
        LAS float* Hl = (LAS float*)(lds + 131072) + wave * 512;
        const float* LRE = a.in[I_LRE]; const float* LIM = a.in[I_LIM]; const float* LOGDT = a.in[I_LOGDT];
        typedef float f32x16 __attribute__((ext_vector_type(16)));
        constexpr int UROW = 528;
        LAS unsigned char* UL = lds;
        LAS unsigned char* SL = lds + 128 * UROW;
        LAS unsigned char* KL = lds + 256 * UROW;
        for (int item = bid; item < 256; item += G) {
            const int n = item >> 6, g = item & 63;
            const bf16_t* PM = (const bf16_t*)(ws + WS_PM) + (size_t)g * 128 * 256; const bf16_t* QM = (const bf16_t*)(ws + WS_QM) + (size_t)g * 256 * 128; const bf16_t* KT = (const bf16_t*)(ws + WS_KT) + (size_t)g * 4096;
            const int li_ = lane & 31, kq = lane >> 5;
            u32x4 ut[8];
#pragma unroll
            for (int i = 0; i < 8; ++i) ut[i] = *((const u32x4*)(Ussm + (size_t)item * 2048 * 16) + tid + 512 * i);
            const u32x4 ktv = *(const u32x4*)(KT + tid * 8);
            bf16x8 pmf[16], qmf[8];
            { const bf16_t* pa = PM + (size_t)(32 * (wave & 3) + li_) * 256 + 8 * kq;
#pragma unroll
              for (int ks = 0; ks < 16; ++ks) pmf[ks] = *(const bf16x8*)(pa + 16 * ks); }
            float a16r = 0.f, a16i = 0.f;
            if (wave == 0) { const f32x2 a16 = A16T[g * 64 + lane]; a16r = a16[0]; a16i = a16[1]; }
            __syncthreads();
#pragma unroll
            for (int i = 0; i < 8; ++i) { const int idx = tid + 512 * i; *(LAS u32x4*)(UL + (idx >> 5) * UROW + (idx & 31) * 16) = ut[i]; }
            *(LAS u32x4*)(KL + tid * 16) = ktv;
            __syncthreads();
            {
                const int rb = wave & 3, cbp = wave >> 2; f32x16 s0, s1;
#pragma unroll
                for (int r = 0; r < 16; ++r) { s0[r] = 0.f; s1[r] = 0.f; }
                const LAS unsigned char* ub0 = UL + (64 * cbp + li_) * UROW + 16 * kq, * ub1 = ub0 + 32 * UROW;
#pragma unroll
                for (int ks = 0; ks < 16; ++ks) { const bf16x8 af = pmf[ks];
                    s0 = __builtin_amdgcn_mfma_f32_32x32x16_bf16(af, *(const LAS bf16x8*)(ub0 + 32 * ks), s0, 0, 0, 0);
                    s1 = __builtin_amdgcn_mfma_f32_32x32x16_bf16(af, *(const LAS bf16x8*)(ub1 + 32 * ks), s1, 0, 0, 0); }
                LAS unsigned char* sr0 = SL + (64 * cbp + li_) * UROW + (32 * rb + 4 * kq) * 4, * sr1 = sr0 + 32 * UROW;
#pragma unroll
                for (int rq = 0; rq < 4; ++rq) { *(LAS f32x4*)(sr0 + rq * 32) = (f32x4){s0[4 * rq], s0[4 * rq + 1], s0[4 * rq + 2], s0[4 * rq + 3]};
                                                 *(LAS f32x4*)(sr1 + rq * 32) = (f32x4){s1[4 * rq], s1[4 * rq + 1], s1[4 * rq + 2], s1[4 * rq + 3]}; }
            }
            { const bf16_t* qa = QM + (size_t)(32 * wave + li_) * 128 + 8 * kq;
#pragma unroll
              for (int kc = 0; kc < 8; ++kc) qmf[kc] = *(const bf16x8*)(qa + 16 * kc); }
            __syncthreads();
            if (wave == 0) {
                const int p = lane;
                float hr = 0.f, hi = 0.f;
#pragma unroll 8
                for (int c = 0; c < 128; ++c) { LAS unsigned char* row = SL + c * UROW;
                    const float sr = *(const LAS float*)(row + p * 4), si = *(const LAS float*)(row + 256 + p * 4);
                    const unsigned hb = cvt_pk_bf16(hr, hi);
                    *(LAS bf16_t*)(row + p * 2) = (bf16_t)(hb & 0xffffu); *(LAS bf16_t*)(row + 128 + p * 2) = (bf16_t)(hb >> 16);
                    const float nhr = a16r * hr - a16i * hi + sr, nhi = a16r * hi + a16i * hr + si; hr = nhr; hi = nhi; }
                out[OFF_RE_P + (size_t)(n * 64 + g) * 64 + p] = hr; out[OFF_IM_P + (size_t)(n * 64 + g) * 64 + p] = hi;
            }
            __syncthreads();
            {
                f32x16 y0, y1, y2, y3;
#pragma unroll
                for (int r = 0; r < 16; ++r) { y0[r] = 0.f; y1[r] = 0.f; y2[r] = 0.f; y3[r] = 0.f; }
                const int tq = 2 * wave + (li_ >> 4), hp = li_ & 15;
                const LAS unsigned char* ub = UL + li_ * UROW + 16 * kq;
                for (int ks = 0; ks <= 2 * wave + 1; ++ks) { const int d = tq - ks;
                    bf16x8 af = (bf16x8){0, 0, 0, 0, 0, 0, 0, 0}; if (d >= 0) af = *(const LAS bf16x8*)(KL + ((d * 16 + hp) * 16 + 8 * kq) * 2);
                    y0 = __builtin_amdgcn_mfma_f32_32x32x16_bf16(af, *(const LAS bf16x8*)(ub + 32 * ks), y0, 0, 0, 0);
                    y1 = __builtin_amdgcn_mfma_f32_32x32x16_bf16(af, *(const LAS bf16x8*)(ub + 32 * UROW + 32 * ks), y1, 0, 0, 0);
                    y2 = __builtin_amdgcn_mfma_f32_32x32x16_bf16(af, *(const LAS bf16x8*)(ub + 64 * UROW + 32 * ks), y2, 0, 0, 0);
                    y3 = __builtin_amdgcn_mfma_f32_32x32x16_bf16(af, *(const LAS bf16x8*)(ub + 96 * UROW + 32 * ks), y3, 0, 0, 0); }
                const LAS unsigned char* hb = SL + li_ * UROW + 16 * kq;
#pragma unroll
                for (int kc = 0; kc < 8; ++kc) { const bf16x8 af = qmf[kc];
                    y0 = __builtin_amdgcn_mfma_f32_32x32x16_bf16(af, *(const LAS bf16x8*)(hb + 32 * kc), y0, 0, 0, 0);
                    y1 = __builtin_amdgcn_mfma_f32_32x32x16_bf16(af, *(const LAS bf16x8*)(hb + 32 * UROW + 32 * kc), y1, 0, 0, 0);
                    y2 = __builtin_amdgcn_mfma_f32_32x32x16_bf16(af, *(const LAS bf16x8*)(hb + 64 * UROW + 32 * kc), y2, 0, 0, 0);
                    y3 = __builtin_amdgcn_mfma_f32_32x32x16_bf16(af, *(const LAS bf16x8*)(hb + 96 * UROW + 32 * kc), y3, 0, 0, 0); }
#define SSM_STORE(yv, cb) do { _Pragma("unroll") for (int rq = 0; rq < 4; ++rq) { f32x4 v = (f32x4){yv[4 * rq], yv[4 * rq + 1], yv[4 * rq + 2], yv[4 * rq + 3]}; \
                    _Pragma("unroll") for (int j = 0; j < 4; ++j) v[j] = gelu_tanh_f(v[j]); \
                    const int tok = 16 * (32 * (cb) + li_) + 2 * wave + (rq >> 1); \
                    *(u32x2*)(SSMACT + (size_t)(n * 2048 + tok) * 1024 + g * 16 + 8 * (rq & 1) + 4 * kq) = pack4(v); } } while (0)
                SSM_STORE(y0, 0); SSM_STORE(y1, 1); SSM_STORE(y2, 2); SSM_STORE(y3, 3);
#undef SSM_STORE
            }
        }
        __syncthreads();
        {
            const int lane = lane_id();
            const int gwv = bid * 8 + wave, g = gwv & 63, ns0 = (gwv >> 6) * 4, p = lane;
            if (gwv < 2048) {
                const f32x2 av = ABAR[g * 64 + p]; const float ar = av[0], ai = av[1];
                float Br[16], Bi[16];
#pragma unroll
                for (int q = 0; q < 8; ++q) { const f32x4 b = *((const f32x4*)(BBAR + (size_t)(g * 64 + p) * 16) + q); Br[2 * q] = b[0]; Bi[2 * q] = b[1]; Br[2 * q + 1] = b[2]; Bi[2 * q + 1] = b[3]; }
                const int hp = lane & 15, pq = lane >> 4;
                f32x4 Cr[4], Ci[4];
#pragma unroll
                for (int q = 0; q < 4; ++q) { Cr[q] = *(const f32x4*)(a.in[I_CRE] + (size_t)(g * 16 + hp) * 64 + pq * 16 + q * 4); Ci[q] = *(const f32x4*)(a.in[I_CIM] + (size_t)(g * 16 + hp) * 64 + pq * 16 + q * 4); }
                const float dsk = a.in[I_D][g * 16 + hp];
#pragma unroll
                for (int k = 0; k < 4; ++k) { const int ns = ns0 + k;
                    const bf16_t* ur = Usam + (size_t)ns * 1024 + g * 16; float bur = 0.f, bui = 0.f;
#pragma unroll
                    for (int q = 0; q < 4; ++q) { const f32x4 uv = unpack4(*(const u32x2*)(ur + q * 4));
#pragma unroll
                        for (int jj = 0; jj < 4; ++jj) { bur += Br[q * 4 + jj] * uv[jj]; bui += Bi[q * 4 + jj] * uv[jj]; } }
                    const float h0r = a.in[I_SRE][(size_t)(ns * 64 + g) * 64 + p], h0i = a.in[I_SIM][(size_t)(ns * 64 + g) * 64 + p];
                    const float hr = ar * h0r - ai * h0i + bur, hi = ar * h0i + ai * h0r + bui;
                    out[OFF_RE_S + (size_t)(ns * 64 + g) * 64 + p] = hr; out[OFF_IM_S + (size_t)(ns * 64 + g) * 64 + p] = hi;
                    *(LAS f32x2*)(Hl + k * 128 + p * 2) = (f32x2){hr, hi};
                    float y = 0.f;
#pragma unroll
                    for (int q = 0; q < 4; ++q)
#pragma unroll
                        for (int jj = 0; jj < 4; ++jj) { const f32x2 hv = *(const LAS f32x2*)(Hl + k * 128 + (pq * 16 + q * 4 + jj) * 2); y += Cr[q][jj] * hv[0] - Ci[q][jj] * hv[1]; }
                    y += shfl_xor_f(y, lane, 16); y += shfl_xor_f(y, lane, 32);
                    if (pq == 0) { y = gelu_tanh_f(y + dsk * bf_lo((unsigned)ur[hp])); SSMACT[(size_t)(MPR + ns) * 1024 + g * 16 + hp] = (bf16_t)(cvt_pk_bf16(y, 0.f) & 0xffffu); }
                }
            }
        }
        __syncthreads();
        if (!conv_first) { const int lane = lane_id(); LAS float* scr = (LAS float*)(lds + wave * 16640); const int gw = bid * 8 + wave, NGW = G * 8; TRANSPOSE_ITEMS(TI_EARLY, TI_ALL); }
}
    GRID_SYNC();
    }

    {
    { pg8::Gemm g{DIFF, W_POOL, 1024, 256, 256, 32, 4, 256, 128, 256}; EpiBf E{YCAT, 2048, a.in[I_PSCALE]}; pg8::gemm_phase(lds, g, G, bid, wave_s, E); }
    { pg8::Gemm g{SSMACT, W_GLU, 1024, 1024, 1024, 32, 8, 0, 1024, 128}; EpiGlu E{YCAT, 2048, 1024}; pg8::gemm_phase(lds, g, G, bid, wave_s, E); }
    GRID_SYNC();
    }

    {
    { pg8::Gemm g{YCAT, W_BP, 2048, 2048, 2048, 32, 8, 0, 128, 256}; EpiMerge E{GATES, MERGED}; pg8::gemm_phase(lds, g, G, bid, wave_s, E); }
    GRID_SYNC();
    }

    {
    { pg8::Gemm g{MERGED, W_OUT, 2048, 2048, 2048, 32, 8, 0, 128, 256}; EpiRes<false> E{a.in[I_XP], a.in[I_XS], nullptr, X1B, RS1}; pg8::gemm_phase(lds, g, G, bid, wave_s, E); }
    GRID_SYNC();
    }

    {
    { pg8::Gemm g{X1B, W_UP, 2048, 2048, 2048, 32, 48, 0, 6144, 128}; EpiUp E{RS1, VBUF, SAb, SAb + 128 * SA_BLK, out, a.in[I_WCONV], a.in[I_BCONV]}; pg8::gemm_phase(lds, g, G, bid, wave_s, E); }
    GRID_SYNC();
    }

    {
    {
        FRESH_IDS
        const float* WC = a.in[I_WCONV]; const float* BC = a.in[I_BCONV]; const float* CC = a.in[I_CCONV]; const float* SAS = SAb + 128 * SA_BLK;
        for (int id = bid * 512 + tid; id < (256 + 128) * 768; id += G * 512) {
            const int ri = id / 768, c0 = (id - ri * 768) * 8;
            const f32x4 w0a = *(const f32x4*)(WC + c0), w0b = *(const f32x4*)(WC + c0 + 4), w1a = *(const f32x4*)(WC + 6144 + c0), w1b = *(const f32x4*)(WC + 6144 + c0 + 4);
            const f32x4 w2a = *(const f32x4*)(WC + 12288 + c0), w2b = *(const f32x4*)(WC + 12288 + c0 + 4), bca = *(const f32x4*)(BC + c0), bcb = *(const f32x4*)(BC + c0 + 4);
            const f32x4 z4 = (f32x4){0.f, 0.f, 0.f, 0.f};
            f32x4 a0, a1, m1a = z4, m1b = z4, m2a = z4, m2b = z4; int row;
            if (ri < 256) { const int blk = ri >> 1, j = ri & 1; row = 64 * blk + j; const bool first = (blk & 31) == 0;
                const float* sb = SAb + (size_t)blk * SA_BLK + c0; a0 = *(const f32x4*)(sb + (size_t)j * 6144); a1 = *(const f32x4*)(sb + (size_t)j * 6144 + 4);
                const float* sp = sb - SA_BLK;
                if (j == 0) { if (!first) { m1a = *(const f32x4*)(sp + 3 * 6144); m1b = *(const f32x4*)(sp + 3 * 6144 + 4); m2a = *(const f32x4*)(sp + 2 * 6144); m2b = *(const f32x4*)(sp + 2 * 6144 + 4); } }
                else { m1a = *(const f32x4*)sb; m1b = *(const f32x4*)(sb + 4); if (!first) { m2a = *(const f32x4*)(sp + 3 * 6144); m2b = *(const f32x4*)(sp + 3 * 6144 + 4); } }
            } else { const int ns = ri - 256; row = MPR + ns; const float* c = CC + (size_t)ns * 2 * 6144 + c0;
                m2a = *(const f32x4*)c; m2b = *(const f32x4*)(c + 4); m1a = *(const f32x4*)(c + 6144); m1b = *(const f32x4*)(c + 6144 + 4);
                a0 = *(const f32x4*)(SAS + (size_t)ns * 6144 + c0); a1 = *(const f32x4*)(SAS + (size_t)ns * 6144 + c0 + 4);
                float* q = out + OFF_CONV_S + (size_t)ns * 2 * 6144 + c0; *(f32x4*)q = m1a; *(f32x4*)(q + 4) = m1b; }
            bf16_t* vp = VBUF + (size_t)(c0 >> 11) * ((size_t)MPAD * 2048) + (size_t)row * 2048 + (c0 & 2047); f32x4 v0, v1; unpack8(*(const u32x4*)vp, v0, v1);
            f32x4 ca = bca + w0a * m2a + w1a * m1a + w2a * a0, cb = bcb + w0b * m2b + w1b * m1b + w2b * a1;
#pragma unroll
            for (int j = 0; j < 4; ++j) { ca[j] = gelu_tanh_f(ca[j]) * v0[j]; cb[j] = gelu_tanh_f(cb[j]) * v1[j]; }
            *(u32x4*)vp = pack8(ca, cb);
        }
    }
    GRID_SYNC();
    }

    {
    { pg8::Gemm g{VBUF, W_DOWN, 2048, 2048, 6144, 32, 8, 0, 128, 256, 5, (unsigned)((size_t)MPAD * 2048 * 2), (unsigned)(2048u * 2048u * 2u)}; EpiRes<true> E{nullptr, nullptr, X1B, X2B, RS2}; pg8::gemm_phase(lds, g, G, bid, wave_s, E); }
    GRID_SYNC();
    }

    {
    { pg8::Gemm g{X2B, W_PG, 2048, 2048, 2048, 32, 8, 0, 128, 256}; EpiPle E{RS2, Pb, X2B, RS3, X1B}; pg8::gemm_phase(lds, g, G, bid, wave_s, E); }
    GRID_SYNC();
    }

    { FRESH_IDS
    for (int row = bid * 8 + wave; row < MT; row += G * 8) {
        const float r = rsqrtf(wave_sum((row < MPR && lane >= 32) ? 0.f : RS3[(size_t)row * RS_SLOTS + lane], lane) * (1.0f / (float)DM) + EPS);
        const u32x4* xi = (const u32x4*)(X1B + (size_t)row * 2048) + lane; f32x4* o = (f32x4*)(out + (size_t)row * 2048) + 2 * lane;
#pragma unroll
        for (int j = 0; j < 4; ++j) { f32x4 v0, v1; unpack8(xi[64 * j], v0, v1); const f32x4 g0 = *((const f32x4*)a.in[I_GFINAL] + 2 * lane + 128 * j), g1 = *((const f32x4*)a.in[I_GFINAL] + 2 * lane + 128 * j + 1);
            o[128 * j] = v0 * r * g0; o[128 * j + 1] = v1 * r * g1; }
    } }
}

extern "C" void kernel_launch(void* const* d_in, const int* in_sizes, int n_in, void* d_out, int out_size, void* d_ws, size_t ws_size, hipStream_t stream) {
    static int grid = 0;
    if (grid == 0) {
        if (n_in != 33 || ws_size < WS_END) { fprintf(stderr, "kernel_launch: unexpected n_in %d or ws_size %zu (< %zu)\n", n_in, ws_size, (size_t)WS_END); grid = -1; return; }
        int dev = 0, cus = 0, per_cu = 0;
        (void)hipGetDevice(&dev); (void)hipDeviceGetAttribute(&cus, hipDeviceAttributeMultiprocessorCount, dev);
        if (hipFuncSetAttribute((const void*)fwd_kernel, hipFuncAttributeMaxDynamicSharedMemorySize, LDS_BYTES) != hipSuccess) { fprintf(stderr, "kernel_launch: hipFuncSetAttribute failed\n"); grid = -1; return; }
        if (hipOccupancyMaxActiveBlocksPerMultiprocessor(&per_cu, (const void*)fwd_kernel, 512, LDS_BYTES) != hipSuccess || per_cu < 1) { fprintf(stderr, "kernel_launch: occupancy query says %d blocks/CU\n", per_cu); grid = -1; return; }
        grid = cus;
        fprintf(stderr, "kernel_launch: grid %d (per_cu %d), ws %zu\n", grid, per_cu, ws_size);
    }
    if (grid < 0) return;
    if (hipMemsetAsync((char*)d_ws + WS_CTL, 0, XCD_BAR_WORDS * sizeof(unsigned), stream) != hipSuccess) { fprintf(stderr, "kernel_launch: hipMemsetAsync of the barrier words failed\n"); return; }
    Args a{};
    for (int i = 0; i < 33; ++i) a.in[i] = (const float*)d_in[i];
    a.out = (float*)d_out; a.ws = (unsigned char*)d_ws;
    void* args[] = {&a};
    hipError_t e = hipLaunchCooperativeKernel((const void*)fwd_kernel, dim3(grid), dim3(512), args, LDS_BYTES, stream);
    if (e != hipSuccess) fprintf(stderr, "kernel_launch: cooperative launch failed: %s\n", hipGetErrorString(e));
}
```

```cpp
#include <hip/hip_runtime.h>
#include <hip/hip_cooperative_groups.h>
#include <cstdio>
#include <cstdint>
namespace cg = cooperative_groups;

#define LAS __attribute__((address_space(3)))
typedef unsigned short bf16_t;
typedef short bf16x8 __attribute__((ext_vector_type(8)));
typedef float f32x4 __attribute__((ext_vector_type(4)));
typedef float f32x2 __attribute__((ext_vector_type(2)));
typedef unsigned u32x4 __attribute__((ext_vector_type(4)));
typedef unsigned u32x2 __attribute__((ext_vector_type(2)));

constexpr int DM = 2048, SEQ = 2048, NSMP = 128, MPR = 8192, MT = 8320, MPAD = 8448;
constexpr int DFF = 6144, DPLE = 256;
constexpr float EPS = 1e-6f;
constexpr size_t OFF_Y = 0;
constexpr size_t OFF_POOL_P = (size_t)MT * DM;
constexpr size_t OFF_RE_P = OFF_POOL_P + 4 * 15 * 1024;
constexpr size_t OFF_IM_P = OFF_RE_P + 4 * 64 * 64;
constexpr size_t OFF_CONV_P = OFF_IM_P + 4 * 64 * 64;
constexpr size_t OFF_POOL_S = OFF_CONV_P + 4 * 2 * 6144;
constexpr size_t OFF_RE_S = OFF_POOL_S + (size_t)128 * 15 * 1024;
constexpr size_t OFF_IM_S = OFF_RE_S + 128 * 64 * 64;
constexpr size_t OFF_CONV_S = OFF_IM_S + 128 * 64 * 64;
constexpr size_t MiB = 1u << 20;
constexpr size_t WS_WUP = 0, WS_WDOWN = 48 * MiB, WS_WPG = 72 * MiB, WS_WPLE = 80 * MiB, WS_WOUT = 81 * MiB, WS_WIN = 89 * MiB,
                 WS_WGLU = 113 * MiB, WS_WBP = 117 * MiB, WS_WBS = 121 * MiB, WS_WPOOL = 125 * MiB;
constexpr size_t WS_X1B = 89 * MiB;
constexpr size_t WS_P = 126 * MiB;
constexpr size_t WS_H = 159 * MiB, WS_PB = 192 * MiB;
constexpr size_t WS_U = 197 * MiB, WS_GATES = 263 * MiB;
constexpr size_t WS_DIFF = 329 * MiB, WS_SSMACT = WS_DIFF + (size_t)MPAD * 1024 * 2;
constexpr size_t WS_YCAT = 159 * MiB, WS_T1 = 197 * MiB, WS_MERGED = 329 * MiB;
constexpr size_t WS_ABUF = 159 * MiB, WS_VBUF = 258 * MiB, WS_X2B = 159 * MiB;
constexpr size_t WS_ROWSS = 372 * MiB, WS_CTL = 362 * MiB + 512 * 1024;
constexpr size_t WS_PM = 363 * MiB, WS_QM = 367 * MiB, WS_KT = 371 * MiB, WS_END = 379 * MiB;
constexpr int LDS_BYTES = 163840;

typedef __bf16 bf16x2_t __attribute__((ext_vector_type(2)));
__device__ __forceinline__ unsigned cvt_pk_bf16(float lo, float hi) { const f32x2 v = {lo, hi}; return __builtin_bit_cast(unsigned, __builtin_convertvector(v, bf16x2_t)); }
__device__ __forceinline__ float bf_lo(unsigned w) { return __uint_as_float(w << 16); }
__device__ __forceinline__ float bf_hi(unsigned w) { return __uint_as_float(w & 0xffff0000u); }
__device__ __forceinline__ float sigmoid_f(float x) { return __builtin_amdgcn_rcpf(1.0f + __builtin_amdgcn_exp2f(-1.4426950408889634f * x)); }
__device__ __forceinline__ float gelu_tanh_f(float x) { const float z = 1.5957691216057308f * (x + 0.044715f * x * x * x); return x * sigmoid_f(z); }
__device__ __forceinline__ u32x4 pack8(const f32x4 a, const f32x4 b) { u32x4 w; w.x = cvt_pk_bf16(a[0], a[1]); w.y = cvt_pk_bf16(a[2], a[3]); w.z = cvt_pk_bf16(b[0], b[1]); w.w = cvt_pk_bf16(b[2], b[3]); return w; }
__device__ __forceinline__ void unpack8(const u32x4 w, f32x4& a, f32x4& b) { a = (f32x4){bf_lo(w.x), bf_hi(w.x), bf_lo(w.y), bf_hi(w.y)}; b = (f32x4){bf_lo(w.z), bf_hi(w.z), bf_lo(w.w), bf_hi(w.w)}; }
__device__ __forceinline__ float sumsq8(const f32x4 a, const f32x4 b) { return (a[0] * a[0] + a[1] * a[1]) + (a[2] * a[2] + a[3] * a[3]) + (b[0] * b[0] + b[1] * b[1]) + (b[2] * b[2] + b[3] * b[3]); }
__device__ __forceinline__ int lane_id() { int l; asm volatile("v_mbcnt_lo_u32_b32 %0, -1, 0\n\tv_mbcnt_hi_u32_b32 %0, -1, %0" : "=v"(l)); return l; }
__device__ __forceinline__ float shfl_xor_f(float v, int lane, int m) { return __int_as_float(__builtin_amdgcn_ds_bpermute((lane ^ m) << 2, __float_as_int(v))); }
constexpr int RS_SLOTS = 64;
__device__ __forceinline__ void put_rowss(float* rs, int row, int slot, float s, int fr, int fq, bool valid) {
    const int lane = fq * 16 + fr; s += shfl_xor_f(s, lane, 16); s += shfl_xor_f(s, lane, 32);
    if (fq == 0 && valid) rs[(size_t)row * RS_SLOTS + slot] = s;
}
__device__ __forceinline__ float rs_rstd_main(const float* rs, int row, int fr, int fq) {
    const f32x4 a = *(const f32x4*)(rs + (size_t)row * RS_SLOTS + 8 * fq), b = *(const f32x4*)(rs + (size_t)row * RS_SLOTS + 8 * fq + 4);
    float s = (a[0] + a[1]) + (a[2] + a[3]) + (b[0] + b[1]) + (b[2] + b[3]); const int lane = fq * 16 + fr;
    s += shfl_xor_f(s, lane, 16); s += shfl_xor_f(s, lane, 32);
    return rsqrtf(s * (1.0f / (float)DM) + EPS);
}
__device__ __forceinline__ float rs_rstd_x(const float* rs, int row, int fr, int fq) {
    float s = 0.f;
#pragma unroll
    for (int q = 0; q < 4; ++q) { const f32x4 a = *(const f32x4*)(rs + (size_t)row * RS_SLOTS + 16 * fq + 4 * q); s += (a[0] + a[1]) + (a[2] + a[3]); }
    const int lane = fq * 16 + fr; s += shfl_xor_f(s, lane, 16); s += shfl_xor_f(s, lane, 32);
    return rsqrtf(s * (1.0f / (float)DM) + EPS);
}
__device__ __forceinline__ float wave_sum(float v, int lane) {
#pragma unroll
    for (int o = 1; o < 64; o <<= 1) v += shfl_xor_f(v, lane, o);
    return v;
}

namespace pg8 {
constexpr int BM = 256, BK = 64, HALF = 128, HTB = HALF * BK * 2, STAGE_BYTES = 8 * HTB, NXCD = 8, WGM = 4;
__device__ __forceinline__ int lds_byte(int r, int c) { const int st = (r >> 4) * 2 + (c >> 5), rr = r & 15, cc = c & 31, ob = rr * 64 + cc * 2; return st * 1024 + (ob ^ (((ob >> 9) & 1) << 5)); }
__device__ __forceinline__ void stage_rc(int b, int& R, int& C) { const int st = b / 1024, sb = b % 1024, swz = sb ^ (((sb >> 9) & 1) << 5); R = (st >> 1) * 16 + swz / 64; C = (st & 1) * 32 + (swz % 64) / 2; }
__device__ __forceinline__ int perm32(int rho) { const int n = rho >> 4, i = rho & 15; return 8 * (i >> 2) + 4 * n + (i & 3); }
struct Unit { int pm, pn; };
struct Gemm { const bf16_t* A; const bf16_t* B; int lda, ldb, K, nM, nN, a_koff, b_half_rows, b_tile_rows; int kp_shift; unsigned a_pstride, b_pstride; };
struct StaticOrder {
    int nM, nN, nwg, G, c;
    __device__ __forceinline__ void init(int nM_, int nN_, int G_, int c_) { nM = nM_; nN = nN_; nwg = nM * nN; G = G_; c = c_; }
    __device__ __forceinline__ bool next(int i, Unit& u) const {
        const long L = (long)i * G + c; if (L >= nwg) return false;
        int wgid = (int)L; { const int q = nwg / NXCD, r = nwg % NXCD, xcd = wgid % NXCD, off = wgid / NXCD; wgid = (xcd < r ? xcd * (q + 1) : r * (q + 1) + (xcd - r) * q) + off; }
        const int nig = WGM * nN, gid = wgid / nig, fm = gid * WGM, gsz = (nM - fm) < WGM ? (nM - fm) : WGM;
        u.pm = fm + ((wgid % nig) % gsz); u.pn = (wgid % nig) / gsz; return true;
    }
};

template <class Epi, bool XROWS_, int WR>
__device__ __forceinline__ void gemm_phase_wr(LAS unsigned char* lds, const Gemm g, int G, int cidx, int wave_s, const Epi& E) {
    const int lane = lane_id();
    constexpr int wr = WR;
    constexpr bool XROWS = XROWS_ && WR == 1;
    const int wid = wave_s, tid = wid * 64 + lane, wc = wid & 3, fr = lane & 15, fq = lane >> 4;
    int K = g.K; asm volatile("" : "+s"(K));
    const int nt = K / BK;
    StaticOrder S; S.init(g.nM, g.nN, G, cidx);
    unsigned voffA[2], voffB[2];
#pragma unroll
    for (int i = 0; i < 2; ++i) { int R, C; stage_rc(tid * 16 + i * 8192, R, C); const int Rb = (R & ~31) + perm32(R & 31);
        voffA[i] = (unsigned)(R * g.lda + C) * 2u; voffB[i] = (unsigned)(Rb * g.ldb + C) * 2u; }
    const unsigned kstep = (unsigned)(BK * 2);
    const unsigned kps = g.kp_shift > 0 ? (unsigned)g.kp_shift : 31u, kpm = (1u << kps) - 1u;
    const unsigned hstepA = (unsigned)HALF * g.lda * 2u, tstepA = 2u * hstepA, kofA = (unsigned)g.a_koff * 2u;
    const unsigned hstepB = (unsigned)g.b_half_rows * g.ldb * 2u, tstepB = (unsigned)g.b_tile_rows * g.ldb * 2u;
    const __amdgpu_buffer_rsrc_t rsA = __builtin_amdgcn_make_buffer_rsrc((void*)g.A, (short)0, 0x7fffffff, 0x00020000);
    const __amdgpu_buffer_rsrc_t rsB = __builtin_amdgcn_make_buffer_rsrc((void*)g.B, (short)0, 0x7fffffff, 0x00020000);
    const unsigned ldsw = (unsigned)wid * 1024u;
    const int aoff = lds_byte(wr * 64 + fr, fq * 8), boff = lds_byte(wc * 32 + fr, fq * 8);
    const unsigned voffX = (unsigned)(fr * g.lda + fq * 8) * 2u;
    const unsigned xrow0 = (unsigned)MPR * g.lda * 2u, xstep = 4u * g.lda * 2u;
#define PG8_SA(b, h) (((b) * 2 + (h)) * HTB)
#define PG8_SB(b, h) ((4 + (b) * 2 + (h)) * HTB)
#define PG8_STAGE(bufoff, rs, soff, voff) do { _Pragma("unroll") for (int _i = 0; _i < 2; ++_i) \
        __builtin_amdgcn_raw_ptr_buffer_load_lds(rs, (LAS unsigned*)(lds + (bufoff) + ldsw + _i * 8192), 16, (voff)[_i], (soff), 0, 0); } while (0)
#define PG8_LDA(dst, b, h) do { _Pragma("unroll") for (int m = 0; m < 4; ++m) _Pragma("unroll") for (int k = 0; k < 2; ++k) dst[m][k] = *(const LAS bf16x8*)(lds + PG8_SA(b, h) + aoff + m * 2048 + k * 1024); } while (0)
#define PG8_LDB(dst, b, h) do { _Pragma("unroll") for (int n = 0; n < 2; ++n) _Pragma("unroll") for (int k = 0; k < 2; ++k) dst[n][k] = *(const LAS bf16x8*)(lds + PG8_SB(b, h) + boff + n * 2048 + k * 1024); } while (0)
#define PG8_MMA(ai, bj, At, Bt) do { __builtin_amdgcn_s_setprio(1); _Pragma("unroll") for (int m = 0; m < 4; ++m) _Pragma("unroll") for (int n = 0; n < 2; ++n) _Pragma("unroll") for (int k = 0; k < 2; ++k) \
        acc[ai][bj][m][n] = __builtin_amdgcn_mfma_f32_16x16x32_bf16(Bt[n][k], At[m][k], acc[ai][bj][m][n], 0, 0, 0); __builtin_amdgcn_s_setprio(0); } while (0)
#define PG8_LOADX(dst, soff) do { if (XROWS) { _Pragma("unroll") for (int k = 0; k < 2; ++k) dst[k] = __builtin_bit_cast(bf16x8, __builtin_amdgcn_raw_buffer_load_b128(rsA, voffX + k * 64, (soff), 0)); } } while (0)
#define PG8_MMAX(Xf) do { if (!XROWS) break; __builtin_amdgcn_s_setprio(1); _Pragma("unroll") for (int k = 0; k < 2; ++k) _Pragma("unroll") for (int n = 0; n < 2; ++n) { \
        accX[n] = __builtin_amdgcn_mfma_f32_16x16x32_bf16(B0[n][k], Xf[k], accX[n], 0, 0, 0); accX[2 + n] = __builtin_amdgcn_mfma_f32_16x16x32_bf16(B1[n][k], Xf[k], accX[2 + n], 0, 0, 0); } __builtin_amdgcn_s_setprio(0); } while (0)
#define PG8_WAIT_V(n) asm volatile("s_waitcnt vmcnt(" #n ")" ::: "memory")
#define PG8_WAITV_SP2 do { if constexpr (XROWS) PG8_WAIT_V(10); else PG8_WAIT_V(8); } while (0)
#define PG8_WAIT_L(n) asm volatile("s_waitcnt lgkmcnt(" #n ")" ::: "memory")
#define PG8_BAR __builtin_amdgcn_s_barrier()
#define PG8_SCHED __builtin_amdgcn_sched_barrier(0)
    Unit cur, nxt; int ui = 0;
    if (!S.next(0, cur)) return;
    f32x4 acc[2][2][4][2];
#pragma unroll
    for (int a = 0; a < 2; ++a)
#pragma unroll
        for (int b = 0; b < 2; ++b)
#pragma unroll
            for (int m = 0; m < 4; ++m)
#pragma unroll
                for (int n = 0; n < 2; ++n) acc[a][b][m][n] = (f32x4){0.f, 0.f, 0.f, 0.f};
    bf16x8 At[4][2], B0[2][2], B1[2][2], XA[2];
    f32x4 accX[4]; accX[0] = (f32x4){0.f, 0.f, 0.f, 0.f}; accX[1] = accX[0]; accX[2] = accX[0]; accX[3] = accX[0];
    unsigned cA = (unsigned)cur.pm * tstepA + (unsigned)cur.pn * kofA, cB = (unsigned)cur.pn * tstepB;
    unsigned cX = xrow0 + (unsigned)cur.pm * xstep + (unsigned)cur.pn * kofA;
    PG8_LOADX(XA, cX);
    PG8_STAGE(PG8_SB(0, 0), rsB, cB, voffB); PG8_STAGE(PG8_SB(0, 1), rsB, cB + hstepB, voffB); PG8_STAGE(PG8_SA(0, 0), rsA, cA, voffA); PG8_STAGE(PG8_SA(0, 1), rsA, cA + hstepA, voffA);
    if (wr == 1) PG8_BAR;
    PG8_WAIT_V(2); PG8_BAR;
    PG8_STAGE(PG8_SB(1, 0), rsB, cB + kstep, voffB); PG8_STAGE(PG8_SA(1, 0), rsA, cA + kstep, voffA); PG8_STAGE(PG8_SB(1, 1), rsB, cB + hstepB + kstep, voffB);
    PG8_WAIT_V(6); PG8_BAR;
    for (;;) {
        const bool has_next = S.next(ui + 1, nxt);
        const unsigned nA = has_next ? (unsigned)nxt.pm * tstepA + (unsigned)nxt.pn * kofA : cA, nB = has_next ? (unsigned)nxt.pn * tstepB : cB;
        const unsigned nX = has_next ? xrow0 + (unsigned)nxt.pm * xstep + (unsigned)nxt.pn * kofA : cX;
        for (int seg = 0; seg < (Epi::MIDK ? 2 : 1); ++seg) {
        const int tbeg = (Epi::MIDK && seg == 1) ? (nt >> 1) : 0, tend = (Epi::MIDK && seg == 0) ? (nt >> 1) : nt;
        if constexpr (Epi::MIDK) { if (seg == 1) E.mid(acc, accX, cur, wr, wc, fr, fq); }
        for (int t = tbeg; t < tend; t += 2) {
            const bool last = (t == nt - 2);
            const unsigned t1 = (unsigned)(t + 1), t2 = (unsigned)(t + 2);
            const unsigned ko1 = (t1 & kpm) * kstep, ko2 = (t2 & kpm) * kstep, pa1 = (t1 >> kps) * g.a_pstride, pa2 = (t2 >> kps) * g.a_pstride, pb2 = (t2 >> kps) * g.b_pstride;
            const unsigned a1 = cA + pa1 + ko1, x1 = cX + pa1 + ko1;
            const unsigned a2 = last ? nA : cA + pa2 + ko2, b2 = last ? nB : cB + pb2 + ko2;
            const unsigned a3 = a2 + kstep, b3 = b2 + kstep, x2 = last ? nX : cX + pa2 + ko2;
            PG8_LDB(B0, 0, 0); PG8_LDB(B1, 0, 1); PG8_SCHED; PG8_LDA(At, 0, 0); PG8_STAGE(PG8_SA(1, 1), rsA, a1 + hstepA, voffA);
            PG8_WAIT_V(8); PG8_WAIT_L(0); PG8_BAR; PG8_MMA(0, 0, At, B0); PG8_MMA(0, 1, At, B1); PG8_MMAX(XA); PG8_LOADX(XA, x1); PG8_BAR; PG8_SCHED;
            PG8_LDA(At, 0, 1); PG8_STAGE(PG8_SB(0, 0), rsB, b2, voffB); PG8_STAGE(PG8_SB(0, 1), rsB, b2 + hstepB, voffB); PG8_STAGE(PG8_SA(0, 0), rsA, a2, voffA);
            PG8_WAITV_SP2; PG8_WAIT_L(0); PG8_BAR; PG8_MMA(1, 0, At, B0); PG8_MMA(1, 1, At, B1); PG8_BAR; PG8_SCHED;
            PG8_LDB(B0, 1, 0); PG8_LDB(B1, 1, 1); PG8_SCHED; PG8_LDA(At, 1, 0); PG8_STAGE(PG8_SA(0, 1), rsA, a2 + hstepA, voffA);
            PG8_WAIT_V(8); PG8_WAIT_L(0); PG8_BAR; PG8_MMA(0, 0, At, B0); PG8_MMA(0, 1, At, B1); PG8_MMAX(XA); PG8_LOADX(XA, x2); PG8_BAR; PG8_SCHED;
            PG8_LDA(At, 1, 1); PG8_STAGE(PG8_SB(1, 0), rsB, b3, voffB); PG8_STAGE(PG8_SB(1, 1), rsB, b3 + hstepB, voffB); PG8_STAGE(PG8_SA(1, 0), rsA, a3, voffA);
            PG8_WAITV_SP2; PG8_WAIT_L(0); PG8_BAR; PG8_MMA(1, 0, At, B0); PG8_MMA(1, 1, At, B1); PG8_BAR; PG8_SCHED;
        }
        }
        if (wr == 0) PG8_BAR;
        if constexpr (Epi::FUSED) { E.template fused<XROWS>(acc, accX, cur, wr, wc, fr, fq, tid == 0); }
        else {
        if constexpr (XROWS) { { const f32x4 ax2[2] = {accX[0], accX[2]}; E.x(ax2, cur, 0, wc, fr, fq); } { const f32x4 ax3[2] = {accX[1], accX[3]}; E.x(ax3, cur, 1, wc, fr, fq); } }
        E(acc, cur, wr, wc, fr, fq);
        }
        if (!has_next) break;
        accX[0] = (f32x4){0.f, 0.f, 0.f, 0.f}; accX[1] = accX[0]; accX[2] = accX[0]; accX[3] = accX[0];
#pragma unroll
        for (int a = 0; a < 2; ++a)
#pragma unroll
            for (int b = 0; b < 2; ++b)
#pragma unroll
                for (int m = 0; m < 4; ++m)
#pragma unroll
                    for (int n = 0; n < 2; ++n) acc[a][b][m][n] = (f32x4){0.f, 0.f, 0.f, 0.f};
        cur = nxt; cA = nA; cB = nB; cX = nX; ++ui;
        if (wr == 1) PG8_BAR;
    }
    PG8_WAIT_V(0);
    PG8_BAR;
#undef PG8_SA
#undef PG8_SB
#undef PG8_STAGE
#undef PG8_LDA
#undef PG8_LDB
#undef PG8_MMA
#undef PG8_LOADX
#undef PG8_MMAX
#undef PG8_WAIT_V
#undef PG8_WAITV_SP2
#undef PG8_WAIT_L
#undef PG8_BAR
#undef PG8_SCHED
}
template <class Epi, bool XROWS = true>
__device__ __forceinline__ void gemm_phase(LAS unsigned char* lds, const Gemm g, int G, int cidx, int wave_s, const Epi& E) {
    if (wave_s < 4) gemm_phase_wr<Epi, XROWS, 0>(lds, g, G, cidx, wave_s, E); else gemm_phase_wr<Epi, XROWS, 1>(lds, g, G, cidx, wave_s, E);
}
}
using pg8::Unit;

#define EPI_ARGS const f32x4 (&acc)[2][2][4][2], const Unit& u, int wr, int wc, int fr, int fq
#define EPI_FOR_ROWS _Pragma("unroll") for (int ai = 0; ai < 2; ++ai) _Pragma("unroll") for (int m = 0; m < 4; ++m)
#define EPI_ROW (u.pm * 256 + ai * 128 + wr * 64 + m * 16 + fr)

#define XROW_SETUP const bool valid = fr < 4; const int row = MPR + 4 * u.pm + fr; const int cq = wc * 32 + 8 * fq + 4 * wr; (void)valid; (void)row; (void)cq;
__device__ __forceinline__ u32x2 pack4(const f32x4 a) { u32x2 w; w.x = cvt_pk_bf16(a[0], a[1]); w.y = cvt_pk_bf16(a[2], a[3]); return w; }
__device__ __forceinline__ f32x4 unpack4(const u32x2 w) { return (f32x4){bf_lo(w.x), bf_hi(w.x), bf_lo(w.y), bf_hi(w.y)}; }
__device__ __forceinline__ float sumsq4(const f32x4 a) { return (a[0] * a[0] + a[1] * a[1]) + (a[2] * a[2] + a[3] * a[3]); }
#define XEPI_ARGS const f32x4 (&ax)[2], const Unit& u, int wr, int wc, int fr, int fq

struct EpiZ { static constexpr bool MIDK = false; static constexpr bool FUSED = false;
    bf16_t* U; bf16_t* US; bf16_t* UX; bf16_t* GATES; float* out;
    __device__ __forceinline__ void operator()(EPI_ARGS) const {
        const int colh = wc * 32 + 8 * fq;
        if (u.pn < 8) {
            EPI_FOR_ROWS { const int row = EPI_ROW;
#pragma unroll
                for (int bj = 0; bj < 2; ++bj) { const int col = u.pn * 256 + bj * 128 + colh;
                    bf16_t* dst = u.pn < 4 ? U + (size_t)row * 1024 + col : US + (((size_t)((row >> 11) * 64 + ((col - 1024) >> 4)) * 2048 + (row & 2047)) * 16 + (col & 8));
                    *(u32x4*)dst = pack8(acc[ai][bj][m][0], acc[ai][bj][m][1]);
                    if (u.pn < 4) { const int t = row & 2047;
                        if (t >= 2033) { float* q = out + OFF_POOL_P + ((size_t)((row >> 11) * 15 + (t - 2033))) * 1024 + col; *(f32x4*)q = acc[ai][bj][m][0]; *(f32x4*)(q + 4) = acc[ai][bj][m][1]; } } } }
        } else {
            EPI_FOR_ROWS { const int row = EPI_ROW;
#pragma unroll
                for (int bj = 0; bj < 2; ++bj) { const int col = (u.pn - 8) * 256 + bj * 128 + colh; f32x4 v0 = acc[ai][bj][m][0], v1 = acc[ai][bj][m][1];
#pragma unroll
                    for (int j = 0; j < 4; ++j) { v0[j] = sigmoid_f(v0[j]); v1[j] = sigmoid_f(v1[j]); }
                    *(u32x4*)(GATES + (size_t)row * 4096 + col) = pack8(v0, v1); } }
        }
    }
    __device__ __forceinline__ void x(XEPI_ARGS) const { XROW_SETUP
        if (!valid) return;
#pragma unroll
        for (int bj = 0; bj < 2; ++bj) { const int col = u.pn * 256 + bj * 128 + cq;
            if (u.pn < 8) { *(u32x2*)(u.pn < 4 ? U + (size_t)row * 1024 + col : UX + (size_t)(row - MPR) * 1024 + (col - 1024)) = pack4(ax[bj]); if (u.pn < 4) *(f32x4*)(out + OFF_POOL_S + ((size_t)(row - MPR) * 15 + 14) * 1024 + col) = ax[bj]; }
            else { f32x4 v = ax[bj];
#pragma unroll
                for (int j = 0; j < 4; ++j) v[j] = sigmoid_f(v[j]);
                *(u32x2*)(GATES + (size_t)row * 4096 + col - 2048) = pack4(v); } }
    }
};
struct EpiBf { static constexpr bool MIDK = false; static constexpr bool FUSED = false;
    bf16_t* O; int ldo; const float* cscale;
    __device__ __forceinline__ void operator()(EPI_ARGS) const {
        const int colh = wc * 32 + 8 * fq;
#pragma unroll
        for (int bj = 0; bj < 2; ++bj) { const int col = u.pn * 256 + bj * 128 + colh;
            f32x4 s0 = (f32x4){1.f, 1.f, 1.f, 1.f}, s1 = s0; if (cscale) { s0 = *(const f32x4*)(cscale + col); s1 = *(const f32x4*)(cscale + col + 4); }
            EPI_FOR_ROWS { const int row = EPI_ROW; *(u32x4*)(O + (size_t)row * ldo + col) = pack8(acc[ai][bj][m][0] * s0, acc[ai][bj][m][1] * s1); } }
    }
    __device__ __forceinline__ void x(XEPI_ARGS) const { XROW_SETUP
        if (!valid) return;
#pragma unroll
        for (int bj = 0; bj < 2; ++bj) { const int col = u.pn * 256 + bj * 128 + cq; f32x4 v = ax[bj]; if (cscale) v = v * *(const f32x4*)(cscale + col);
            *(u32x2*)(O + (size_t)row * ldo + col) = pack4(v); }
    }
};
struct EpiGlu { static constexpr bool MIDK = false; static constexpr bool FUSED = false;
    bf16_t* O; int ldo; int coff;
    __device__ __forceinline__ void operator()(EPI_ARGS) const {
        const int col = coff + u.pn * 128 + wc * 32 + 8 * fq;
        EPI_FOR_ROWS { const int row = EPI_ROW; f32x4 v0 = acc[ai][0][m][0], v1 = acc[ai][0][m][1]; const f32x4 g0 = acc[ai][1][m][0], g1 = acc[ai][1][m][1];
#pragma unroll
            for (int j = 0; j < 4; ++j) { v0[j] *= sigmoid_f(g0[j]); v1[j] *= sigmoid_f(g1[j]); }
            *(u32x4*)(O + (size_t)row * ldo + col) = pack8(v0, v1); }
    }
    __device__ __forceinline__ void x(XEPI_ARGS) const { XROW_SETUP
        if (!valid) return;
        f32x4 v = ax[0];
#pragma unroll
        for (int j = 0; j < 4; ++j) v[j] *= sigmoid_f(ax[1][j]);
        *(u32x2*)(O + (size_t)row * ldo + coff + u.pn * 128 + cq) = pack4(v);
    }
};
struct EpiMerge { static constexpr bool MIDK = true; static constexpr bool FUSED = false;
    const bf16_t* GATES; bf16_t* MERGED;
    static __device__ __forceinline__ f32x4 clampg(f32x4 g) { return (f32x4){fmaxf(g[0], 1e-20f), fmaxf(g[1], 1e-20f), fmaxf(g[2], 1e-20f), fmaxf(g[3], 1e-20f)}; }
    static __device__ __forceinline__ f32x4 rcp4(f32x4 g) { return (f32x4){__builtin_amdgcn_rcpf(g[0]), __builtin_amdgcn_rcpf(g[1]), __builtin_amdgcn_rcpf(g[2]), __builtin_amdgcn_rcpf(g[3])}; }
    __device__ __forceinline__ void mid(f32x4 (&acc)[2][2][4][2], f32x4 (&ax)[4], const Unit& u, int wr, int wc, int fr0, int fq) const {
        int fr = fr0; asm volatile("" : "+v"(fr));
        const int colh = wc * 32 + 8 * fq;
#pragma unroll
        for (int ai = 0; ai < 2; ++ai)
#pragma unroll
            for (int m = 0; m < 4; ++m) { u32x4 gp[2], gs[2];
#pragma unroll
                for (int bj = 0; bj < 2; ++bj) { const bf16_t* gr = GATES + (size_t)EPI_ROW * 4096 + u.pn * 256 + bj * 128 + colh; gp[bj] = *(const u32x4*)gr; gs[bj] = *(const u32x4*)(gr + 2048); }
#pragma unroll
                for (int bj = 0; bj < 2; ++bj) { f32x4 p0, p1, s0, s1; unpack8(gp[bj], p0, p1); unpack8(gs[bj], s0, s1);
                    acc[ai][bj][m][0] = acc[ai][bj][m][0] * (p0 * rcp4(clampg(s0))); acc[ai][bj][m][1] = acc[ai][bj][m][1] * (p1 * rcp4(clampg(s1))); }
                if (m & 1) asm volatile("" ::: "memory"); }
        if (wr == 0) return;
        const int row = MPR + 4 * u.pm + (fr & 3);
#pragma unroll
        for (int bj = 0; bj < 2; ++bj)
#pragma unroll
            for (int n = 0; n < 2; ++n) { const bf16_t* gr = GATES + (size_t)row * 4096 + u.pn * 256 + bj * 128 + wc * 32 + 8 * fq + 4 * n;
                ax[2 * bj + n] = ax[2 * bj + n] * (unpack4(*(const u32x2*)gr) * rcp4(clampg(unpack4(*(const u32x2*)(gr + 2048))))); }
    }
    __device__ __forceinline__ void operator()(EPI_ARGS) const {
        const int colh = wc * 32 + 8 * fq;
#pragma unroll
        for (int ai = 0; ai < 2; ++ai) { u32x4 gs[4][2];
#pragma unroll
            for (int m = 0; m < 4; ++m)
#pragma unroll
                for (int bj = 0; bj < 2; ++bj) gs[m][bj] = *(const u32x4*)(GATES + (size_t)EPI_ROW * 4096 + 2048 + u.pn * 256 + bj * 128 + colh);
#pragma unroll
            for (int m = 0; m < 4; ++m) { const int row = EPI_ROW;
#pragma unroll
                for (int bj = 0; bj < 2; ++bj) { const int col = u.pn * 256 + bj * 128 + colh; f32x4 s0, s1; unpack8(gs[m][bj], s0, s1);
                    *(u32x4*)(MERGED + (size_t)row * 2048 + col) = pack8(acc[ai][bj][m][0] * clampg(s0), acc[ai][bj][m][1] * clampg(s1)); } }
            asm volatile("" ::: "memory"); }
    }
    __device__ __forceinline__ void x(XEPI_ARGS) const { XROW_SETUP
        if (!valid) return;
#pragma unroll
        for (int bj = 0; bj < 2; ++bj) { const int col = u.pn * 256 + bj * 128 + cq; const f32x4 g = clampg(unpack4(*(const u32x2*)(GATES + (size_t)row * 4096 + 2048 + col)));
            *(u32x2*)(MERGED + (size_t)row * 2048 + col) = pack4(ax[bj] * g); }
    }
};
template <bool SRC_BF16> struct EpiRes { static constexpr bool MIDK = false; static constexpr bool FUSED = false;
    const float* xp; const float* xs; const bf16_t* XS; bf16_t* XB; float* rs;
    __device__ __forceinline__ void operator()(EPI_ARGS) const {
        const int colh = wc * 32 + 8 * fq;
#pragma unroll
        for (int ai = 0; ai < 2; ++ai) { f32x4 xr[4][2][2];
#pragma unroll
            for (int m = 0; m < 4; ++m)
#pragma unroll
                for (int bj = 0; bj < 2; ++bj) { const size_t off = (size_t)EPI_ROW * 2048 + u.pn * 256 + bj * 128 + colh;
                    if (SRC_BF16) unpack8(*(const u32x4*)(XS + off), xr[m][bj][0], xr[m][bj][1]); else { xr[m][bj][0] = *(const f32x4*)(xp + off); xr[m][bj][1] = *(const f32x4*)(xp + off + 4); } }
#pragma unroll
            for (int m = 0; m < 4; ++m) { const int row = EPI_ROW; float ss = 0.f;
#pragma unroll
                for (int bj = 0; bj < 2; ++bj) { const int col = u.pn * 256 + bj * 128 + colh;
                    const f32x4 v0 = acc[ai][bj][m][0] + xr[m][bj][0], v1 = acc[ai][bj][m][1] + xr[m][bj][1];
                    *(u32x4*)(XB + (size_t)row * 2048 + col) = pack8(v0, v1); ss += sumsq8(v0, v1); }
                put_rowss(rs, row, u.pn * 4 + wc, ss, fr, fq, true); }
            asm volatile("" ::: "memory"); }
    }
    __device__ __forceinline__ void x(XEPI_ARGS) const { XROW_SETUP
        float ss = 0.f;
        if (valid) {
#pragma unroll
            for (int bj = 0; bj < 2; ++bj) { const int col = u.pn * 256 + bj * 128 + cq;
                const f32x4 xo = SRC_BF16 ? unpack4(*(const u32x2*)(XS + (size_t)row * 2048 + col)) : *(const f32x4*)(xs + (size_t)(row - MPR) * 2048 + col);
                const f32x4 v = ax[bj] + xo; *(u32x2*)(XB + (size_t)row * 2048 + col) = pack4(v); ss += sumsq4(v); } }
        put_rowss(rs, row, u.pn * 8 + wr * 4 + wc, ss, fr, fq, valid);
    }
};
__device__ __forceinline__ float dpp_prev1(float cur, float prevgrp) { const int o = __builtin_amdgcn_update_dpp(0, __float_as_int(prevgrp), 0x121, 0xf, 0xf, false);
    return __int_as_float(__builtin_amdgcn_update_dpp(o, __float_as_int(cur), 0x111, 0xf, 0xf, false)); }
__device__ __forceinline__ float dpp_prev2(float cur, float prevgrp) { const int o = __builtin_amdgcn_update_dpp(0, __float_as_int(prevgrp), 0x122, 0xf, 0xf, false);
    return __int_as_float(__builtin_amdgcn_update_dpp(o, __float_as_int(cur), 0x112, 0xf, 0xf, false)); }
constexpr size_t SA_BLK = (size_t)4 * 6144;
struct EpiUp { static constexpr bool MIDK = false; static constexpr bool FUSED = false;
    const float* rs; bf16_t* VB; float* SA; float* SAS; float* out; const float* WC; const float* BC;
    __device__ __forceinline__ void operator()(const f32x4 (&acc)[2][2][4][2], const Unit& u, int wr, int wc, int fr0, int fq0) const {
        int fr = fr0, fq = fq0; asm volatile("" : "+v"(fr), "+v"(fq));
        const int col = u.pn * 128 + wc * 32 + 8 * fq;
        const f32x4 w0a = *(const f32x4*)(WC + col), w0b = *(const f32x4*)(WC + col + 4), w1a = *(const f32x4*)(WC + 6144 + col), w1b = *(const f32x4*)(WC + 6144 + col + 4);
        const f32x4 w2a = *(const f32x4*)(WC + 12288 + col), w2b = *(const f32x4*)(WC + 12288 + col + 4), bca = *(const f32x4*)(BC + col), bcb = *(const f32x4*)(BC + col + 4);
        bf16_t* vbase = VB + (size_t)(u.pn >> 4) * ((size_t)MPAD * 2048) + (col & 2047);
#pragma unroll
        for (int ai = 0; ai < 2; ++ai) { f32x4 pa0, pa1; float rr[4];
#pragma unroll
            for (int m = 0; m < 4; ++m) rr[m] = rs_rstd_main(rs, EPI_ROW, fr, fq);
            float* sa = SA + (size_t)(4 * u.pm + 2 * ai + wr) * SA_BLK + col;
#pragma unroll
            for (int m = 0; m < 4; ++m) { const int row = EPI_ROW; const float r = rr[m];
                const f32x4 a0 = acc[ai][0][m][0] * r, a1 = acc[ai][0][m][1] * r, v0 = acc[ai][1][m][0] * r, v1 = acc[ai][1][m][1] * r;
                if (m == 0) { pa0 = a0; pa1 = a1; }
                f32x4 o0, o1;
#pragma unroll
                for (int j = 0; j < 4; ++j) {
                    const float c0 = bca[j] + w0a[j] * dpp_prev2(a0[j], pa0[j]) + w1a[j] * dpp_prev1(a0[j], pa0[j]) + w2a[j] * a0[j];
                    const float c1 = bcb[j] + w0b[j] * dpp_prev2(a1[j], pa1[j]) + w1b[j] * dpp_prev1(a1[j], pa1[j]) + w2b[j] * a1[j];
                    o0[j] = gelu_tanh_f(c0) * v0[j]; o1[j] = gelu_tanh_f(c1) * v1[j]; }
                if (m == 0 && fr < 2) { o0 = v0; o1 = v1; float* q = sa + (size_t)fr * 6144; *(f32x4*)q = a0; *(f32x4*)(q + 4) = a1; }
                if (m == 3 && fr >= 14) { float* q = sa + (size_t)(fr - 12) * 6144; *(f32x4*)q = a0; *(f32x4*)(q + 4) = a1;
                    const int t = row & 2047; if (t >= 2046) { float* q2 = out + OFF_CONV_P + ((size_t)((row >> 11) * 2 + (t - 2046))) * 6144 + col; *(f32x4*)q2 = a0; *(f32x4*)(q2 + 4) = a1; } }
                *(u32x4*)(vbase + (size_t)row * 2048) = pack8(o0, o1);
                pa0 = a0; pa1 = a1; }
            asm volatile("" ::: "memory"); }
    }
    __device__ __forceinline__ void x(XEPI_ARGS) const { XROW_SETUP
        const float r = rs_rstd_x(rs, valid ? row : MPR, fr, fq);
        if (!valid) return;
        const int col = u.pn * 128 + cq; const f32x4 av = ax[0] * r, vv = ax[1] * r;
        *(f32x4*)(SAS + (size_t)(row - MPR) * 6144 + col) = av;
        *(u32x2*)(VB + (size_t)(u.pn >> 4) * ((size_t)MPAD * 2048) + (size_t)row * 2048 + (col & 2047)) = pack4(vv);
        *(f32x4*)(out + OFF_CONV_S + ((size_t)(row - MPR) * 2 + 1) * 6144 + col) = av;
    }
};
struct EpiPle { static constexpr bool MIDK = false; static constexpr bool FUSED = false;
    const float* rs2; const bf16_t* P; const bf16_t* X2; float* rs3; bf16_t* wout;
    __device__ __forceinline__ void operator()(EPI_ARGS) const {
        const int colh = wc * 32 + 8 * fq;
#pragma unroll
        for (int ai = 0; ai < 2; ++ai)
#pragma unroll
            for (int mp = 0; mp < 2; ++mp) { u32x4 pt[2][2], xt[2][2]; float rr[2];
#pragma unroll
                for (int mm = 0; mm < 2; ++mm) { const int m = 2 * mp + mm; rr[mm] = rs_rstd_main(rs2, EPI_ROW, fr, fq);
#pragma unroll
                    for (int bj = 0; bj < 2; ++bj) { const int col = u.pn * 256 + bj * 128 + colh; pt[mm][bj] = *(const u32x4*)(P + (size_t)EPI_ROW * 2048 + col);
                        xt[mm][bj] = *(const u32x4*)(X2 + (size_t)EPI_ROW * 2048 + col); } }
#pragma unroll
                for (int mm = 0; mm < 2; ++mm) { const int m = 2 * mp + mm; const int row = EPI_ROW; float ss = 0.f; const float r = rr[mm];
#pragma unroll
                    for (int bj = 0; bj < 2; ++bj) { const int col = u.pn * 256 + bj * 128 + colh; f32x4 p0, p1; unpack8(pt[mm][bj], p0, p1);
                        f32x4 v0, v1; unpack8(xt[mm][bj], v0, v1);
#pragma unroll
                        for (int j = 0; j < 4; ++j) { v0[j] += sigmoid_f(r * acc[ai][bj][m][0][j]) * p0[j]; v1[j] += sigmoid_f(r * acc[ai][bj][m][1][j]) * p1[j]; }
                        *(u32x4*)(wout + (size_t)row * 2048 + col) = pack8(v0, v1); ss += sumsq8(v0, v1); }
                    put_rowss(rs3, row, u.pn * 4 + wc, ss, fr, fq, true); }
                asm volatile("" ::: "memory"); }
    }
    __device__ __forceinline__ void x(XEPI_ARGS) const { XROW_SETUP
        float ss = 0.f; const float r = rs_rstd_x(rs2, valid ? row : MPR, fr, fq);
        if (valid) {
#pragma unroll
            for (int bj = 0; bj < 2; ++bj) { const int col = u.pn * 256 + bj * 128 + cq; const f32x4 p = unpack4(*(const u32x2*)(P + (size_t)row * 2048 + col));
                f32x4 v = unpack4(*(const u32x2*)(X2 + (size_t)row * 2048 + col));
#pragma unroll
                for (int j = 0; j < 4; ++j) v[j] += sigmoid_f(r * ax[bj][j]) * p[j];
                *(u32x2*)(wout + (size_t)row * 2048 + col) = pack4(v); ss += sumsq4(v); } }
        put_rowss(rs3, row, u.pn * 8 + wr * 4 + wc, ss, fr, fq, valid);
    }
};

#define XB_TMO      128
#define XB_XCNT(j)  (256  + 64 * (j))
#define XB_XSUB(j)  (1280 + 64 * (j))
#define XB_XGEN(j)  (2304 + 64 * (j))
#define XB_TOP      3328
#define XB_TOPGEN   3392
#define XB_PANEL(j) (3456 + 64 * (j))
#define XCD_BAR_WORDS 5504
#define XB_SPIN_CAP (1u << 22)
__device__ __forceinline__ unsigned xb_ld(unsigned* p)              { return __hip_atomic_load(p, __ATOMIC_RELAXED, __HIP_MEMORY_SCOPE_AGENT); }
__device__ __forceinline__ unsigned xb_add(unsigned* p, unsigned v) { return __hip_atomic_fetch_add(p, v, __ATOMIC_RELAXED, __HIP_MEMORY_SCOPE_AGENT); }
__device__ __forceinline__ unsigned xb_xcc_id() { return (unsigned)__builtin_amdgcn_s_getreg((3 << 11) | 20) & 0xFu; }
#define XB_SPIN(cond, bar) do { unsigned _sp = 0; while (cond) { __builtin_amdgcn_s_sleep(1); \
    if ((++_sp & 255u) == 0u) { if (xb_ld(&(bar)[XB_TMO])) break; if (_sp > XB_SPIN_CAP) { atomicAdd(&(bar)[XB_TMO], 1u); break; } } } } while (0)
struct XcdBarrier { unsigned* bar; unsigned x; volatile LAS unsigned* st; };
__device__ __forceinline__ void xcd_barrier_complete(unsigned* bar, unsigned x, unsigned G, unsigned& nloc, unsigned& nx) {
    unsigned sum, cnt, mine, sp = 0u;
    for (;;) {
        sum = 0u; cnt = 0u; mine = 0u;
#pragma unroll
        for (unsigned j = 0; j < 16; ++j) { const unsigned c = xb_ld(&bar[XB_XCNT(j)]); sum += c; cnt += (c > 0u) ? 1u : 0u; mine = (j == x) ? c : mine; }
        if (sum == G) break;
        __builtin_amdgcn_s_sleep(1);
        if ((++sp & 255u) == 0u) { if (xb_ld(&bar[XB_TMO])) break; if (sp > XB_SPIN_CAP) { atomicAdd(&bar[XB_TMO], 1u); break; } }
    }
    nloc = mine > 0u ? mine : 1u; nx = cnt > 0u ? cnt : 1u;
}
__device__ __forceinline__ void xcd_barrier(const XcdBarrier& b, bool leader, unsigned G) {
    asm volatile("s_waitcnt vmcnt(0)" ::: "memory");
    __syncthreads();
    if (leader) {
        unsigned* bar = b.bar;
        __builtin_amdgcn_s_waitcnt(0);
        unsigned nloc = b.st[0], nx = b.st[1];
        if (nloc == 0u) { xcd_barrier_complete(bar, b.x, G, nloc, nx); b.st[0] = nloc; b.st[1] = nx; }
        const unsigned old = xb_add(&bar[XB_XSUB(b.x)], 1u);
        const unsigned gen = old / nloc;
        if (old + 1u == (gen + 1u) * nloc) {
            __builtin_amdgcn_fence(__ATOMIC_RELEASE, "agent");
            asm volatile("s_waitcnt vmcnt(0)" ::: "memory");
            const unsigned og = xb_add(&bar[XB_TOP], 1u);
            const unsigned tg = og / nx;
            if (og + 1u == (tg + 1u) * nx) xb_add(&bar[XB_TOPGEN], 1u);
            else XB_SPIN(xb_ld(&bar[XB_TOPGEN]) == tg, bar);
            __builtin_amdgcn_fence(__ATOMIC_ACQUIRE, "agent");
            xb_add(&bar[XB_XGEN(b.x)], 1u);
            asm volatile("s_waitcnt vmcnt(0)" ::: "memory");
        } else {
            XB_SPIN(xb_ld(&bar[XB_XGEN(b.x)]) == gen, bar);
            __builtin_amdgcn_fence(__ATOMIC_ACQUIRE, "agent");
            asm volatile("s_waitcnt vmcnt(0)" ::: "memory");
        }
    }
    __syncthreads();
}

struct EpiPleF { static constexpr bool MIDK = false; static constexpr bool FUSED = true;
    const float* rs2; const bf16_t* P; const bf16_t* X2; float* rs3; float* out; const float* gf; unsigned* bar;
    template <bool XR>
    __device__ __forceinline__ void fused(f32x4 (&acc)[2][2][4][2], f32x4 (&accX)[4], const Unit& u, int wr, int wc, int fr0, int fq0, bool leader) const {
        int fr = fr0, fq = fq0; asm volatile("" : "+v"(fr), "+v"(fq));
        const int colh = wc * 32 + 8 * fq;
#pragma unroll
        for (int ai = 0; ai < 2; ++ai)
#pragma unroll
            for (int mp = 0; mp < 2; ++mp) { u32x4 pt[2][2], xt[2][2]; float rr[2];
#pragma unroll
                for (int mm = 0; mm < 2; ++mm) { const int m = 2 * mp + mm; rr[mm] = rs_rstd_main(rs2, EPI_ROW, fr, fq);
#pragma unroll
                    for (int bj = 0; bj < 2; ++bj) { const int col = u.pn * 256 + bj * 128 + colh; pt[mm][bj] = *(const u32x4*)(P + (size_t)EPI_ROW * 2048 + col);
                        xt[mm][bj] = *(const u32x4*)(X2 + (size_t)EPI_ROW * 2048 + col); } }
#pragma unroll
                for (int mm = 0; mm < 2; ++mm) { const int m = 2 * mp + mm; const int row = EPI_ROW; float ss = 0.f; const float r = rr[mm];
#pragma unroll
                    for (int bj = 0; bj < 2; ++bj) { f32x4 p0, p1; unpack8(pt[mm][bj], p0, p1);
                        f32x4 v0, v1; unpack8(xt[mm][bj], v0, v1);
#pragma unroll
                        for (int j = 0; j < 4; ++j) { v0[j] += sigmoid_f(r * acc[ai][bj][m][0][j]) * p0[j]; v1[j] += sigmoid_f(r * acc[ai][bj][m][1][j]) * p1[j]; }
                        acc[ai][bj][m][0] = v0; acc[ai][bj][m][1] = v1; ss += sumsq8(v0, v1); }
                    put_rowss(rs3, row, u.pn * 4 + wc, ss, fr, fq, true); }
                asm volatile("" ::: "memory"); }
        const bool xvalid = fr < 4; const int xrow = MPR + 4 * u.pm + fr;
        if constexpr (XR) {
#pragma unroll
            for (int n = 0; n < 2; ++n) { float ss = 0.f; const float r = rs_rstd_x(rs2, xvalid ? xrow : MPR, fr, fq);
                if (xvalid) {
#pragma unroll
                    for (int bj = 0; bj < 2; ++bj) { const int col = u.pn * 256 + bj * 128 + wc * 32 + 8 * fq + 4 * n; const f32x4 p = unpack4(*(const u32x2*)(P + (size_t)xrow * 2048 + col));
                        f32x4 v = unpack4(*(const u32x2*)(X2 + (size_t)xrow * 2048 + col));
#pragma unroll
                        for (int j = 0; j < 4; ++j) v[j] += sigmoid_f(r * accX[bj * 2 + n][j]) * p[j];
                        accX[bj * 2 + n] = v; ss += sumsq4(v); } }
                put_rowss(rs3, xrow, u.pn * 8 + n * 4 + wc, ss, fr, fq, xvalid); }
        }
        asm volatile("s_waitcnt vmcnt(0)" ::: "memory");
        __builtin_amdgcn_s_barrier();
        if (leader) {
            __builtin_amdgcn_fence(__ATOMIC_RELEASE, "agent");
            asm volatile("s_waitcnt vmcnt(0)" ::: "memory");
            unsigned* ctr = bar + XB_PANEL(u.pm);
            (void)xb_add(ctr, 1u);
            XB_SPIN(xb_ld(ctr) < 8u, bar);
            __builtin_amdgcn_fence(__ATOMIC_ACQUIRE, "agent");
            asm volatile("s_waitcnt vmcnt(0)" ::: "memory");
        }
        __builtin_amdgcn_s_barrier();
        asm volatile("" ::: "memory");
        { const float* gp = gf + u.pn * 256 + colh;
          const f32x4 g00 = *(const f32x4*)gp, g01 = *(const f32x4*)(gp + 4), g10 = *(const f32x4*)(gp + 128), g11 = *(const f32x4*)(gp + 132);
          EPI_FOR_ROWS { const int row = EPI_ROW; const float r = rs_rstd_main(rs3, row, fr, fq); float* o = out + (size_t)row * 2048 + u.pn * 256 + colh;
              *(f32x4*)o = acc[ai][0][m][0] * r * g00; *(f32x4*)(o + 4) = acc[ai][0][m][1] * r * g01; *(f32x4*)(o + 128) = acc[ai][1][m][0] * r * g10; *(f32x4*)(o + 132) = acc[ai][1][m][1] * r * g11; } }
        if constexpr (XR) {
            const float r = rs_rstd_x(rs3, xvalid ? xrow : MPR, fr, fq);
            if (xvalid) {
#pragma unroll
                for (int n = 0; n < 2; ++n)
#pragma unroll
                    for (int bj = 0; bj < 2; ++bj) { const int col = u.pn * 256 + bj * 128 + wc * 32 + 8 * fq + 4 * n;
                        *(f32x4*)(out + (size_t)xrow * 2048 + col) = accX[bj * 2 + n] * r * *(const f32x4*)(gf + col); } }
        }
    }
};

struct Args { const float* in[33]; float* out; unsigned char* ws; };
enum { I_XP = 0, I_XS, I_CPOOL, I_SRE, I_SIM, I_CCONV, I_PP, I_PS, I_GMIX, I_WIN, I_WPOOL, I_PSCALE, I_LRE, I_LIM, I_LOGDT, I_BRE, I_BIM, I_CRE, I_CIM, I_D,
       I_WGLU, I_WBP, I_WBS, I_WOUT, I_GFFN, I_WUP, I_WCONV, I_BCONV, I_WDOWN, I_GPLE, I_WPG, I_WPLE, I_GFINAL };

__device__ __forceinline__ void transpose_item(const float* W, int K, int N, bf16_t* WT, const float* kscale, LAS float* scr, int item, int lane, int ldw = 0) {
    if (ldw == 0) ldw = K;
    const int nblk = N >> 6, kb = item / nblk, nb = item - kb * nblk, k0 = kb * 64, n0 = nb * 64;
    const int c4 = (lane & 15) * 4, kr = lane >> 4;
    f32x4 v[16];
#pragma unroll
    for (int i = 0; i < 16; ++i) v[i] = __builtin_nontemporal_load((const f32x4*)(W + (size_t)(k0 + 4 * i + kr) * N + n0 + c4));
    if (kscale) {
#pragma unroll
        for (int i = 0; i < 16; ++i) v[i] = v[i] * kscale[k0 + 4 * i + kr]; }
#pragma unroll
    for (int i = 0; i < 16; ++i) { LAS float* s = scr + (4 * i + kr) * 65 + c4; s[0] = v[i][0]; s[1] = v[i][1]; s[2] = v[i][2]; s[3] = v[i][3]; }
    asm volatile("s_waitcnt lgkmcnt(0)" ::: "memory");
    const int c = lane & 7;
#pragma unroll
    for (int j = 0; j < 8; ++j) { const int n = (lane >> 3) + 8 * j; const LAS float* s = scr + (8 * c) * 65 + n;
        u32x4 o; o.x = cvt_pk_bf16(s[0 * 65], s[1 * 65]); o.y = cvt_pk_bf16(s[2 * 65], s[3 * 65]); o.z = cvt_pk_bf16(s[4 * 65], s[5 * 65]); o.w = cvt_pk_bf16(s[6 * 65], s[7 * 65]);
        *(u32x4*)(WT + (size_t)(n0 + n) * ldw + k0 + 8 * c) = o; }
    asm volatile("s_waitcnt lgkmcnt(0)" ::: "memory");
}


constexpr int TI_IN = 32 * 96, TI_LE = 4 * 32, TI_EARLY = TI_IN + TI_LE, TI_PL = 4 * 4 * 4, TI_G = 16 * 32, TI_O = 32 * 32, TI_U = 32 * 192, TI_DN = 96 * 32;
constexpr int TI_ALL = TI_EARLY + TI_PL + 3 * TI_G + TI_O + TI_U + TI_DN + TI_O;
#define TRANSPOSE_ITEMS(first, last) do { for (int it = (first) + gw; it < (last); it += NGW) { int r = it; \
        if (r < TI_IN) { transpose_item(a.in[I_WIN], 2048, 6144, W_IN, nullptr, scr, r, lane); continue; } r -= TI_IN; \
        if (r < TI_LE) { transpose_item(a.in[I_WPLE], 256, 2048, W_PLE, nullptr, scr, r, lane); continue; } r -= TI_LE; \
        if (r < TI_PL) { const int k = r >> 4; transpose_item(a.in[I_WPOOL] + (size_t)k * 65536, 256, 256, W_POOL + (size_t)k * 65536, nullptr, scr, r & 15, lane); continue; } r -= TI_PL; \
        if (r < TI_G) { transpose_item(a.in[I_WGLU], 1024, 2048, W_GLU, nullptr, scr, r, lane); continue; } r -= TI_G; \
        if (r < TI_G) { transpose_item(a.in[I_WBP], 1024, 2048, W_BP, nullptr, scr, r, lane, 2048); continue; } r -= TI_G; \
        if (r < TI_G) { transpose_item(a.in[I_WBS], 1024, 2048, W_BP + 1024, nullptr, scr, r, lane, 2048); continue; } r -= TI_G; \
        if (r < TI_O) { transpose_item(a.in[I_WOUT], 2048, 2048, W_OUT, nullptr, scr, r, lane); continue; } r -= TI_O; \
        if (r < TI_U) { transpose_item(a.in[I_WUP], 2048, 12288, W_UP, a.in[I_GFFN], scr, r, lane); continue; } r -= TI_U; \
        if (r < TI_DN) { const int pnl = r >> 10; transpose_item(a.in[I_WDOWN] + (size_t)pnl * 2048 * 2048, 2048, 2048, W_DOWN + (size_t)pnl * 2048 * 2048, nullptr, scr, r & 1023, lane); continue; } r -= TI_DN; \
        transpose_item(a.in[I_WPG], 2048, 2048, W_PG, a.in[I_GPLE], scr, r, lane); } } while (0)

template <bool FUSE_FINAL>
__global__ void __launch_bounds__(512, 2) fwd_kernel(Args a) {
    extern __shared__ __attribute__((aligned(16))) unsigned char smem[];
    cg::grid_group grid = cg::this_grid();
    LAS unsigned char* lds = (LAS unsigned char*)smem;
    const int G = gridDim.x, bid = blockIdx.x;
    const int wave_s = __builtin_amdgcn_readfirstlane((int)(threadIdx.x >> 6));
#define GRID_SYNC() do { const bool _ld = (wave_s == 0) && (lane_id() == 0); xcd_barrier(xbar, _ld, (unsigned)G); } while (0)
#define FRESH_IDS const int lane = lane_id(); const int wave = wave_s, tid = wave * 64 + lane; (void)tid;
    unsigned char* ws = a.ws; float* out = a.out;
    bf16_t* W_UP = (bf16_t*)(ws + WS_WUP); bf16_t* W_DOWN = (bf16_t*)(ws + WS_WDOWN); bf16_t* W_PG = (bf16_t*)(ws + WS_WPG); bf16_t* W_PLE = (bf16_t*)(ws + WS_WPLE);
    bf16_t* W_OUT = (bf16_t*)(ws + WS_WOUT); bf16_t* W_IN = (bf16_t*)(ws + WS_WIN); bf16_t* W_GLU = (bf16_t*)(ws + WS_WGLU); bf16_t* W_BP = (bf16_t*)(ws + WS_WBP);
    bf16_t* W_BS = (bf16_t*)(ws + WS_WBS); bf16_t* W_POOL = (bf16_t*)(ws + WS_WPOOL);
    bf16_t* Hb = (bf16_t*)(ws + WS_H); bf16_t* PBb = (bf16_t*)(ws + WS_PB); bf16_t* Pb = (bf16_t*)(ws + WS_P);
    bf16_t* Ub = (bf16_t*)(ws + WS_U); bf16_t* GATES = (bf16_t*)(ws + WS_GATES);
    f32x2* ABAR = (f32x2*)(ws + WS_U + 44 * MiB); f32x2* A16T = ABAR + 4096; f32x2* BBAR = ABAR + 8192;
    bf16_t* Ussm = (bf16_t*)(ws + WS_U + 20 * MiB); bf16_t* Usam = (bf16_t*)(ws + WS_U + 40 * MiB);
    bf16_t* DIFF = (bf16_t*)(ws + WS_DIFF); bf16_t* SSMACT = (bf16_t*)(ws + WS_SSMACT); bf16_t* YCAT = (bf16_t*)(ws + WS_YCAT);
 bf16_t* MERGED = (bf16_t*)(ws + WS_MERGED); bf16_t* X1B = (bf16_t*)(ws + WS_X1B);
    float* SAb = (float*)(ws + WS_ABUF + 40 * MiB);
    bf16_t* VBUF = (bf16_t*)(ws + WS_VBUF); bf16_t* X2B = (bf16_t*)(ws + WS_X2B);
    float* RS1 = (float*)(ws + WS_ROWSS); float* RS2 = RS1 + (size_t)MPAD * RS_SLOTS; float* RS3 = RS2 + (size_t)MPAD * RS_SLOTS;

    XcdBarrier xbar; xbar.bar = (unsigned*)(ws + WS_CTL); xbar.st = (volatile LAS unsigned*)(lds + LDS_BYTES - 16);
    { const int t0 = threadIdx.x; if (t0 < 2) xbar.st[t0] = 0u;
      if (gridDim.y == 0x7fffu) grid.sync();
      xbar.x = xb_xcc_id(); if (t0 == 0) (void)xb_add(&xbar.bar[XB_XCNT(xbar.x)], 1u); }
    {
    {
        FRESH_IDS
        const int gtid = bid * 512 + tid, GT = G * 512;
        if (bid < 256) {
            const int g = bid >> 2, q = bid & 3;
            LAS float* La = (LAS float*)lds;
            LAS float* Lap = (LAS float*)(lds + 512);
            LAS float* Lbb = (LAS float*)(lds + 9216);
            LAS float* Lcc = (LAS float*)(lds + 17408);
            bf16_t* PM = (bf16_t*)(ws + WS_PM) + (size_t)g * 128 * 256; bf16_t* QM = (bf16_t*)(ws + WS_QM) + (size_t)g * 256 * 128; bf16_t* KT = (bf16_t*)(ws + WS_KT) + (size_t)g * 4096;
            if (tid < 64) { const int p = tid;
                const float dt = expf(a.in[I_LOGDT][g]), lr = a.in[I_LRE][g * 64 + p], li = a.in[I_LIM][g * 64 + p];
                const float mag = expf(lr * dt), ar = mag * cosf(li * dt), ai = mag * sinf(li * dt);
                const float nr = ar - 1.0f, ni = ai, den = lr * lr + li * li, cr = (nr * lr + ni * li) / den, ci = (ni * lr - nr * li) / den;
                La[p * 2] = ar; La[p * 2 + 1] = ai;
                float wr_ = 1.f, wi_ = 0.f;
                for (int d = 0; d <= 16; ++d) { Lap[(d * 64 + p) * 2] = wr_; Lap[(d * 64 + p) * 2 + 1] = wi_; const float tr = wr_ * ar - wi_ * ai, ti = wr_ * ai + wi_ * ar; wr_ = tr; wi_ = ti; }
                for (int h = 0; h < 16; ++h) { const float br = a.in[I_BRE][(size_t)(g * 64 + p) * 16 + h], bi = a.in[I_BIM][(size_t)(g * 64 + p) * 16 + h];
                    Lbb[(p * 16 + h) * 2] = cr * br - ci * bi; Lbb[(p * 16 + h) * 2 + 1] = cr * bi + ci * br; } }
            for (int i = tid; i < 1024; i += 512) { Lcc[i * 2] = a.in[I_CRE][(size_t)g * 1024 + i]; Lcc[i * 2 + 1] = a.in[I_CIM][(size_t)g * 1024 + i]; }
            __syncthreads();
            if (q == 0) {
                if (tid < 64) { ABAR[g * 64 + tid] = *(const LAS f32x2*)(La + tid * 2); A16T[g * 64 + tid] = *(const LAS f32x2*)(Lap + (16 * 64 + tid) * 2); }
                for (int i = tid; i < 1024; i += 512) BBAR[(size_t)g * 1024 + i] = *(const LAS f32x2*)(Lbb + i * 2); }
            if (tid < 256) {
                const int hp = tid >> 4, h = tid & 15; float acc0 = 0.f, acc1 = 0.f, acc2 = 0.f, acc3 = 0.f;
                for (int p = 0; p < 64; ++p) { const f32x2 c = *(const LAS f32x2*)(Lcc + (hp * 64 + p) * 2), b = *(const LAS f32x2*)(Lbb + (p * 16 + h) * 2), w = *(const LAS f32x2*)(Lap + (4 * q * 64 + p) * 2), av = *(const LAS f32x2*)(La + p * 2);
                    const float mr = c[0] * b[0] - c[1] * b[1], mi = c[0] * b[1] + c[1] * b[0];
                    float zr = mr * w[0] - mi * w[1], zi = mr * w[1] + mi * w[0]; float t_;
                    acc0 += zr; t_ = zr * av[0] - zi * av[1]; zi = zr * av[1] + zi * av[0]; zr = t_;
                    acc1 += zr; t_ = zr * av[0] - zi * av[1]; zi = zr * av[1] + zi * av[0]; zr = t_;
                    acc2 += zr; t_ = zr * av[0] - zi * av[1]; zi = zr * av[1] + zi * av[0]; zr = t_;
                    acc3 += zr; }
                if (q == 0 && h == hp) acc0 += a.in[I_D][g * 16 + hp];
                bf16_t* k = KT + (size_t)(4 * q) * 256 + hp * 16 + h;
                k[0] = (bf16_t)(cvt_pk_bf16(acc0, 0.f) & 0xffffu); k[256] = (bf16_t)(cvt_pk_bf16(acc1, 0.f) & 0xffffu); k[512] = (bf16_t)(cvt_pk_bf16(acc2, 0.f) & 0xffffu); k[768] = (bf16_t)(cvt_pk_bf16(acc3, 0.f) & 0xffffu);
            }
            {
                const int pr = 32 * q + (tid >> 4), h = tid & 15, part = pr >> 6, p = pr & 63;
                const f32x2 b = *(const LAS f32x2*)(Lbb + (p * 16 + h) * 2);
                for (int s_ = 0; s_ < 16; ++s_) { const f32x2 w = *(const LAS f32x2*)(Lap + ((15 - s_) * 64 + p) * 2);
                    const float v = part ? (w[0] * b[1] + w[1] * b[0]) : (w[0] * b[0] - w[1] * b[1]);
                    PM[(size_t)pr * 256 + s_ * 16 + h] = (bf16_t)(cvt_pk_bf16(v, 0.f) & 0xffffu); } }
            {
                const int rloc = tid >> 3, tq = 4 * q + (rloc >> 4), hp = rloc & 15, pg = tid & 7; float vr[8], vi[8];
#pragma unroll
                for (int e = 0; e < 8; ++e) { const int p = pg * 8 + e; const f32x2 c = *(const LAS f32x2*)(Lcc + (hp * 64 + p) * 2), w = *(const LAS f32x2*)(Lap + ((tq + 1) * 64 + p) * 2);
                    vr[e] = c[0] * w[0] - c[1] * w[1]; vi[e] = -(c[0] * w[1] + c[1] * w[0]); }
                bf16_t* qrow = QM + (size_t)(tq * 16 + hp) * 128 + pg * 8;
                *(u32x4*)qrow = pack8((f32x4){vr[0], vr[1], vr[2], vr[3]}, (f32x4){vr[4], vr[5], vr[6], vr[7]});
                *(u32x4*)(qrow + 64) = pack8((f32x4){vi[0], vi[1], vi[2], vi[3]}, (f32x4){vi[4], vi[5], vi[6], vi[7]}); }
            __syncthreads();
        }
        LAS float* scr = (LAS float*)(lds + wave * 16640);
        const int gw = bid * 8 + wave, NGW = G * 8;
        TRANSPOSE_ITEMS(0, TI_EARLY);
        for (int row = gw; row < MPAD; row += NGW) {
            u32x2* o = (u32x2*)(Hb + (size_t)row * 2048) + lane;
            if (row < MT) {
                const float* xr = row < MPR ? a.in[I_XP] + (size_t)row * 2048 : a.in[I_XS] + (size_t)(row - MPR) * 2048;
                f32x4 v[8]; float s = 0.f;
#pragma unroll
                for (int j = 0; j < 8; ++j) { v[j] = *((const f32x4*)xr + lane + 64 * j); s += (v[j][0] * v[j][0] + v[j][1] * v[j][1]) + (v[j][2] * v[j][2] + v[j][3] * v[j][3]); }
                const float r = rsqrtf(wave_sum(s, lane) * (1.0f / 2048.0f) + EPS);
#pragma unroll
                for (int j = 0; j < 8; ++j) { const f32x4 gm = *((const f32x4*)a.in[I_GMIX] + lane + 64 * j); const f32x4 y = v[j] * r * gm; u32x2 w; w.x = cvt_pk_bf16(y[0], y[1]); w.y = cvt_pk_bf16(y[2], y[3]); o[64 * j] = w; }
            } else {
#pragma unroll
                for (int j = 0; j < 8; ++j) o[64 * j] = (u32x2){0u, 0u};
            }
        }
        for (int i = gtid; i < MPAD * 64; i += GT) { const int row = i >> 6, c4 = (i & 63) * 4; u32x2 w = (u32x2){0u, 0u};
            if (row < MT) { const float* pr = row < MPR ? a.in[I_PP] + (size_t)row * 256 : a.in[I_PS] + (size_t)(row - MPR) * 256; const f32x4 v = *(const f32x4*)(pr + c4); w.x = cvt_pk_bf16(v[0], v[1]); w.y = cvt_pk_bf16(v[2], v[3]); }
            *(u32x2*)(PBb + (size_t)row * 256 + c4) = w; }
    }
    GRID_SYNC();
    }

    {
    { pg8::Gemm g{Hb, W_IN, 2048, 2048, 2048, 32, 24, 0, 128, 256}; EpiZ E{Ub, Ussm, Usam, GATES, out}; pg8::gemm_phase(lds, g, G, bid, wave_s, E); }
    { pg8::Gemm g{PBb, W_PLE, 256, 256, 256, 32, 8, 0, 128, 256}; EpiBf E{Pb, 2048, nullptr}; pg8::gemm_phase(lds, g, G, bid, wave_s, E); }
    GRID_SYNC();
    }

    {
    {
        FRESH_IDS
#define POOL_LOADS(W, tile_, raw) do { const int r0_ = (tile_) * 16, t0_ = r0_ & 2047; const bf16_t* up_ = Ub + (size_t)r0_ * 1024 + c; \
            _Pragma("unroll") for (int j = 0; j < 15 + W; ++j) { const int dr = j - (W - 1); unsigned w_ = 0u; if (t0_ + dr >= 0) w_ = *(const unsigned*)(up_ + (long)dr * 1024); raw[j] = w_; } } while (0)
#define POOL_COMP(W, tile_, raw) do { const int r0_ = (tile_) * 16, t0_ = r0_ & 2047; f32x2 v[15 + W]; \
            _Pragma("unroll") for (int j = 0; j < 15 + W; ++j) v[j] = (f32x2){bf_lo(raw[j]), bf_hi(raw[j])}; \
            f32x2 sum = (f32x2){0.f, 0.f}; _Pragma("unroll") for (int j = 0; j < W - 1; ++j) sum += v[j]; \
            _Pragma("unroll") for (int i = 0; i < 16; ++i) { const int t = t0_ + i; const f32x2 cur = v[W - 1 + i]; sum += cur; \
                const float inv = 1.0f / (float)((t + 1) < W ? (t + 1) : W); const f32x2 d = sum * inv - cur; \
                *(unsigned*)(DIFF + (size_t)(r0_ + i) * 1024 + c) = cvt_pk_bf16(d[0], d[1]); sum -= v[i]; } } while (0)
#define POOL_ALL(W) do { \
            const bool has_s = bid < 128; const int ns = has_s ? bid : 0; f32x2 cr[15]; unsigned wc_ = 0u; \
            { const float* cp = a.in[I_CPOOL] + (size_t)ns * 15 * 1024 + c; \
              _Pragma("unroll") for (int j = 0; j < 15; ++j) cr[j] = has_s ? *(const f32x2*)(cp + (size_t)j * 1024) : (f32x2){0.f, 0.f}; \
              if (has_s) wc_ = *(const unsigned*)(Ub + (size_t)(MPR + ns) * 1024 + c); } \
            for (int tA = bid; tA < 512; tA += 2 * G) { const int tB = tA + G; const bool hasB = tB < 512; unsigned rawA[15 + W], rawB[15 + W]; \
                POOL_LOADS(W, tA, rawA); POOL_LOADS(W, hasB ? tB : tA, rawB); \
                POOL_COMP(W, tA, rawA); if (hasB) POOL_COMP(W, tB, rawB); } \
            if (has_s) { const f32x2 cur = (f32x2){bf_lo(wc_), bf_hi(wc_)}; f32x2 sum = cur; \
                _Pragma("unroll") for (int j = 16 - W; j <= 14; ++j) sum += cr[j]; \
                const f32x2 d = sum * (1.0f / (float)W) - cur; \
                *(unsigned*)(DIFF + (size_t)(MPR + ns) * 1024 + c) = cvt_pk_bf16(d[0], d[1]); \
                float* po = out + OFF_POOL_S + (size_t)ns * 15 * 1024 + c; \
                _Pragma("unroll") for (int j = 0; j < 14; ++j) *(f32x2*)(po + (size_t)j * 1024) = cr[j + 1]; } \
            for (int ns2 = bid + G; ns2 < 128; ns2 += G) {   \
                const float* cp = a.in[I_CPOOL] + (size_t)ns2 * 15 * 1024 + c; f32x2 c2[15]; \
                _Pragma("unroll") for (int j = 0; j < 15; ++j) c2[j] = *(const f32x2*)(cp + (size_t)j * 1024); \
                const unsigned w2 = *(const unsigned*)(Ub + (size_t)(MPR + ns2) * 1024 + c); const f32x2 cur = (f32x2){bf_lo(w2), bf_hi(w2)}; f32x2 sum = cur; \
                _Pragma("unroll") for (int j = 16 - W; j <= 14; ++j) sum += c2[j]; \
                const f32x2 d = sum * (1.0f / (float)W) - cur; \
                *(unsigned*)(DIFF + (size_t)(MPR + ns2) * 1024 + c) = cvt_pk_bf16(d[0], d[1]); \
                float* po = out + OFF_POOL_S + (size_t)ns2 * 15 * 1024 + c; \
                _Pragma("unroll") for (int j = 0; j < 14; ++j) *(f32x2*)(po + (size_t)j * 1024) = c2[j + 1]; } \
            } while (0)
        const bool conv_first = ((bid >> 3) & 1) != 0;
        if (conv_first) { const int lane = lane_id(); LAS float* scr = (LAS float*)(lds + wave * 16640); const int gw = bid * 8 + wave, NGW = G * 8; TRANSPOSE_ITEMS(TI_EARLY, TI_ALL); }
        __syncthreads();
        { const int c = 2 * tid, wsel = wave >> 1;
          if (wsel == 0) POOL_ALL(2); else if (wsel == 1) POOL_ALL(4); else if (wsel == 2) POOL_ALL(8); else POOL_ALL(16); }
#undef POOL_ALL
#undef POOL_COMP
#undef POOL_LOADS
        LAS float* Hl = (LAS float*)(lds + 131072) + wave * 512;
        const float* LRE = a.in[I_LRE]; const float* LIM = a.in[I_LIM]; const float* LOGDT = a.in[I_LOGDT];
        typedef float f32x16 __attribute__((ext_vector_type(16)));
        constexpr int UROW = 528;
        LAS unsigned char* UL = lds;
        LAS unsigned char* SL = lds + 128 * UROW;
        LAS unsigned char* KL = lds + 256 * UROW;
        for (int item = bid; item < 256; item += G) {
            const int n = item >> 6, g = item & 63;
            const bf16_t* PM = (const bf16_t*)(ws + WS_PM) + (size_t)g * 128 * 256; const bf16_t* QM = (const bf16_t*)(ws + WS_QM) + (size_t)g * 256 * 128; const bf16_t* KT = (const bf16_t*)(ws + WS_KT) + (size_t)g * 4096;
            const int li_ = lane & 31, kq = lane >> 5;
            u32x4 ut[8];
#pragma unroll
            for (int i = 0; i < 8; ++i) ut[i] = *((const u32x4*)(Ussm + (size_t)item * 2048 * 16) + tid + 512 * i);
            const u32x4 ktv = *(const u32x4*)(KT + tid * 8);
            bf16x8 pmf[16], qmf[8];
            { const bf16_t* pa = PM + (size_t)(32 * (wave & 3) + li_) * 256 + 8 * kq;
#pragma unroll
              for (int ks = 0; ks < 16; ++ks) pmf[ks] = *(const bf16x8*)(pa + 16 * ks); }
            float a16r = 0.f, a16i = 0.f;
            if (wave == 0) { const f32x2 a16 = A16T[g * 64 + lane]; a16r = a16[0]; a16i = a16[1]; }
            __syncthreads();
#pragma unroll
            for (int i = 0; i < 8; ++i) { const int idx = tid + 512 * i; *(LAS u32x4*)(UL + (idx >> 5) * UROW + (idx & 31) * 16) = ut[i]; }
            *(LAS u32x4*)(KL + tid * 16) = ktv;
            __syncthreads();
            {
                const int rb = wave & 3, cbp = wave >> 2; f32x16 s0, s1;
#pragma unroll
                for (int r = 0; r < 16; ++r) { s0[r] = 0.f; s1[r] = 0.f; }
                const LAS unsigned char* ub0 = UL + (64 * cbp + li_) * UROW + 16 * kq, * ub1 = ub0 + 32 * UROW;
#pragma unroll
                for (int ks = 0; ks < 16; ++ks) { const bf16x8 af = pmf[ks];
                    s0 = __builtin_amdgcn_mfma_f32_32x32x16_bf16(af, *(const LAS bf16x8*)(ub0 + 32 * ks), s0, 0, 0, 0);
                    s1 = __builtin_amdgcn_mfma_f32_32x32x16_bf16(af, *(const LAS bf16x8*)(ub1 + 32 * ks), s1, 0, 0, 0); }
                LAS unsigned char* sr0 = SL + (64 * cbp + li_) * UROW + (32 * rb + 4 * kq) * 4, * sr1 = sr0 + 32 * UROW;
#pragma unroll
                for (int rq = 0; rq < 4; ++rq) { *(LAS f32x4*)(sr0 + rq * 32) = (f32x4){s0[4 * rq], s0[4 * rq + 1], s0[4 * rq + 2], s0[4 * rq + 3]};
                                                 *(LAS f32x4*)(sr1 + rq * 32) = (f32x4){s1[4 * rq], s1[4 * rq + 1], s1[4 * rq + 2], s1[4 * rq + 3]}; }
            }
            { const bf16_t* qa = QM + (size_t)(32 * wave + li_) * 128 + 8 * kq;
#pragma unroll
              for (int kc = 0; kc < 8; ++kc) qmf[kc] = *(const bf16x8*)(qa + 16 * kc); }
            __syncthreads();
            if (wave == 0) {
                const int p = lane;
                float hr = 0.f, hi = 0.f;
#pragma unroll 8
                for (int c = 0; c < 128; ++c) { LAS unsigned char* row = SL + c * UROW;
                    const float sr = *(const LAS float*)(row + p * 4), si = *(const LAS float*)(row + 256 + p * 4);
                    const unsigned hb = cvt_pk_bf16(hr, hi);
                    *(LAS bf16_t*)(row + p * 2) = (bf16_t)(hb & 0xffffu); *(LAS bf16_t*)(row + 128 + p * 2) = (bf16_t)(hb >> 16);
                    const float nhr = a16r * hr - a16i * hi + sr, nhi = a16r * hi + a16i * hr + si; hr = nhr; hi = nhi; }
                out[OFF_RE_P + (size_t)(n * 64 + g) * 64 + p] = hr; out[OFF_IM_P + (size_t)(n * 64 + g) * 64 + p] = hi;
            }
            __syncthreads();
            {
                f32x16 y0, y1, y2, y3;
#pragma unroll
                for (int r = 0; r < 16; ++r) { y0[r] = 0.f; y1[r] = 0.f; y2[r] = 0.f; y3[r] = 0.f; }
                const int tq = 2 * wave + (li_ >> 4), hp = li_ & 15;
                const LAS unsigned char* ub = UL + li_ * UROW + 16 * kq;
                for (int ks = 0; ks <= 2 * wave + 1; ++ks) { const int d = tq - ks;
                    bf16x8 af = (bf16x8){0, 0, 0, 0, 0, 0, 0, 0}; if (d >= 0) af = *(const LAS bf16x8*)(KL + ((d * 16 + hp) * 16 + 8 * kq) * 2);
                    y0 = __builtin_amdgcn_mfma_f32_32x32x16_bf16(af, *(const LAS bf16x8*)(ub + 32 * ks), y0, 0, 0, 0);
                    y1 = __builtin_amdgcn_mfma_f32_32x32x16_bf16(af, *(const LAS bf16x8*)(ub + 32 * UROW + 32 * ks), y1, 0, 0, 0);
                    y2 = __builtin_amdgcn_mfma_f32_32x32x16_bf16(af, *(const LAS bf16x8*)(ub + 64 * UROW + 32 * ks), y2, 0, 0, 0);
                    y3 = __builtin_amdgcn_mfma_f32_32x32x16_bf16(af, *(const LAS bf16x8*)(ub + 96 * UROW + 32 * ks), y3, 0, 0, 0); }
                const LAS unsigned char* hb = SL + li_ * UROW + 16 * kq;
#pragma unroll
                for (int kc = 0; kc < 8; ++kc) { const bf16x8 af = qmf[kc];
                    y0 = __builtin_amdgcn_mfma_f32_32x32x16_bf16(af, *(const LAS bf16x8*)(hb + 32 * kc), y0, 0, 0, 0);
                    y1 = __builtin_amdgcn_mfma_f32_32x32x16_bf16(af, *(const LAS bf16x8*)(hb + 32 * UROW + 32 * kc), y1, 0, 0, 0);
                    y2 = __builtin_amdgcn_mfma_f32_32x32x16_bf16(af, *(const LAS bf16x8*)(hb + 64 * UROW + 32 * kc), y2, 0, 0, 0);
                    y3 = __builtin_amdgcn_mfma_f32_32x32x16_bf16(af, *(const LAS bf16x8*)(hb + 96 * UROW + 32 * kc), y3, 0, 0, 0); }
#define SSM_STORE(yv, cb) do { _Pragma("unroll") for (int rq = 0; rq < 4; ++rq) { f32x4 v = (f32x4){yv[4 * rq], yv[4 * rq + 1], yv[4 * rq + 2], yv[4 * rq + 3]}; \
                    _Pragma("unroll") for (int j = 0; j < 4; ++j) v[j] = gelu_tanh_f(v[j]); \
                    const int tok = 16 * (32 * (cb) + li_) + 2 * wave + (rq >> 1); \
                    *(u32x2*)(SSMACT + (size_t)(n * 2048 + tok) * 1024 + g * 16 + 8 * (rq & 1) + 4 * kq) = pack4(v); } } while (0)
                SSM_STORE(y0, 0); SSM_STORE(y1, 1); SSM_STORE(y2, 2); SSM_STORE(y3, 3);
#undef SSM_STORE
            }
        }
        __syncthreads();
        {
            const int lane = lane_id();
            const int gwv = bid * 8 + wave, g = gwv & 63, ns0 = (gwv >> 6) * 4, p = lane;
            if (gwv < 2048) {
                const f32x2 av = ABAR[g * 64 + p]; const float ar = av[0], ai = av[1];
                float Br[16], Bi[16];
#pragma unroll
                for (int q = 0; q < 8; ++q) { const f32x4 b = *((const f32x4*)(BBAR + (size_t)(g * 64 + p) * 16) + q); Br[2 * q] = b[0]; Bi[2 * q] = b[1]; Br[2 * q + 1] = b[2]; Bi[2 * q + 1] = b[3]; }
                const int hp = lane & 15, pq = lane >> 4;
                f32x4 Cr[4], Ci[4];
#pragma unroll
                for (int q = 0; q < 4; ++q) { Cr[q] = *(const f32x4*)(a.in[I_CRE] + (size_t)(g * 16 + hp) * 64 + pq * 16 + q * 4); Ci[q] = *(const f32x4*)(a.in[I_CIM] + (size_t)(g * 16 + hp) * 64 + pq * 16 + q * 4); }
                const float dsk = a.in[I_D][g * 16 + hp];
#pragma unroll
                for (int k = 0; k < 4; ++k) { const int ns = ns0 + k;
                    const bf16_t* ur = Usam + (size_t)ns * 1024 + g * 16; float bur = 0.f, bui = 0.f;
#pragma unroll
                    for (int q = 0; q < 4; ++q) { const f32x4 uv = unpack4(*(const u32x2*)(ur + q * 4));
#pragma unroll
                        for (int jj = 0; jj < 4; ++jj) { bur += Br[q * 4 + jj] * uv[jj]; bui += Bi[q * 4 + jj] * uv[jj]; } }
                    const float h0r = a.in[I_SRE][(size_t)(ns * 64 + g) * 64 + p], h0i = a.in[I_SIM][(size_t)(ns * 64 + g) * 64 + p];
                    const float hr = ar * h0r - ai * h0i + bur, hi = ar * h0i + ai * h0r + bui;
                    out[OFF_RE_S + (size_t)(ns * 64 + g) * 64 + p] = hr; out[OFF_IM_S + (size_t)(ns * 64 + g) * 64 + p] = hi;
                    *(LAS f32x2*)(Hl + k * 128 + p * 2) = (f32x2){hr, hi};
                    float y = 0.f;
#pragma unroll
                    for (int q = 0; q < 4; ++q)
#pragma unroll
                        for (int jj = 0; jj < 4; ++jj) { const f32x2 hv = *(const LAS f32x2*)(Hl + k * 128 + (pq * 16 + q * 4 + jj) * 2); y += Cr[q][jj] * hv[0] - Ci[q][jj] * hv[1]; }
                    y += shfl_xor_f(y, lane, 16); y += shfl_xor_f(y, lane, 32);
                    if (pq == 0) { y = gelu_tanh_f(y + dsk * bf_lo((unsigned)ur[hp])); SSMACT[(size_t)(MPR + ns) * 1024 + g * 16 + hp] = (bf16_t)(cvt_pk_bf16(y, 0.f) & 0xffffu); }
                }
            }
        }
        __syncthreads();
        if (!conv_first) { const int lane = lane_id(); LAS float* scr = (LAS float*)(lds + wave * 16640); const int gw = bid * 8 + wave, NGW = G * 8; TRANSPOSE_ITEMS(TI_EARLY, TI_ALL); }
}
    GRID_SYNC();
    }

    {
    { pg8::Gemm g{DIFF, W_POOL, 1024, 256, 256, 32, 4, 256, 128, 256}; EpiBf E{YCAT, 2048, a.in[I_PSCALE]}; pg8::gemm_phase(lds, g, G, bid, wave_s, E); }
    { pg8::Gemm g{SSMACT, W_GLU, 1024, 1024, 1024, 32, 8, 0, 1024, 128}; EpiGlu E{YCAT, 2048, 1024}; pg8::gemm_phase(lds, g, G, bid, wave_s, E); }
    GRID_SYNC();
    }

    {
    { pg8::Gemm g{YCAT, W_BP, 2048, 2048, 2048, 32, 8, 0, 128, 256}; EpiMerge E{GATES, MERGED}; pg8::gemm_phase(lds, g, G, bid, wave_s, E); }
    GRID_SYNC();
    }

    {
    { pg8::Gemm g{MERGED, W_OUT, 2048, 2048, 2048, 32, 8, 0, 128, 256}; EpiRes<false> E{a.in[I_XP], a.in[I_XS], nullptr, X1B, RS1}; pg8::gemm_phase(lds, g, G, bid, wave_s, E); }
    GRID_SYNC();
    }

    {
    { pg8::Gemm g{X1B, W_UP, 2048, 2048, 2048, 32, 48, 0, 6144, 128}; EpiUp E{RS1, VBUF, SAb, SAb + 128 * SA_BLK, out, a.in[I_WCONV], a.in[I_BCONV]}; pg8::gemm_phase(lds, g, G, bid, wave_s, E); }
    GRID_SYNC();
    }

    {
    {
        FRESH_IDS
        const float* WC = a.in[I_WCONV]; const float* BC = a.in[I_BCONV]; const float* CC = a.in[I_CCONV]; const float* SAS = SAb + 128 * SA_BLK;
        for (int id = bid * 512 + tid; id < (256 + 128) * 768; id += G * 512) {
            const int ri = id / 768, c0 = (id - ri * 768) * 8;
            const f32x4 w0a = *(const f32x4*)(WC + c0), w0b = *(const f32x4*)(WC + c0 + 4), w1a = *(const f32x4*)(WC + 6144 + c0), w1b = *(const f32x4*)(WC + 6144 + c0 + 4);
            const f32x4 w2a = *(const f32x4*)(WC + 12288 + c0), w2b = *(const f32x4*)(WC + 12288 + c0 + 4), bca = *(const f32x4*)(BC + c0), bcb = *(const f32x4*)(BC + c0 + 4);
            const f32x4 z4 = (f32x4){0.f, 0.f, 0.f, 0.f};
            f32x4 a0, a1, m1a = z4, m1b = z4, m2a = z4, m2b = z4; int row;
            if (ri < 256) { const int blk = ri >> 1, j = ri & 1; row = 64 * blk + j; const bool first = (blk & 31) == 0;
                const float* sb = SAb + (size_t)blk * SA_BLK + c0; a0 = *(const f32x4*)(sb + (size_t)j * 6144); a1 = *(const f32x4*)(sb + (size_t)j * 6144 + 4);
                const float* sp = sb - SA_BLK;
                if (j == 0) { if (!first) { m1a = *(const f32x4*)(sp + 3 * 6144); m1b = *(const f32x4*)(sp + 3 * 6144 + 4); m2a = *(const f32x4*)(sp + 2 * 6144); m2b = *(const f32x4*)(sp + 2 * 6144 + 4); } }
                else { m1a = *(const f32x4*)sb; m1b = *(const f32x4*)(sb + 4); if (!first) { m2a = *(const f32x4*)(sp + 3 * 6144); m2b = *(const f32x4*)(sp + 3 * 6144 + 4); } }
            } else { const int ns = ri - 256; row = MPR + ns; const float* c = CC + (size_t)ns * 2 * 6144 + c0;
                m2a = *(const f32x4*)c; m2b = *(const f32x4*)(c + 4); m1a = *(const f32x4*)(c + 6144); m1b = *(const f32x4*)(c + 6144 + 4);
                a0 = *(const f32x4*)(SAS + (size_t)ns * 6144 + c0); a1 = *(const f32x4*)(SAS + (size_t)ns * 6144 + c0 + 4);
                float* q = out + OFF_CONV_S + (size_t)ns * 2 * 6144 + c0; *(f32x4*)q = m1a; *(f32x4*)(q + 4) = m1b; }
            bf16_t* vp = VBUF + (size_t)(c0 >> 11) * ((size_t)MPAD * 2048) + (size_t)row * 2048 + (c0 & 2047); f32x4 v0, v1; unpack8(*(const u32x4*)vp, v0, v1);
            f32x4 ca = bca + w0a * m2a + w1a * m1a + w2a * a0, cb = bcb + w0b * m2b + w1b * m1b + w2b * a1;
#pragma unroll
            for (int j = 0; j < 4; ++j) { ca[j] = gelu_tanh_f(ca[j]) * v0[j]; cb[j] = gelu_tanh_f(cb[j]) * v1[j]; }
            *(u32x4*)vp = pack8(ca, cb);
        }
    }
    GRID_SYNC();
    }

    {
    { pg8::Gemm g{VBUF, W_DOWN, 2048, 2048, 6144, 32, 8, 0, 128, 256, 5, (unsigned)((size_t)MPAD * 2048 * 2), (unsigned)(2048u * 2048u * 2u)}; EpiRes<true> E{nullptr, nullptr, X1B, X2B, RS2}; pg8::gemm_phase(lds, g, G, bid, wave_s, E); }
    GRID_SYNC();
    }

    if constexpr (FUSE_FINAL) {
    { pg8::Gemm g{X2B, W_PG, 2048, 2048, 2048, 32, 8, 0, 128, 256}; EpiPleF E{RS2, Pb, X2B, RS3, out, a.in[I_GFINAL], xbar.bar}; pg8::gemm_phase(lds, g, G, bid, wave_s, E); }
    } else {
    {
    { pg8::Gemm g{X2B, W_PG, 2048, 2048, 2048, 32, 8, 0, 128, 256}; EpiPle E{RS2, Pb, X2B, RS3, X1B}; pg8::gemm_phase(lds, g, G, bid, wave_s, E); }
    GRID_SYNC();
    }
    { FRESH_IDS
    for (int row = bid * 8 + wave; row < MT; row += G * 8) {
        const float r = rsqrtf(wave_sum((row < MPR && lane >= 32) ? 0.f : RS3[(size_t)row * RS_SLOTS + lane], lane) * (1.0f / (float)DM) + EPS);
        const u32x4* xi = (const u32x4*)(X1B + (size_t)row * 2048) + lane; f32x4* o = (f32x4*)(out + (size_t)row * 2048) + 2 * lane;
#pragma unroll
        for (int j = 0; j < 4; ++j) { f32x4 v0, v1; unpack8(xi[64 * j], v0, v1); const f32x4 g0 = *((const f32x4*)a.in[I_GFINAL] + 2 * lane + 128 * j), g1 = *((const f32x4*)a.in[I_GFINAL] + 2 * lane + 128 * j + 1);
            o[128 * j] = v0 * r * g0; o[128 * j + 1] = v1 * r * g1; }
    } }
    }
}

extern "C" void kernel_launch(void* const* d_in, const int* in_sizes, int n_in, void* d_out, int out_size, void* d_ws, size_t ws_size, hipStream_t stream) {
    static int grid = 0; static const void* fn = nullptr;
    if (grid == 0) {
        if (n_in != 33 || ws_size < WS_END) { fprintf(stderr, "kernel_launch: unexpected n_in %d or ws_size %zu (< %zu)\n", n_in, ws_size, (size_t)WS_END); grid = -1; return; }
        int dev = 0, cus = 0, per_cu = 0;
        (void)hipGetDevice(&dev); (void)hipDeviceGetAttribute(&cus, hipDeviceAttributeMultiprocessorCount, dev);
        fn = cus == 256 ? (const void*)fwd_kernel<true> : (const void*)fwd_kernel<false>;
        if (hipFuncSetAttribute(fn, hipFuncAttributeMaxDynamicSharedMemorySize, LDS_BYTES) != hipSuccess) { fprintf(stderr, "kernel_launch: hipFuncSetAttribute failed\n"); grid = -1; return; }
        if (hipOccupancyMaxActiveBlocksPerMultiprocessor(&per_cu, fn, 512, LDS_BYTES) != hipSuccess || per_cu < 1) { fprintf(stderr, "kernel_launch: occupancy query says %d blocks/CU\n", per_cu); grid = -1; return; }
        grid = cus;
        fprintf(stderr, "kernel_launch: grid %d (per_cu %d), ws %zu\n", grid, per_cu, ws_size);
    }
    if (grid < 0) return;
    if (hipMemsetAsync((char*)d_ws + WS_CTL, 0, XCD_BAR_WORDS * sizeof(unsigned), stream) != hipSuccess) { fprintf(stderr, "kernel_launch: hipMemsetAsync of the barrier words failed\n"); return; }
    Args a{};
    for (int i = 0; i < 33; ++i) a.in[i] = (const float*)d_in[i];
    a.out = (float*)d_out; a.ws = (unsigned char*)d_ws;
    void* args[] = {&a};
    hipError_t e = hipLaunchCooperativeKernel(fn, dim3(grid), dim3(512), args, LDS_BYTES, stream);
    if (e != hipSuccess) fprintf(stderr, "kernel_launch: cooperative launch failed: %s\n", hipGetErrorString(e));
}
```

```cpp
#include <hip/hip_runtime.h>
#include <hip/hip_cooperative_groups.h>
#include <cstdio>
#include <cstdint>
namespace cg = cooperative_groups;

#define LAS __attribute__((address_space(3)))
typedef unsigned short bf16_t;
typedef short bf16x8 __attribute__((ext_vector_type(8)));
typedef float f32x4 __attribute__((ext_vector_type(4)));
typedef float f32x2 __attribute__((ext_vector_type(2)));
typedef unsigned u32x4 __attribute__((ext_vector_type(4)));
typedef unsigned u32x2 __attribute__((ext_vector_type(2)));

constexpr int DM = 2048, SEQ = 2048, NSMP = 128, MPR = 8192, MT = 8320, MPAD = 8448;
constexpr int DFF = 6144, DPLE = 256;
constexpr float EPS = 1e-6f;
constexpr size_t OFF_Y = 0;
constexpr size_t OFF_POOL_P = (size_t)MT * DM;
constexpr size_t OFF_RE_P = OFF_POOL_P + 4 * 15 * 1024;
constexpr size_t OFF_IM_P = OFF_RE_P + 4 * 64 * 64;
constexpr size_t OFF_CONV_P = OFF_IM_P + 4 * 64 * 64;
constexpr size_t OFF_POOL_S = OFF_CONV_P + 4 * 2 * 6144;
constexpr size_t OFF_RE_S = OFF_POOL_S + (size_t)128 * 15 * 1024;
constexpr size_t OFF_IM_S = OFF_RE_S + 128 * 64 * 64;
constexpr size_t OFF_CONV_S = OFF_IM_S + 128 * 64 * 64;
constexpr size_t MiB = 1u << 20;
constexpr size_t WS_WUP = 0, WS_WDOWN = 48 * MiB, WS_WPG = 72 * MiB, WS_WPLE = 80 * MiB, WS_WOUT = 81 * MiB, WS_WIN = 89 * MiB,
                 WS_WGLU = 113 * MiB, WS_WBP = 117 * MiB, WS_WBS = 121 * MiB, WS_WPOOL = 125 * MiB;
constexpr size_t WS_X1B = 89 * MiB;
constexpr size_t WS_P = 126 * MiB;
constexpr size_t WS_H = 159 * MiB, WS_PB = 192 * MiB;
constexpr size_t WS_U = 197 * MiB, WS_GATES = 263 * MiB;
constexpr size_t WS_DIFF = 329 * MiB, WS_SSMACT = WS_DIFF + (size_t)MPAD * 1024 * 2;
constexpr size_t WS_YCAT = 159 * MiB, WS_T1 = 197 * MiB, WS_MERGED = 329 * MiB;
constexpr size_t WS_ABUF = 159 * MiB, WS_VBUF = 258 * MiB, WS_X2B = 159 * MiB;
constexpr size_t WS_ROWSS = 372 * MiB, WS_CTL = 362 * MiB + 512 * 1024;
constexpr size_t WS_PM = 363 * MiB, WS_QM = 367 * MiB, WS_KT = 371 * MiB, WS_END = 379 * MiB;
constexpr int LDS_BYTES = 163840;

typedef __bf16 bf16x2_t __attribute__((ext_vector_type(2)));
__device__ __forceinline__ unsigned cvt_pk_bf16(float lo, float hi) { const f32x2 v = {lo, hi}; return __builtin_bit_cast(unsigned, __builtin_convertvector(v, bf16x2_t)); }
__device__ __forceinline__ float bf_lo(unsigned w) { return __uint_as_float(w << 16); }
__device__ __forceinline__ float bf_hi(unsigned w) { return __uint_as_float(w & 0xffff0000u); }
__device__ __forceinline__ float sigmoid_f(float x) { return __builtin_amdgcn_rcpf(1.0f + __builtin_amdgcn_exp2f(-1.4426950408889634f * x)); }
__device__ __forceinline__ float gelu_tanh_f(float x) { const float z = 1.5957691216057308f * (x + 0.044715f * x * x * x); return x * sigmoid_f(z); }
constexpr float GC1 = -(1.5957691216057308f * 1.4426950408889634f), GC2 = GC1 * 0.044715f;
__device__ __forceinline__ f32x2 gelu2(const f32x2 x) { const f32x2 t = x * x; const f32x2 u = t * GC2 + GC1; const f32x2 w = x * u;
    const f32x2 e = (f32x2){__builtin_amdgcn_exp2f(w[0]), __builtin_amdgcn_exp2f(w[1])} + 1.0f; return x * (f32x2){__builtin_amdgcn_rcpf(e[0]), __builtin_amdgcn_rcpf(e[1])}; }
__device__ __forceinline__ u32x4 pack8(const f32x4 a, const f32x4 b) { u32x4 w; w.x = cvt_pk_bf16(a[0], a[1]); w.y = cvt_pk_bf16(a[2], a[3]); w.z = cvt_pk_bf16(b[0], b[1]); w.w = cvt_pk_bf16(b[2], b[3]); return w; }
__device__ __forceinline__ void unpack8(const u32x4 w, f32x4& a, f32x4& b) { a = (f32x4){bf_lo(w.x), bf_hi(w.x), bf_lo(w.y), bf_hi(w.y)}; b = (f32x4){bf_lo(w.z), bf_hi(w.z), bf_lo(w.w), bf_hi(w.w)}; }
__device__ __forceinline__ float sumsq8(const f32x4 a, const f32x4 b) { return (a[0] * a[0] + a[1] * a[1]) + (a[2] * a[2] + a[3] * a[3]) + (b[0] * b[0] + b[1] * b[1]) + (b[2] * b[2] + b[3] * b[3]); }
__device__ __forceinline__ int lane_id() { int l; asm volatile("v_mbcnt_lo_u32_b32 %0, -1, 0\n\tv_mbcnt_hi_u32_b32 %0, -1, %0" : "=v"(l)); return l; }
__device__ __forceinline__ float shfl_xor_f(float v, int lane, int m) { return __int_as_float(__builtin_amdgcn_ds_bpermute((lane ^ m) << 2, __float_as_int(v))); }
constexpr int RS_SLOTS = 64;
__device__ __forceinline__ void put_rowss(float* rs, int row, int slot, float s, int fr, int fq, bool valid) {
    const int lane = fq * 16 + fr; s += shfl_xor_f(s, lane, 16); s += shfl_xor_f(s, lane, 32);
    if (fq == 0 && valid) rs[(size_t)row * RS_SLOTS + slot] = s;
}
__device__ __forceinline__ float rs_rstd_main(const float* rs, int row, int fr, int fq) {
    const f32x4 a = *(const f32x4*)(rs + (size_t)row * RS_SLOTS + 8 * fq), b = *(const f32x4*)(rs + (size_t)row * RS_SLOTS + 8 * fq + 4);
    float s = (a[0] + a[1]) + (a[2] + a[3]) + (b[0] + b[1]) + (b[2] + b[3]); const int lane = fq * 16 + fr;
    s += shfl_xor_f(s, lane, 16); s += shfl_xor_f(s, lane, 32);
    return rsqrtf(s * (1.0f / (float)DM) + EPS);
}
__device__ __forceinline__ float rs_rstd_x(const float* rs, int row, int fr, int fq) {
    float s = 0.f;
#pragma unroll
    for (int q = 0; q < 4; ++q) { const f32x4 a = *(const f32x4*)(rs + (size_t)row * RS_SLOTS + 16 * fq + 4 * q); s += (a[0] + a[1]) + (a[2] + a[3]); }
    const int lane = fq * 16 + fr; s += shfl_xor_f(s, lane, 16); s += shfl_xor_f(s, lane, 32);
    return rsqrtf(s * (1.0f / (float)DM) + EPS);
}
__device__ __forceinline__ float wave_sum(float v, int lane) {
#pragma unroll
    for (int o = 1; o < 64; o <<= 1) v += shfl_xor_f(v, lane, o);
    return v;
}

namespace pg8 {
constexpr int BM = 256, BK = 64, HALF = 128, HTB = HALF * BK * 2, STAGE_BYTES = 8 * HTB, NXCD = 8, WGM = 4;
__device__ __forceinline__ int lds_byte(int r, int c) { const int st = (r >> 4) * 2 + (c >> 5), rr = r & 15, cc = c & 31, ob = rr * 64 + cc * 2; return st * 1024 + (ob ^ (((ob >> 9) & 1) << 5)); }
__device__ __forceinline__ void stage_rc(int b, int& R, int& C) { const int st = b / 1024, sb = b % 1024, swz = sb ^ (((sb >> 9) & 1) << 5); R = (st >> 1) * 16 + swz / 64; C = (st & 1) * 32 + (swz % 64) / 2; }
__device__ __forceinline__ int perm32(int rho) { const int n = rho >> 4, i = rho & 15; return 8 * (i >> 2) + 4 * n + (i & 3); }
struct Unit { int pm, pn; };
struct Gemm { const bf16_t* A; const bf16_t* B; int lda, ldb, K, nM, nN, a_koff, b_half_rows, b_tile_rows; int kp_shift; unsigned a_pstride, b_pstride; };
struct StaticOrder {
    int nM, nN, nwg, G, c;
    __device__ __forceinline__ void init(int nM_, int nN_, int G_, int c_) { nM = nM_; nN = nN_; nwg = nM * nN; G = G_; c = c_; }
    __device__ __forceinline__ bool next(int i, Unit& u) const {
        const long L = (long)i * G + c; if (L >= nwg) return false;
        int wgid = (int)L; { const int q = nwg / NXCD, r = nwg % NXCD, xcd = wgid % NXCD, off = wgid / NXCD; wgid = (xcd < r ? xcd * (q + 1) : r * (q + 1) + (xcd - r) * q) + off; }
        const int nig = WGM * nN, gid = wgid / nig, fm = gid * WGM, gsz = (nM - fm) < WGM ? (nM - fm) : WGM;
        u.pm = fm + ((wgid % nig) % gsz); u.pn = (wgid % nig) / gsz; return true;
    }
};

template <class Epi, bool XROWS_, int WR>
__device__ __forceinline__ void gemm_phase_wr(LAS unsigned char* lds, const Gemm g, int G, int cidx, int wave_s, const Epi& E) {
    const int lane = lane_id();
    constexpr int wr = WR;
    constexpr bool XROWS = XROWS_ && WR == 1;
    const int wid = wave_s, tid = wid * 64 + lane, wc = wid & 3, fr = lane & 15, fq = lane >> 4;
    int K = g.K; asm volatile("" : "+s"(K));
    const int nt = K / BK;
    StaticOrder S; S.init(g.nM, g.nN, G, cidx);
    unsigned voffA[2], voffB[2];
#pragma unroll
    for (int i = 0; i < 2; ++i) { int R, C; stage_rc(tid * 16 + i * 8192, R, C); const int Rb = (R & ~31) + perm32(R & 31);
        voffA[i] = (unsigned)(R * g.lda + C) * 2u; voffB[i] = (unsigned)(Rb * g.ldb + C) * 2u; }
    const unsigned kstep = (unsigned)(BK * 2);
    const unsigned kps = g.kp_shift > 0 ? (unsigned)g.kp_shift : 31u, kpm = (1u << kps) - 1u;
    const unsigned hstepA = (unsigned)HALF * g.lda * 2u, tstepA = 2u * hstepA, kofA = (unsigned)g.a_koff * 2u;
    const unsigned hstepB = (unsigned)g.b_half_rows * g.ldb * 2u, tstepB = (unsigned)g.b_tile_rows * g.ldb * 2u;
    const __amdgpu_buffer_rsrc_t rsA = __builtin_amdgcn_make_buffer_rsrc((void*)g.A, (short)0, 0x7fffffff, 0x00020000);
    const __amdgpu_buffer_rsrc_t rsB = __builtin_amdgcn_make_buffer_rsrc((void*)g.B, (short)0, 0x7fffffff, 0x00020000);
    const unsigned ldsw = (unsigned)wid * 1024u;
    const int aoff = lds_byte(wr * 64 + fr, fq * 8), boff = lds_byte(wc * 32 + fr, fq * 8);
    const unsigned voffX = (unsigned)(fr * g.lda + fq * 8) * 2u;
    const unsigned xrow0 = (unsigned)MPR * g.lda * 2u, xstep = 4u * g.lda * 2u;
#define PG8_SA(b, h) (((b) * 2 + (h)) * HTB)
#define PG8_SB(b, h) ((4 + (b) * 2 + (h)) * HTB)
#define PG8_STAGE(bufoff, rs, soff, voff) do { _Pragma("unroll") for (int _i = 0; _i < 2; ++_i) \
        __builtin_amdgcn_raw_ptr_buffer_load_lds(rs, (LAS unsigned*)(lds + (bufoff) + ldsw + _i * 8192), 16, (voff)[_i], (soff), 0, 0); } while (0)
#define PG8_LDA(dst, b, h) do { _Pragma("unroll") for (int m = 0; m < 4; ++m) _Pragma("unroll") for (int k = 0; k < 2; ++k) dst[m][k] = *(const LAS bf16x8*)(lds + PG8_SA(b, h) + aoff + m * 2048 + k * 1024); } while (0)
#define PG8_LDB(dst, b, h) do { _Pragma("unroll") for (int n = 0; n < 2; ++n) _Pragma("unroll") for (int k = 0; k < 2; ++k) dst[n][k] = *(const LAS bf16x8*)(lds + PG8_SB(b, h) + boff + n * 2048 + k * 1024); } while (0)
#define PG8_MMA(ai, bj, At, Bt) do { __builtin_amdgcn_s_setprio(1); _Pragma("unroll") for (int m = 0; m < 4; ++m) _Pragma("unroll") for (int n = 0; n < 2; ++n) _Pragma("unroll") for (int k = 0; k < 2; ++k) \
        acc[ai][bj][m][n] = __builtin_amdgcn_mfma_f32_16x16x32_bf16(Bt[n][k], At[m][k], acc[ai][bj][m][n], 0, 0, 0); __builtin_amdgcn_s_setprio(0); } while (0)
#define PG8_LOADX(dst, soff) do { if (XROWS) { _Pragma("unroll") for (int k = 0; k < 2; ++k) dst[k] = __builtin_bit_cast(bf16x8, __builtin_amdgcn_raw_buffer_load_b128(rsA, voffX + k * 64, (soff), 0)); } } while (0)
#define PG8_MMAX(Xf) do { if (!XROWS) break; __builtin_amdgcn_s_setprio(1); _Pragma("unroll") for (int k = 0; k < 2; ++k) _Pragma("unroll") for (int n = 0; n < 2; ++n) { \
        accX[n] = __builtin_amdgcn_mfma_f32_16x16x32_bf16(B0[n][k], Xf[k], accX[n], 0, 0, 0); accX[2 + n] = __builtin_amdgcn_mfma_f32_16x16x32_bf16(B1[n][k], Xf[k], accX[2 + n], 0, 0, 0); } __builtin_amdgcn_s_setprio(0); } while (0)
#define PG8_WAIT_V(n) asm volatile("s_waitcnt vmcnt(" #n ")" ::: "memory")
#define PG8_WAITV_SP2 do { if constexpr (XROWS) PG8_WAIT_V(10); else PG8_WAIT_V(8); } while (0)
#define PG8_WAIT_L(n) asm volatile("s_waitcnt lgkmcnt(" #n ")" ::: "memory")
#define PG8_BAR __builtin_amdgcn_s_barrier()
#define PG8_SCHED __builtin_amdgcn_sched_barrier(0)
    Unit cur, nxt; int ui = 0;
    if (!S.next(0, cur)) return;
    f32x4 acc[2][2][4][2];
#pragma unroll
    for (int a = 0; a < 2; ++a)
#pragma unroll
        for (int b = 0; b < 2; ++b)
#pragma unroll
            for (int m = 0; m < 4; ++m)
#pragma unroll
                for (int n = 0; n < 2; ++n) acc[a][b][m][n] = (f32x4){0.f, 0.f, 0.f, 0.f};
    bf16x8 At[4][2], B0[2][2], B1[2][2], XA[2];
    f32x4 accX[4]; accX[0] = (f32x4){0.f, 0.f, 0.f, 0.f}; accX[1] = accX[0]; accX[2] = accX[0]; accX[3] = accX[0];
    unsigned cA = (unsigned)cur.pm * tstepA + (unsigned)cur.pn * kofA, cB = (unsigned)cur.pn * tstepB;
    unsigned cX = xrow0 + (unsigned)cur.pm * xstep + (unsigned)cur.pn * kofA;
    PG8_LOADX(XA, cX);
    PG8_STAGE(PG8_SB(0, 0), rsB, cB, voffB); PG8_STAGE(PG8_SB(0, 1), rsB, cB + hstepB, voffB); PG8_STAGE(PG8_SA(0, 0), rsA, cA, voffA); PG8_STAGE(PG8_SA(0, 1), rsA, cA + hstepA, voffA);
    if (wr == 1) PG8_BAR;
    PG8_WAIT_V(2); PG8_BAR;
    PG8_STAGE(PG8_SB(1, 0), rsB, cB + kstep, voffB); PG8_STAGE(PG8_SA(1, 0), rsA, cA + kstep, voffA); PG8_STAGE(PG8_SB(1, 1), rsB, cB + hstepB + kstep, voffB);
    PG8_WAIT_V(6); PG8_BAR;
    for (;;) {
        const bool has_next = S.next(ui + 1, nxt);
        const unsigned nA = has_next ? (unsigned)nxt.pm * tstepA + (unsigned)nxt.pn * kofA : cA, nB = has_next ? (unsigned)nxt.pn * tstepB : cB;
        const unsigned nX = has_next ? xrow0 + (unsigned)nxt.pm * xstep + (unsigned)nxt.pn * kofA : cX;
        for (int seg = 0; seg < (Epi::MIDK ? 2 : 1); ++seg) {
        const int tbeg = (Epi::MIDK && seg == 1) ? (nt >> 1) : 0, tend = (Epi::MIDK && seg == 0) ? (nt >> 1) : nt;
        if constexpr (Epi::MIDK) { if (seg == 1) E.mid(acc, accX, cur, wr, wc, fr, fq); }
        for (int t = tbeg; t < tend; t += 2) {
            const bool last = (t == nt - 2);
            const unsigned t1 = (unsigned)(t + 1), t2 = (unsigned)(t + 2);
            const unsigned ko1 = (t1 & kpm) * kstep, ko2 = (t2 & kpm) * kstep, pa1 = (t1 >> kps) * g.a_pstride, pa2 = (t2 >> kps) * g.a_pstride, pb2 = (t2 >> kps) * g.b_pstride;
            const unsigned a1 = cA + pa1 + ko1, x1 = cX + pa1 + ko1;
            const unsigned a2 = last ? nA : cA + pa2 + ko2, b2 = last ? nB : cB + pb2 + ko2;
            const unsigned a3 = a2 + kstep, b3 = b2 + kstep, x2 = last ? nX : cX + pa2 + ko2;
            PG8_LDB(B0, 0, 0); PG8_LDB(B1, 0, 1); PG8_SCHED; PG8_LDA(At, 0, 0); PG8_STAGE(PG8_SA(1, 1), rsA, a1 + hstepA, voffA);
            PG8_WAIT_V(8); PG8_WAIT_L(0); PG8_BAR; PG8_MMA(0, 0, At, B0); PG8_MMA(0, 1, At, B1); PG8_MMAX(XA); PG8_LOADX(XA, x1); PG8_BAR; PG8_SCHED;
            PG8_LDA(At, 0, 1); PG8_STAGE(PG8_SB(0, 0), rsB, b2, voffB); PG8_STAGE(PG8_SB(0, 1), rsB, b2 + hstepB, voffB); PG8_STAGE(PG8_SA(0, 0), rsA, a2, voffA);
            PG8_WAITV_SP2; PG8_WAIT_L(0); PG8_BAR; PG8_MMA(1, 0, At, B0); PG8_MMA(1, 1, At, B1); PG8_BAR; PG8_SCHED;
            PG8_LDB(B0, 1, 0); PG8_LDB(B1, 1, 1); PG8_SCHED; PG8_LDA(At, 1, 0); PG8_STAGE(PG8_SA(0, 1), rsA, a2 + hstepA, voffA);
            PG8_WAIT_V(8); PG8_WAIT_L(0); PG8_BAR; PG8_MMA(0, 0, At, B0); PG8_MMA(0, 1, At, B1); PG8_MMAX(XA); PG8_LOADX(XA, x2); PG8_BAR; PG8_SCHED;
            PG8_LDA(At, 1, 1); PG8_STAGE(PG8_SB(1, 0), rsB, b3, voffB); PG8_STAGE(PG8_SB(1, 1), rsB, b3 + hstepB, voffB); PG8_STAGE(PG8_SA(1, 0), rsA, a3, voffA);
            PG8_WAITV_SP2; PG8_WAIT_L(0); PG8_BAR; PG8_MMA(1, 0, At, B0); PG8_MMA(1, 1, At, B1); PG8_BAR; PG8_SCHED;
        }
        }
        if (wr == 0) PG8_BAR;
        if constexpr (Epi::FUSED) { E.template fused<XROWS>(acc, accX, cur, wr, wc, fr, fq, tid == 0); }
        else {
        if constexpr (XROWS) { { const f32x4 ax2[2] = {accX[0], accX[2]}; E.x(ax2, cur, 0, wc, fr, fq); } { const f32x4 ax3[2] = {accX[1], accX[3]}; E.x(ax3, cur, 1, wc, fr, fq); } }
        E(acc, cur, wr, wc, fr, fq);
        }
        if (!has_next) break;
        accX[0] = (f32x4){0.f, 0.f, 0.f, 0.f}; accX[1] = accX[0]; accX[2] = accX[0]; accX[3] = accX[0];
#pragma unroll
        for (int a = 0; a < 2; ++a)
#pragma unroll
            for (int b = 0; b < 2; ++b)
#pragma unroll
                for (int m = 0; m < 4; ++m)
#pragma unroll
                    for (int n = 0; n < 2; ++n) acc[a][b][m][n] = (f32x4){0.f, 0.f, 0.f, 0.f};
        cur = nxt; cA = nA; cB = nB; cX = nX; ++ui;
        if (wr == 1) PG8_BAR;
    }
    PG8_WAIT_V(0);
    PG8_BAR;
#undef PG8_SA
#undef PG8_SB
#undef PG8_STAGE
#undef PG8_LDA
#undef PG8_LDB
#undef PG8_MMA
#undef PG8_LOADX
#undef PG8_MMAX
#undef PG8_WAIT_V
#undef PG8_WAITV_SP2
#undef PG8_WAIT_L
#undef PG8_BAR
#undef PG8_SCHED
}
template <class Epi, bool XROWS = true>
__device__ __forceinline__ void gemm_phase(LAS unsigned char* lds, const Gemm g, int G, int cidx, int wave_s, const Epi& E) {
    if (wave_s < 4) gemm_phase_wr<Epi, XROWS, 0>(lds, g, G, cidx, wave_s, E); else gemm_phase_wr<Epi, XROWS, 1>(lds, g, G, cidx, wave_s, E);
}
}
using pg8::Unit;

#define EPI_ARGS const f32x4 (&acc)[2][2][4][2], const Unit& u, int wr, int wc, int fr, int fq
#define EPI_FOR_ROWS _Pragma("unroll") for (int ai = 0; ai < 2; ++ai) _Pragma("unroll") for (int m = 0; m < 4; ++m)
#define EPI_ROW (u.pm * 256 + ai * 128 + wr * 64 + m * 16 + fr)

#define XROW_SETUP const bool valid = fr < 4; const int row = MPR + 4 * u.pm + fr; const int cq = wc * 32 + 8 * fq + 4 * wr; (void)valid; (void)row; (void)cq;
__device__ __forceinline__ u32x2 pack4(const f32x4 a) { u32x2 w; w.x = cvt_pk_bf16(a[0], a[1]); w.y = cvt_pk_bf16(a[2], a[3]); return w; }
__device__ __forceinline__ f32x4 unpack4(const u32x2 w) { return (f32x4){bf_lo(w.x), bf_hi(w.x), bf_lo(w.y), bf_hi(w.y)}; }
__device__ __forceinline__ float sumsq4(const f32x4 a) { return (a[0] * a[0] + a[1] * a[1]) + (a[2] * a[2] + a[3] * a[3]); }
#define XEPI_ARGS const f32x4 (&ax)[2], const Unit& u, int wr, int wc, int fr, int fq

struct EpiZ { static constexpr bool MIDK = false; static constexpr bool FUSED = false;
    bf16_t* U; bf16_t* US; bf16_t* UX; bf16_t* GATES; float* out;
    __device__ __forceinline__ void operator()(EPI_ARGS) const {
        const int colh = wc * 32 + 8 * fq;
        if (u.pn < 8) {
            EPI_FOR_ROWS { const int row = EPI_ROW;
#pragma unroll
                for (int bj = 0; bj < 2; ++bj) { const int col = u.pn * 256 + bj * 128 + colh;
                    bf16_t* dst = u.pn < 4 ? U + (size_t)row * 1024 + col : US + (((size_t)((row >> 11) * 64 + ((col - 1024) >> 4)) * 2048 + (row & 2047)) * 16 + (col & 8));
                    *(u32x4*)dst = pack8(acc[ai][bj][m][0], acc[ai][bj][m][1]);
                    if (u.pn < 4) { const int t = row & 2047;
                        if (t >= 2033) { float* q = out + OFF_POOL_P + ((size_t)((row >> 11) * 15 + (t - 2033))) * 1024 + col; *(f32x4*)q = acc[ai][bj][m][0]; *(f32x4*)(q + 4) = acc[ai][bj][m][1]; } } } }
        } else {
            EPI_FOR_ROWS { const int row = EPI_ROW;
#pragma unroll
                for (int bj = 0; bj < 2; ++bj) { const int col = (u.pn - 8) * 256 + bj * 128 + colh; f32x4 v0 = acc[ai][bj][m][0], v1 = acc[ai][bj][m][1];
#pragma unroll
                    for (int j = 0; j < 4; ++j) { v0[j] = sigmoid_f(v0[j]); v1[j] = sigmoid_f(v1[j]); }
                    *(u32x4*)(GATES + (size_t)row * 4096 + col) = pack8(v0, v1); } }
        }
    }
    __device__ __forceinline__ void x(XEPI_ARGS) const { XROW_SETUP
        if (!valid) return;
#pragma unroll
        for (int bj = 0; bj < 2; ++bj) { const int col = u.pn * 256 + bj * 128 + cq;
            if (u.pn < 8) { *(u32x2*)(u.pn < 4 ? U + (size_t)row * 1024 + col : UX + (size_t)(row - MPR) * 1024 + (col - 1024)) = pack4(ax[bj]); if (u.pn < 4) *(f32x4*)(out + OFF_POOL_S + ((size_t)(row - MPR) * 15 + 14) * 1024 + col) = ax[bj]; }
            else { f32x4 v = ax[bj];
#pragma unroll
                for (int j = 0; j < 4; ++j) v[j] = sigmoid_f(v[j]);
                *(u32x2*)(GATES + (size_t)row * 4096 + col - 2048) = pack4(v); } }
    }
};
struct EpiBf { static constexpr bool MIDK = false; static constexpr bool FUSED = false;
    bf16_t* O; int ldo; const float* cscale;
    __device__ __forceinline__ void operator()(EPI_ARGS) const {
        const int colh = wc * 32 + 8 * fq;
#pragma unroll
        for (int bj = 0; bj < 2; ++bj) { const int col = u.pn * 256 + bj * 128 + colh;
            f32x4 s0 = (f32x4){1.f, 1.f, 1.f, 1.f}, s1 = s0; if (cscale) { s0 = *(const f32x4*)(cscale + col); s1 = *(const f32x4*)(cscale + col + 4); }
            EPI_FOR_ROWS { const int row = EPI_ROW; *(u32x4*)(O + (size_t)row * ldo + col) = pack8(acc[ai][bj][m][0] * s0, acc[ai][bj][m][1] * s1); } }
    }
    __device__ __forceinline__ void x(XEPI_ARGS) const { XROW_SETUP
        if (!valid) return;
#pragma unroll
        for (int bj = 0; bj < 2; ++bj) { const int col = u.pn * 256 + bj * 128 + cq; f32x4 v = ax[bj]; if (cscale) v = v * *(const f32x4*)(cscale + col);
            *(u32x2*)(O + (size_t)row * ldo + col) = pack4(v); }
    }
};
struct EpiGlu { static constexpr bool MIDK = false; static constexpr bool FUSED = false;
    bf16_t* O; int ldo; int coff;
    __device__ __forceinline__ void operator()(EPI_ARGS) const {
        const int col = coff + u.pn * 128 + wc * 32 + 8 * fq;
        EPI_FOR_ROWS { const int row = EPI_ROW; f32x4 v0 = acc[ai][0][m][0], v1 = acc[ai][0][m][1]; const f32x4 g0 = acc[ai][1][m][0], g1 = acc[ai][1][m][1];
#pragma unroll
            for (int j = 0; j < 4; ++j) { v0[j] *= sigmoid_f(g0[j]); v1[j] *= sigmoid_f(g1[j]); }
            *(u32x4*)(O + (size_t)row * ldo + col) = pack8(v0, v1); }
    }
    __device__ __forceinline__ void x(XEPI_ARGS) const { XROW_SETUP
        if (!valid) return;
        f32x4 v = ax[0];
#pragma unroll
        for (int j = 0; j < 4; ++j) v[j] *= sigmoid_f(ax[1][j]);
        *(u32x2*)(O + (size_t)row * ldo + coff + u.pn * 128 + cq) = pack4(v);
    }
};
struct EpiMerge { static constexpr bool MIDK = true; static constexpr bool FUSED = false;
    const bf16_t* GATES; bf16_t* MERGED;
    static __device__ __forceinline__ f32x4 clampg(f32x4 g) { return (f32x4){fmaxf(g[0], 1e-20f), fmaxf(g[1], 1e-20f), fmaxf(g[2], 1e-20f), fmaxf(g[3], 1e-20f)}; }
    static __device__ __forceinline__ f32x4 rcp4(f32x4 g) { return (f32x4){__builtin_amdgcn_rcpf(g[0]), __builtin_amdgcn_rcpf(g[1]), __builtin_amdgcn_rcpf(g[2]), __builtin_amdgcn_rcpf(g[3])}; }
    __device__ __forceinline__ void mid(f32x4 (&acc)[2][2][4][2], f32x4 (&ax)[4], const Unit& u, int wr, int wc, int fr0, int fq) const {
        int fr = fr0; asm volatile("" : "+v"(fr));
        const int colh = wc * 32 + 8 * fq;
#pragma unroll
        for (int ai = 0; ai < 2; ++ai)
#pragma unroll
            for (int m = 0; m < 4; ++m) { u32x4 gp[2], gs[2];
#pragma unroll
                for (int bj = 0; bj < 2; ++bj) { const bf16_t* gr = GATES + (size_t)EPI_ROW * 4096 + u.pn * 256 + bj * 128 + colh; gp[bj] = *(const u32x4*)gr; gs[bj] = *(const u32x4*)(gr + 2048); }
#pragma unroll
                for (int bj = 0; bj < 2; ++bj) { f32x4 p0, p1, s0, s1; unpack8(gp[bj], p0, p1); unpack8(gs[bj], s0, s1);
                    acc[ai][bj][m][0] = acc[ai][bj][m][0] * (p0 * rcp4(clampg(s0))); acc[ai][bj][m][1] = acc[ai][bj][m][1] * (p1 * rcp4(clampg(s1))); }
                if (m & 1) asm volatile("" ::: "memory"); }
        if (wr == 0) return;
        const int row = MPR + 4 * u.pm + (fr & 3);
#pragma unroll
        for (int bj = 0; bj < 2; ++bj)
#pragma unroll
            for (int n = 0; n < 2; ++n) { const bf16_t* gr = GATES + (size_t)row * 4096 + u.pn * 256 + bj * 128 + wc * 32 + 8 * fq + 4 * n;
                ax[2 * bj + n] = ax[2 * bj + n] * (unpack4(*(const u32x2*)gr) * rcp4(clampg(unpack4(*(const u32x2*)(gr + 2048))))); }
    }
    __device__ __forceinline__ void operator()(EPI_ARGS) const {
        const int colh = wc * 32 + 8 * fq;
#pragma unroll
        for (int ai = 0; ai < 2; ++ai) { u32x4 gs[4][2];
#pragma unroll
            for (int m = 0; m < 4; ++m)
#pragma unroll
                for (int bj = 0; bj < 2; ++bj) gs[m][bj] = *(const u32x4*)(GATES + (size_t)EPI_ROW * 4096 + 2048 + u.pn * 256 + bj * 128 + colh);
#pragma unroll
            for (int m = 0; m < 4; ++m) { const int row = EPI_ROW;
#pragma unroll
                for (int bj = 0; bj < 2; ++bj) { const int col = u.pn * 256 + bj * 128 + colh; f32x4 s0, s1; unpack8(gs[m][bj], s0, s1);
                    *(u32x4*)(MERGED + (size_t)row * 2048 + col) = pack8(acc[ai][bj][m][0] * clampg(s0), acc[ai][bj][m][1] * clampg(s1)); } }
            asm volatile("" ::: "memory"); }
    }
    __device__ __forceinline__ void x(XEPI_ARGS) const { XROW_SETUP
        if (!valid) return;
#pragma unroll
        for (int bj = 0; bj < 2; ++bj) { const int col = u.pn * 256 + bj * 128 + cq; const f32x4 g = clampg(unpack4(*(const u32x2*)(GATES + (size_t)row * 4096 + 2048 + col)));
            *(u32x2*)(MERGED + (size_t)row * 2048 + col) = pack4(ax[bj] * g); }
    }
};
template <bool SRC_BF16> struct EpiRes { static constexpr bool MIDK = false; static constexpr bool FUSED = false;
    const float* xp; const float* xs; const bf16_t* XS; bf16_t* XB; float* rs;
    __device__ __forceinline__ void operator()(EPI_ARGS) const {
        const int colh = wc * 32 + 8 * fq;
#pragma unroll
        for (int ai = 0; ai < 2; ++ai) { f32x4 xr[4][2][2];
#pragma unroll
            for (int m = 0; m < 4; ++m)
#pragma unroll
                for (int bj = 0; bj < 2; ++bj) { const size_t off = (size_t)EPI_ROW * 2048 + u.pn * 256 + bj * 128 + colh;
                    if (SRC_BF16) unpack8(*(const u32x4*)(XS + off), xr[m][bj][0], xr[m][bj][1]); else { xr[m][bj][0] = *(const f32x4*)(xp + off); xr[m][bj][1] = *(const f32x4*)(xp + off + 4); } }
#pragma unroll
            for (int m = 0; m < 4; ++m) { const int row = EPI_ROW; float ss = 0.f;
#pragma unroll
                for (int bj = 0; bj < 2; ++bj) { const int col = u.pn * 256 + bj * 128 + colh;
                    const f32x4 v0 = acc[ai][bj][m][0] + xr[m][bj][0], v1 = acc[ai][bj][m][1] + xr[m][bj][1];
                    *(u32x4*)(XB + (size_t)row * 2048 + col) = pack8(v0, v1); ss += sumsq8(v0, v1); }
                put_rowss(rs, row, u.pn * 4 + wc, ss, fr, fq, true); }
            asm volatile("" ::: "memory"); }
    }
    __device__ __forceinline__ void x(XEPI_ARGS) const { XROW_SETUP
        float ss = 0.f;
        if (valid) {
#pragma unroll
            for (int bj = 0; bj < 2; ++bj) { const int col = u.pn * 256 + bj * 128 + cq;
                const f32x4 xo = SRC_BF16 ? unpack4(*(const u32x2*)(XS + (size_t)row * 2048 + col)) : *(const f32x4*)(xs + (size_t)(row - MPR) * 2048 + col);
                const f32x4 v = ax[bj] + xo; *(u32x2*)(XB + (size_t)row * 2048 + col) = pack4(v); ss += sumsq4(v); } }
        put_rowss(rs, row, u.pn * 8 + wr * 4 + wc, ss, fr, fq, valid);
    }
};
__device__ __forceinline__ float dpp_prev1(float cur, float prevgrp) { const int o = __builtin_amdgcn_mov_dpp(__float_as_int(prevgrp), 0x121, 0xf, 0xf, true);
    return __int_as_float(__builtin_amdgcn_update_dpp(o, __float_as_int(cur), 0x111, 0xf, 0xf, false)); }
__device__ __forceinline__ float dpp_prev2(float cur, float prevgrp) { const int o = __builtin_amdgcn_mov_dpp(__float_as_int(prevgrp), 0x122, 0xf, 0xf, true);
    return __int_as_float(__builtin_amdgcn_update_dpp(o, __float_as_int(cur), 0x112, 0xf, 0xf, false)); }
constexpr size_t SA_BLK = (size_t)4 * 6144;
struct EpiUp { static constexpr bool MIDK = false; static constexpr bool FUSED = false;
    const float* rs; bf16_t* VB; float* SA; float* SAS; float* out; const float* WC; const float* BC;
    __device__ __forceinline__ void operator()(const f32x4 (&acc)[2][2][4][2], const Unit& u, int wr, int wc, int fr0, int fq0) const {
        int fr = fr0, fq = fq0; asm volatile("" : "+v"(fr), "+v"(fq));
        const int col = u.pn * 128 + wc * 32 + 8 * fq;
        const f32x4 w0a = *(const f32x4*)(WC + col), w0b = *(const f32x4*)(WC + col + 4), w1a = *(const f32x4*)(WC + 6144 + col), w1b = *(const f32x4*)(WC + 6144 + col + 4);
        const f32x4 w2a = *(const f32x4*)(WC + 12288 + col), w2b = *(const f32x4*)(WC + 12288 + col + 4), bca = *(const f32x4*)(BC + col), bcb = *(const f32x4*)(BC + col + 4);
        bf16_t* vbase = VB + (size_t)(u.pn >> 4) * ((size_t)MPAD * 2048) + (col & 2047);
#pragma unroll
        for (int ai = 0; ai < 2; ++ai) { f32x4 pa0, pa1; float rr[4];
#pragma unroll
            for (int m = 0; m < 4; ++m) rr[m] = rs_rstd_main(rs, EPI_ROW, fr, fq);
            float* sa = SA + (size_t)(4 * u.pm + 2 * ai + wr) * SA_BLK + col;
#pragma unroll
            for (int m = 0; m < 4; ++m) { const int row = EPI_ROW; const float r = rr[m];
                const f32x4 a0 = acc[ai][0][m][0] * r, a1 = acc[ai][0][m][1] * r, v0 = acc[ai][1][m][0] * r, v1 = acc[ai][1][m][1] * r;
                if (m == 0) { pa0 = a0; pa1 = a1; }
                f32x4 o0, o1;
#pragma unroll
                for (int j = 0; j < 4; j += 2) {
                    const f32x2 q0 = (f32x2){dpp_prev2(a0[j], pa0[j]), dpp_prev2(a0[j + 1], pa0[j + 1])}, p0 = (f32x2){dpp_prev1(a0[j], pa0[j]), dpp_prev1(a0[j + 1], pa0[j + 1])};
                    const f32x2 q1 = (f32x2){dpp_prev2(a1[j], pa1[j]), dpp_prev2(a1[j + 1], pa1[j + 1])}, p1 = (f32x2){dpp_prev1(a1[j], pa1[j]), dpp_prev1(a1[j + 1], pa1[j + 1])};
                    const f32x2 c0 = (f32x2){bca[j], bca[j + 1]} + (f32x2){w0a[j], w0a[j + 1]} * q0 + (f32x2){w1a[j], w1a[j + 1]} * p0 + (f32x2){w2a[j], w2a[j + 1]} * (f32x2){a0[j], a0[j + 1]};
                    const f32x2 c1 = (f32x2){bcb[j], bcb[j + 1]} + (f32x2){w0b[j], w0b[j + 1]} * q1 + (f32x2){w1b[j], w1b[j + 1]} * p1 + (f32x2){w2b[j], w2b[j + 1]} * (f32x2){a1[j], a1[j + 1]};
                    const f32x2 g0 = gelu2(c0) * (f32x2){v0[j], v0[j + 1]}, g1 = gelu2(c1) * (f32x2){v1[j], v1[j + 1]};
                    o0[j] = g0[0]; o0[j + 1] = g0[1]; o1[j] = g1[0]; o1[j + 1] = g1[1]; }
                if (m == 0 && fr < 2) { o0 = v0; o1 = v1; float* q = sa + (size_t)fr * 6144; *(f32x4*)q = a0; *(f32x4*)(q + 4) = a1; }
                if (m == 3 && fr >= 14) { float* q = sa + (size_t)(fr - 12) * 6144; *(f32x4*)q = a0; *(f32x4*)(q + 4) = a1;
                    const int t = row & 2047; if (t >= 2046) { float* q2 = out + OFF_CONV_P + ((size_t)((row >> 11) * 2 + (t - 2046))) * 6144 + col; *(f32x4*)q2 = a0; *(f32x4*)(q2 + 4) = a1; } }
                *(u32x4*)(vbase + (size_t)row * 2048) = pack8(o0, o1);
                pa0 = a0; pa1 = a1; }
            asm volatile("" ::: "memory"); }
    }
    __device__ __forceinline__ void x(XEPI_ARGS) const { XROW_SETUP
        const float r = rs_rstd_x(rs, valid ? row : MPR, fr, fq);
        if (!valid) return;
        const int col = u.pn * 128 + cq; const f32x4 av = ax[0] * r, vv = ax[1] * r;
        *(f32x4*)(SAS + (size_t)(row - MPR) * 6144 + col) = av;
        *(u32x2*)(VB + (size_t)(u.pn >> 4) * ((size_t)MPAD * 2048) + (size_t)row * 2048 + (col & 2047)) = pack4(vv);
        *(f32x4*)(out + OFF_CONV_S + ((size_t)(row - MPR) * 2 + 1) * 6144 + col) = av;
    }
};
struct EpiPle { static constexpr bool MIDK = false; static constexpr bool FUSED = false;
    const float* rs2; const bf16_t* P; const bf16_t* X2; float* rs3; bf16_t* wout;
    __device__ __forceinline__ void operator()(EPI_ARGS) const {
        const int colh = wc * 32 + 8 * fq;
#pragma unroll
        for (int ai = 0; ai < 2; ++ai)
#pragma unroll
            for (int mp = 0; mp < 2; ++mp) { u32x4 pt[2][2], xt[2][2]; float rr[2];
#pragma unroll
                for (int mm = 0; mm < 2; ++mm) { const int m = 2 * mp + mm; rr[mm] = rs_rstd_main(rs2, EPI_ROW, fr, fq);
#pragma unroll
                    for (int bj = 0; bj < 2; ++bj) { const int col = u.pn * 256 + bj * 128 + colh; pt[mm][bj] = *(const u32x4*)(P + (size_t)EPI_ROW * 2048 + col);
                        xt[mm][bj] = *(const u32x4*)(X2 + (size_t)EPI_ROW * 2048 + col); } }
#pragma unroll
                for (int mm = 0; mm < 2; ++mm) { const int m = 2 * mp + mm; const int row = EPI_ROW; float ss = 0.f; const float r = rr[mm];
#pragma unroll
                    for (int bj = 0; bj < 2; ++bj) { const int col = u.pn * 256 + bj * 128 + colh; f32x4 p0, p1; unpack8(pt[mm][bj], p0, p1);
                        f32x4 v0, v1; unpack8(xt[mm][bj], v0, v1);
#pragma unroll
                        for (int j = 0; j < 4; ++j) { v0[j] += sigmoid_f(r * acc[ai][bj][m][0][j]) * p0[j]; v1[j] += sigmoid_f(r * acc[ai][bj][m][1][j]) * p1[j]; }
                        *(u32x4*)(wout + (size_t)row * 2048 + col) = pack8(v0, v1); ss += sumsq8(v0, v1); }
                    put_rowss(rs3, row, u.pn * 4 + wc, ss, fr, fq, true); }
                asm volatile("" ::: "memory"); }
    }
    __device__ __forceinline__ void x(XEPI_ARGS) const { XROW_SETUP
        float ss = 0.f; const float r = rs_rstd_x(rs2, valid ? row : MPR, fr, fq);
        if (valid) {
#pragma unroll
            for (int bj = 0; bj < 2; ++bj) { const int col = u.pn * 256 + bj * 128 + cq; const f32x4 p = unpack4(*(const u32x2*)(P + (size_t)row * 2048 + col));
                f32x4 v = unpack4(*(const u32x2*)(X2 + (size_t)row * 2048 + col));
#pragma unroll
                for (int j = 0; j < 4; ++j) v[j] += sigmoid_f(r * ax[bj][j]) * p[j];
                *(u32x2*)(wout + (size_t)row * 2048 + col) = pack4(v); ss += sumsq4(v); } }
        put_rowss(rs3, row, u.pn * 8 + wr * 4 + wc, ss, fr, fq, valid);
    }
};

#define XB_TMO      128
#define XB_XCNT(j)  (256  + 64 * (j))
#define XB_XSUB(j)  (1280 + 64 * (j))
#define XB_XGEN(j)  (2304 + 64 * (j))
#define XB_TOP      3328
#define XB_TOPGEN   3392
#define XB_PANEL(j) (3456 + 64 * (j))
#define XCD_BAR_WORDS 5504
#define XB_SPIN_CAP (1u << 22)
__device__ __forceinline__ unsigned xb_ld(unsigned* p)              { return __hip_atomic_load(p, __ATOMIC_RELAXED, __HIP_MEMORY_SCOPE_AGENT); }
__device__ __forceinline__ unsigned xb_add(unsigned* p, unsigned v) { return __hip_atomic_fetch_add(p, v, __ATOMIC_RELAXED, __HIP_MEMORY_SCOPE_AGENT); }
__device__ __forceinline__ unsigned xb_xcc_id() { return (unsigned)__builtin_amdgcn_s_getreg((3 << 11) | 20) & 0xFu; }
#define XB_SPIN(cond, bar) do { unsigned _sp = 0; while (cond) { __builtin_amdgcn_s_sleep(1); \
    if ((++_sp & 255u) == 0u) { if (xb_ld(&(bar)[XB_TMO])) break; if (_sp > XB_SPIN_CAP) { atomicAdd(&(bar)[XB_TMO], 1u); break; } } } } while (0)
struct XcdBarrier { unsigned* bar; unsigned x; volatile LAS unsigned* st; };
__device__ __forceinline__ void xcd_barrier_complete(unsigned* bar, unsigned x, unsigned G, unsigned& nloc, unsigned& nx) {
    unsigned sum, cnt, mine, sp = 0u;
    for (;;) {
        sum = 0u; cnt = 0u; mine = 0u;
#pragma unroll
        for (unsigned j = 0; j < 16; ++j) { const unsigned c = xb_ld(&bar[XB_XCNT(j)]); sum += c; cnt += (c > 0u) ? 1u : 0u; mine = (j == x) ? c : mine; }
        if (sum == G) break;
        __builtin_amdgcn_s_sleep(1);
        if ((++sp & 255u) == 0u) { if (xb_ld(&bar[XB_TMO])) break; if (sp > XB_SPIN_CAP) { atomicAdd(&bar[XB_TMO], 1u); break; } }
    }
    nloc = mine > 0u ? mine : 1u; nx = cnt > 0u ? cnt : 1u;
}
__device__ __forceinline__ void xcd_barrier(const XcdBarrier& b, bool leader, unsigned G) {
    asm volatile("s_waitcnt vmcnt(0)" ::: "memory");
    __syncthreads();
    if (leader) {
        unsigned* bar = b.bar;
        __builtin_amdgcn_s_waitcnt(0);
        unsigned nloc = b.st[0], nx = b.st[1];
        if (nloc == 0u) { xcd_barrier_complete(bar, b.x, G, nloc, nx); b.st[0] = nloc; b.st[1] = nx; }
        const unsigned old = xb_add(&bar[XB_XSUB(b.x)], 1u);
        const unsigned gen = old / nloc;
        if (old + 1u == (gen + 1u) * nloc) {
            __builtin_amdgcn_fence(__ATOMIC_RELEASE, "agent");
            asm volatile("s_waitcnt vmcnt(0)" ::: "memory");
            const unsigned og = xb_add(&bar[XB_TOP], 1u);
            const unsigned tg = og / nx;
            if (og + 1u == (tg + 1u) * nx) xb_add(&bar[XB_TOPGEN], 1u);
            else XB_SPIN(xb_ld(&bar[XB_TOPGEN]) == tg, bar);
            __builtin_amdgcn_fence(__ATOMIC_ACQUIRE, "agent");
            xb_add(&bar[XB_XGEN(b.x)], 1u);
            asm volatile("s_waitcnt vmcnt(0)" ::: "memory");
        } else {
            XB_SPIN(xb_ld(&bar[XB_XGEN(b.x)]) == gen, bar);
            __builtin_amdgcn_fence(__ATOMIC_ACQUIRE, "agent");
            asm volatile("s_waitcnt vmcnt(0)" ::: "memory");
        }
    }
    __syncthreads();
}

struct EpiPleF { static constexpr bool MIDK = false; static constexpr bool FUSED = true;
    const float* rs2; const bf16_t* P; const bf16_t* X2; float* rs3; float* out; const float* gf; unsigned* bar;
    template <bool XR>
    __device__ __forceinline__ void fused(f32x4 (&acc)[2][2][4][2], f32x4 (&accX)[4], const Unit& u, int wr, int wc, int fr0, int fq0, bool leader) const {
        int fr = fr0, fq = fq0; asm volatile("" : "+v"(fr), "+v"(fq));
        const int colh = wc * 32 + 8 * fq;
#pragma unroll
        for (int ai = 0; ai < 2; ++ai)
#pragma unroll
            for (int mp = 0; mp < 2; ++mp) { u32x4 pt[2][2], xt[2][2]; float rr[2];
#pragma unroll
                for (int mm = 0; mm < 2; ++mm) { const int m = 2 * mp + mm; rr[mm] = rs_rstd_main(rs2, EPI_ROW, fr, fq);
#pragma unroll
                    for (int bj = 0; bj < 2; ++bj) { const int col = u.pn * 256 + bj * 128 + colh; pt[mm][bj] = *(const u32x4*)(P + (size_t)EPI_ROW * 2048 + col);
                        xt[mm][bj] = *(const u32x4*)(X2 + (size_t)EPI_ROW * 2048 + col); } }
#pragma unroll
                for (int mm = 0; mm < 2; ++mm) { const int m = 2 * mp + mm; const int row = EPI_ROW; float ss = 0.f; const float r = rr[mm];
#pragma unroll
                    for (int bj = 0; bj < 2; ++bj) { f32x4 p0, p1; unpack8(pt[mm][bj], p0, p1);
                        f32x4 v0, v1; unpack8(xt[mm][bj], v0, v1);
#pragma unroll
                        for (int j = 0; j < 4; ++j) { v0[j] += sigmoid_f(r * acc[ai][bj][m][0][j]) * p0[j]; v1[j] += sigmoid_f(r * acc[ai][bj][m][1][j]) * p1[j]; }
                        acc[ai][bj][m][0] = v0; acc[ai][bj][m][1] = v1; ss += sumsq8(v0, v1); }
                    put_rowss(rs3, row, u.pn * 4 + wc, ss, fr, fq, true); }
                asm volatile("" ::: "memory"); }
        const bool xvalid = fr < 4; const int xrow = MPR + 4 * u.pm + fr;
        if constexpr (XR) {
#pragma unroll
            for (int n = 0; n < 2; ++n) { float ss = 0.f; const float r = rs_rstd_x(rs2, xvalid ? xrow : MPR, fr, fq);
                if (xvalid) {
#pragma unroll
                    for (int bj = 0; bj < 2; ++bj) { const int col = u.pn * 256 + bj * 128 + wc * 32 + 8 * fq + 4 * n; const f32x4 p = unpack4(*(const u32x2*)(P + (size_t)xrow * 2048 + col));
                        f32x4 v = unpack4(*(const u32x2*)(X2 + (size_t)xrow * 2048 + col));
#pragma unroll
                        for (int j = 0; j < 4; ++j) v[j] += sigmoid_f(r * accX[bj * 2 + n][j]) * p[j];
                        accX[bj * 2 + n] = v; ss += sumsq4(v); } }
                put_rowss(rs3, xrow, u.pn * 8 + n * 4 + wc, ss, fr, fq, xvalid); }
        }
        asm volatile("s_waitcnt vmcnt(0)" ::: "memory");
        __builtin_amdgcn_s_barrier();
        if (leader) {
            __builtin_amdgcn_fence(__ATOMIC_RELEASE, "agent");
            asm volatile("s_waitcnt vmcnt(0)" ::: "memory");
            unsigned* ctr = bar + XB_PANEL(u.pm);
            (void)xb_add(ctr, 1u);
            XB_SPIN(xb_ld(ctr) < 8u, bar);
            __builtin_amdgcn_fence(__ATOMIC_ACQUIRE, "agent");
            asm volatile("s_waitcnt vmcnt(0)" ::: "memory");
        }
        __builtin_amdgcn_s_barrier();
        asm volatile("" ::: "memory");
        { const float* gp = gf + u.pn * 256 + colh;
          const f32x4 g00 = *(const f32x4*)gp, g01 = *(const f32x4*)(gp + 4), g10 = *(const f32x4*)(gp + 128), g11 = *(const f32x4*)(gp + 132);
          EPI_FOR_ROWS { const int row = EPI_ROW; const float r = rs_rstd_main(rs3, row, fr, fq); float* o = out + (size_t)row * 2048 + u.pn * 256 + colh;
              *(f32x4*)o = acc[ai][0][m][0] * r * g00; *(f32x4*)(o + 4) = acc[ai][0][m][1] * r * g01; *(f32x4*)(o + 128) = acc[ai][1][m][0] * r * g10; *(f32x4*)(o + 132) = acc[ai][1][m][1] * r * g11; } }
        if constexpr (XR) {
            const float r = rs_rstd_x(rs3, xvalid ? xrow : MPR, fr, fq);
            if (xvalid) {
#pragma unroll
                for (int n = 0; n < 2; ++n)
#pragma unroll
                    for (int bj = 0; bj < 2; ++bj) { const int col = u.pn * 256 + bj * 128 + wc * 32 + 8 * fq + 4 * n;
                        *(f32x4*)(out + (size_t)xrow * 2048 + col) = accX[bj * 2 + n] * r * *(const f32x4*)(gf + col); } }
        }
    }
};

struct Args { const float* in[33]; float* out; unsigned char* ws; };
enum { I_XP = 0, I_XS, I_CPOOL, I_SRE, I_SIM, I_CCONV, I_PP, I_PS, I_GMIX, I_WIN, I_WPOOL, I_PSCALE, I_LRE, I_LIM, I_LOGDT, I_BRE, I_BIM, I_CRE, I_CIM, I_D,
       I_WGLU, I_WBP, I_WBS, I_WOUT, I_GFFN, I_WUP, I_WCONV, I_BCONV, I_WDOWN, I_GPLE, I_WPG, I_WPLE, I_GFINAL };

__device__ __forceinline__ void transpose_item(const float* W, int K, int N, bf16_t* WT, const float* kscale, LAS float* scr, int item, int lane, int ldw = 0) {
    if (ldw == 0) ldw = K;
    const int nblk = N >> 6, kb = item / nblk, nb = item - kb * nblk, k0 = kb * 64, n0 = nb * 64;
    const int c4 = (lane & 15) * 4, kr = lane >> 4;
    f32x4 v[16];
#pragma unroll
    for (int i = 0; i < 16; ++i) v[i] = __builtin_nontemporal_load((const f32x4*)(W + (size_t)(k0 + 4 * i + kr) * N + n0 + c4));
    if (kscale) {
#pragma unroll
        for (int i = 0; i < 16; ++i) v[i] = v[i] * kscale[k0 + 4 * i + kr]; }
#pragma unroll
    for (int i = 0; i < 16; ++i) { LAS float* s = scr + (4 * i + kr) * 65 + c4; s[0] = v[i][0]; s[1] = v[i][1]; s[2] = v[i][2]; s[3] = v[i][3]; }
    asm volatile("s_waitcnt lgkmcnt(0)" ::: "memory");
    const int c = lane & 7;
#pragma unroll
    for (int j = 0; j < 8; ++j) { const int n = (lane >> 3) + 8 * j; const LAS float* s = scr + (8 * c) * 65 + n;
        u32x4 o; o.x = cvt_pk_bf16(s[0 * 65], s[1 * 65]); o.y = cvt_pk_bf16(s[2 * 65], s[3 * 65]); o.z = cvt_pk_bf16(s[4 * 65], s[5 * 65]); o.w = cvt_pk_bf16(s[6 * 65], s[7 * 65]);
        *(u32x4*)(WT + (size_t)(n0 + n) * ldw + k0 + 8 * c) = o; }
    asm volatile("s_waitcnt lgkmcnt(0)" ::: "memory");
}


constexpr int TI_IN = 32 * 96, TI_LE = 4 * 32, TI_EARLY = TI_IN + TI_LE, TI_PL = 4 * 4 * 4, TI_G = 16 * 32, TI_O = 32 * 32, TI_U = 32 * 192, TI_DN = 96 * 32;
constexpr int TI_ALL = TI_EARLY + TI_PL + 3 * TI_G + TI_O + TI_U + TI_DN + TI_O;
#define TRANSPOSE_ITEMS(first, last) do { for (int it = (first) + gw; it < (last); it += NGW) { int r = it; \
        if (r < TI_IN) { transpose_item(a.in[I_WIN], 2048, 6144, W_IN, nullptr, scr, r, lane); continue; } r -= TI_IN; \
        if (r < TI_LE) { transpose_item(a.in[I_WPLE], 256, 2048, W_PLE, nullptr, scr, r, lane); continue; } r -= TI_LE; \
        if (r < TI_PL) { const int k = r >> 4; transpose_item(a.in[I_WPOOL] + (size_t)k * 65536, 256, 256, W_POOL + (size_t)k * 65536, nullptr, scr, r & 15, lane); continue; } r -= TI_PL; \
        if (r < TI_G) { transpose_item(a.in[I_WGLU], 1024, 2048, W_GLU, nullptr, scr, r, lane); continue; } r -= TI_G; \
        if (r < TI_G) { transpose_item(a.in[I_WBP], 1024, 2048, W_BP, nullptr, scr, r, lane, 2048); continue; } r -= TI_G; \
        if (r < TI_G) { transpose_item(a.in[I_WBS], 1024, 2048, W_BP + 1024, nullptr, scr, r, lane, 2048); continue; } r -= TI_G; \
        if (r < TI_O) { transpose_item(a.in[I_WOUT], 2048, 2048, W_OUT, nullptr, scr, r, lane); continue; } r -= TI_O; \
        if (r < TI_U) { transpose_item(a.in[I_WUP], 2048, 12288, W_UP, a.in[I_GFFN], scr, r, lane); continue; } r -= TI_U; \
        if (r < TI_DN) { const int pnl = r >> 10; transpose_item(a.in[I_WDOWN] + (size_t)pnl * 2048 * 2048, 2048, 2048, W_DOWN + (size_t)pnl * 2048 * 2048, nullptr, scr, r & 1023, lane); continue; } r -= TI_DN; \
        transpose_item(a.in[I_WPG], 2048, 2048, W_PG, a.in[I_GPLE], scr, r, lane); } } while (0)

template <bool FUSE_FINAL>
__global__ void __launch_bounds__(512, 2) fwd_kernel(Args a) {
    extern __shared__ __attribute__((aligned(16))) unsigned char smem[];
    cg::grid_group grid = cg::this_grid();
    LAS unsigned char* lds = (LAS unsigned char*)smem;
    const int G = gridDim.x, bid = blockIdx.x;
    const int wave_s = __builtin_amdgcn_readfirstlane((int)(threadIdx.x >> 6));
#define GRID_SYNC() do { const bool _ld = (wave_s == 0) && (lane_id() == 0); xcd_barrier(xbar, _ld, (unsigned)G); } while (0)
#define FRESH_IDS const int lane = lane_id(); const int wave = wave_s, tid = wave * 64 + lane; (void)tid;
    unsigned char* ws = a.ws; float* out = a.out;
    bf16_t* W_UP = (bf16_t*)(ws + WS_WUP); bf16_t* W_DOWN = (bf16_t*)(ws + WS_WDOWN); bf16_t* W_PG = (bf16_t*)(ws + WS_WPG); bf16_t* W_PLE = (bf16_t*)(ws + WS_WPLE);
    bf16_t* W_OUT = (bf16_t*)(ws + WS_WOUT); bf16_t* W_IN = (bf16_t*)(ws + WS_WIN); bf16_t* W_GLU = (bf16_t*)(ws + WS_WGLU); bf16_t* W_BP = (bf16_t*)(ws + WS_WBP);
    bf16_t* W_BS = (bf16_t*)(ws + WS_WBS); bf16_t* W_POOL = (bf16_t*)(ws + WS_WPOOL);
    bf16_t* Hb = (bf16_t*)(ws + WS_H); bf16_t* PBb = (bf16_t*)(ws + WS_PB); bf16_t* Pb = (bf16_t*)(ws + WS_P);
    bf16_t* Ub = (bf16_t*)(ws + WS_U); bf16_t* GATES = (bf16_t*)(ws + WS_GATES);
    f32x2* ABAR = (f32x2*)(ws + WS_U + 44 * MiB); f32x2* A16T = ABAR + 4096; f32x2* BBAR = ABAR + 8192;
    bf16_t* Ussm = (bf16_t*)(ws + WS_U + 20 * MiB); bf16_t* Usam = (bf16_t*)(ws + WS_U + 40 * MiB);
    bf16_t* DIFF = (bf16_t*)(ws + WS_DIFF); bf16_t* SSMACT = (bf16_t*)(ws + WS_SSMACT); bf16_t* YCAT = (bf16_t*)(ws + WS_YCAT);
 bf16_t* MERGED = (bf16_t*)(ws + WS_MERGED); bf16_t* X1B = (bf16_t*)(ws + WS_X1B);
    float* SAb = (float*)(ws + WS_ABUF + 40 * MiB);
    bf16_t* VBUF = (bf16_t*)(ws + WS_VBUF); bf16_t* X2B = (bf16_t*)(ws + WS_X2B);
    float* RS1 = (float*)(ws + WS_ROWSS); float* RS2 = RS1 + (size_t)MPAD * RS_SLOTS; float* RS3 = RS2 + (size_t)MPAD * RS_SLOTS;

    XcdBarrier xbar; xbar.bar = (unsigned*)(ws + WS_CTL); xbar.st = (volatile LAS unsigned*)(lds + LDS_BYTES - 16);
    { const int t0 = threadIdx.x; if (t0 < 2) xbar.st[t0] = 0u;
      if (gridDim.y == 0x7fffu) grid.sync();
      xbar.x = xb_xcc_id(); if (t0 == 0) (void)xb_add(&xbar.bar[XB_XCNT(xbar.x)], 1u); }
    {
    {
        FRESH_IDS
        const int gtid = bid * 512 + tid, GT = G * 512;
        if (bid < 256) {
            const int g = bid >> 2, q = bid & 3;
            LAS float* La = (LAS float*)lds;
            LAS float* Lap = (LAS float*)(lds + 512);
            LAS float* Lbb = (LAS float*)(lds + 9216);
            LAS float* Lcc = (LAS float*)(lds + 17408);
            bf16_t* PM = (bf16_t*)(ws + WS_PM) + (size_t)g * 128 * 256; bf16_t* QM = (bf16_t*)(ws + WS_QM) + (size_t)g * 256 * 128; bf16_t* KT = (bf16_t*)(ws + WS_KT) + (size_t)g * 4096;
            if (tid < 64) { const int p = tid;
                const float dt = expf(a.in[I_LOGDT][g]), lr = a.in[I_LRE][g * 64 + p], li = a.in[I_LIM][g * 64 + p];
                const float mag = expf(lr * dt), ar = mag * cosf(li * dt), ai = mag * sinf(li * dt);
                const float nr = ar - 1.0f, ni = ai, den = lr * lr + li * li, cr = (nr * lr + ni * li) / den, ci = (ni * lr - nr * li) / den;
                La[p * 2] = ar; La[p * 2 + 1] = ai;
                float wr_ = 1.f, wi_ = 0.f;
                for (int d = 0; d <= 16; ++d) { Lap[(d * 64 + p) * 2] = wr_; Lap[(d * 64 + p) * 2 + 1] = wi_; const float tr = wr_ * ar - wi_ * ai, ti = wr_ * ai + wi_ * ar; wr_ = tr; wi_ = ti; }
                for (int h = 0; h < 16; ++h) { const float br = a.in[I_BRE][(size_t)(g * 64 + p) * 16 + h], bi = a.in[I_BIM][(size_t)(g * 64 + p) * 16 + h];
                    Lbb[(p * 16 + h) * 2] = cr * br - ci * bi; Lbb[(p * 16 + h) * 2 + 1] = cr * bi + ci * br; } }
            for (int i = tid; i < 1024; i += 512) { Lcc[i * 2] = a.in[I_CRE][(size_t)g * 1024 + i]; Lcc[i * 2 + 1] = a.in[I_CIM][(size_t)g * 1024 + i]; }
            __syncthreads();
            if (q == 0) {
                if (tid < 64) { ABAR[g * 64 + tid] = *(const LAS f32x2*)(La + tid * 2); A16T[g * 64 + tid] = *(const LAS f32x2*)(Lap + (16 * 64 + tid) * 2); }
                for (int i = tid; i < 1024; i += 512) BBAR[(size_t)g * 1024 + i] = *(const LAS f32x2*)(Lbb + i * 2); }
            if (tid < 256) {
                const int hp = tid >> 4, h = tid & 15; float acc0 = 0.f, acc1 = 0.f, acc2 = 0.f, acc3 = 0.f;
                for (int p = 0; p < 64; ++p) { const f32x2 c = *(const LAS f32x2*)(Lcc + (hp * 64 + p) * 2), b = *(const LAS f32x2*)(Lbb + (p * 16 + h) * 2), w = *(const LAS f32x2*)(Lap + (4 * q * 64 + p) * 2), av = *(const LAS f32x2*)(La + p * 2);
                    const float mr = c[0] * b[0] - c[1] * b[1], mi = c[0] * b[1] + c[1] * b[0];
                    float zr = mr * w[0] - mi * w[1], zi = mr * w[1] + mi * w[0]; float t_;
                    acc0 += zr; t_ = zr * av[0] - zi * av[1]; zi = zr * av[1] + zi * av[0]; zr = t_;
                    acc1 += zr; t_ = zr * av[0] - zi * av[1]; zi = zr * av[1] + zi * av[0]; zr = t_;
                    acc2 += zr; t_ = zr * av[0] - zi * av[1]; zi = zr * av[1] + zi * av[0]; zr = t_;
                    acc3 += zr; }
                if (q == 0 && h == hp) acc0 += a.in[I_D][g * 16 + hp];
                bf16_t* k = KT + (size_t)(4 * q) * 256 + hp * 16 + h;
                k[0] = (bf16_t)(cvt_pk_bf16(acc0, 0.f) & 0xffffu); k[256] = (bf16_t)(cvt_pk_bf16(acc1, 0.f) & 0xffffu); k[512] = (bf16_t)(cvt_pk_bf16(acc2, 0.f) & 0xffffu); k[768] = (bf16_t)(cvt_pk_bf16(acc3, 0.f) & 0xffffu);
            }
            {
                const int pr = 32 * q + (tid >> 4), h = tid & 15, part = pr >> 6, p = pr & 63;
                const f32x2 b = *(const LAS f32x2*)(Lbb + (p * 16 + h) * 2);
                for (int s_ = 0; s_ < 16; ++s_) { const f32x2 w = *(const LAS f32x2*)(Lap + ((15 - s_) * 64 + p) * 2);
                    const float v = part ? (w[0] * b[1] + w[1] * b[0]) : (w[0] * b[0] - w[1] * b[1]);
                    PM[(size_t)pr * 256 + s_ * 16 + h] = (bf16_t)(cvt_pk_bf16(v, 0.f) & 0xffffu); } }
            {
                const int rloc = tid >> 3, tq = 4 * q + (rloc >> 4), hp = rloc & 15, pg = tid & 7; float vr[8], vi[8];
#pragma unroll
                for (int e = 0; e < 8; ++e) { const int p = pg * 8 + e; const f32x2 c = *(const LAS f32x2*)(Lcc + (hp * 64 + p) * 2), w = *(const LAS f32x2*)(Lap + ((tq + 1) * 64 + p) * 2);
                    vr[e] = c[0] * w[0] - c[1] * w[1]; vi[e] = -(c[0] * w[1] + c[1] * w[0]); }
                bf16_t* qrow = QM + (size_t)(tq * 16 + hp) * 128 + pg * 8;
                *(u32x4*)qrow = pack8((f32x4){vr[0], vr[1], vr[2], vr[3]}, (f32x4){vr[4], vr[5], vr[6], vr[7]});
                *(u32x4*)(qrow + 64) = pack8((f32x4){vi[0], vi[1], vi[2], vi[3]}, (f32x4){vi[4], vi[5], vi[6], vi[7]}); }
            __syncthreads();
        }
        LAS float* scr = (LAS float*)(lds + wave * 16640);
        const int gw = bid * 8 + wave, NGW = G * 8;
        TRANSPOSE_ITEMS(0, TI_EARLY);
        for (int row = gw; row < MPAD; row += NGW) {
            u32x2* o = (u32x2*)(Hb + (size_t)row * 2048) + lane;
            if (row < MT) {
                const float* xr = row < MPR ? a.in[I_XP] + (size_t)row * 2048 : a.in[I_XS] + (size_t)(row - MPR) * 2048;
                f32x4 v[8]; float s = 0.f;
#pragma unroll
                for (int j = 0; j < 8; ++j) { v[j] = *((const f32x4*)xr + lane + 64 * j); s += (v[j][0] * v[j][0] + v[j][1] * v[j][1]) + (v[j][2] * v[j][2] + v[j][3] * v[j][3]); }
                const float r = rsqrtf(wave_sum(s, lane) * (1.0f / 2048.0f) + EPS);
#pragma unroll
                for (int j = 0; j < 8; ++j) { const f32x4 gm = *((const f32x4*)a.in[I_GMIX] + lane + 64 * j); const f32x4 y = v[j] * r * gm; u32x2 w; w.x = cvt_pk_bf16(y[0], y[1]); w.y = cvt_pk_bf16(y[2], y[3]); o[64 * j] = w; }
            } else {
#pragma unroll
                for (int j = 0; j < 8; ++j) o[64 * j] = (u32x2){0u, 0u};
            }
        }
        for (int i = gtid; i < MPAD * 64; i += GT) { const int row = i >> 6, c4 = (i & 63) * 4; u32x2 w = (u32x2){0u, 0u};
            if (row < MT) { const float* pr = row < MPR ? a.in[I_PP] + (size_t)row * 256 : a.in[I_PS] + (size_t)(row - MPR) * 256; const f32x4 v = *(const f32x4*)(pr + c4); w.x = cvt_pk_bf16(v[0], v[1]); w.y = cvt_pk_bf16(v[2], v[3]); }
            *(u32x2*)(PBb + (size_t)row * 256 + c4) = w; }
    }
    GRID_SYNC();
    }

    {
    { pg8::Gemm g{Hb, W_IN, 2048, 2048, 2048, 32, 24, 0, 128, 256}; EpiZ E{Ub, Ussm, Usam, GATES, out}; pg8::gemm_phase(lds, g, G, bid, wave_s, E); }
    { pg8::Gemm g{PBb, W_PLE, 256, 256, 256, 32, 8, 0, 128, 256}; EpiBf E{Pb, 2048, nullptr}; pg8::gemm_phase(lds, g, G, bid, wave_s, E); }
    GRID_SYNC();
    }

    {
    {
        FRESH_IDS
#define POOL_LOADS(W, tile_, raw) do { const int r0_ = (tile_) * 16, t0_ = r0_ & 2047; const bf16_t* up_ = Ub + (size_t)r0_ * 1024 + c; \
            _Pragma("unroll") for (int j = 0; j < 15 + W; ++j) { const int dr = j - (W - 1); unsigned w_ = 0u; if (t0_ + dr >= 0) w_ = *(const unsigned*)(up_ + (long)dr * 1024); raw[j] = w_; } } while (0)
#define POOL_COMP(W, tile_, raw) do { const int r0_ = (tile_) * 16, t0_ = r0_ & 2047; f32x2 v[15 + W]; \
            _Pragma("unroll") for (int j = 0; j < 15 + W; ++j) v[j] = (f32x2){bf_lo(raw[j]), bf_hi(raw[j])}; \
            f32x2 sum = (f32x2){0.f, 0.f}; _Pragma("unroll") for (int j = 0; j < W - 1; ++j) sum += v[j]; \
            _Pragma("unroll") for (int i = 0; i < 16; ++i) { const int t = t0_ + i; const f32x2 cur = v[W - 1 + i]; sum += cur; \
                const float inv = 1.0f / (float)((t + 1) < W ? (t + 1) : W); const f32x2 d = sum * inv - cur; \
                *(unsigned*)(DIFF + (size_t)(r0_ + i) * 1024 + c) = cvt_pk_bf16(d[0], d[1]); sum -= v[i]; } } while (0)
#define POOL_ALL(W) do { \
            const bool has_s = bid < 128; const int ns = has_s ? bid : 0; f32x2 cr[15]; unsigned wc_ = 0u; \
            { const float* cp = a.in[I_CPOOL] + (size_t)ns * 15 * 1024 + c; \
              _Pragma("unroll") for (int j = 0; j < 15; ++j) cr[j] = has_s ? *(const f32x2*)(cp + (size_t)j * 1024) : (f32x2){0.f, 0.f}; \
              if (has_s) wc_ = *(const unsigned*)(Ub + (size_t)(MPR + ns) * 1024 + c); } \
            for (int tA = bid; tA < 512; tA += 2 * G) { const int tB = tA + G; const bool hasB = tB < 512; unsigned rawA[15 + W], rawB[15 + W]; \
                POOL_LOADS(W, tA, rawA); POOL_LOADS(W, hasB ? tB : tA, rawB); \
                POOL_COMP(W, tA, rawA); if (hasB) POOL_COMP(W, tB, rawB); } \
            if (has_s) { const f32x2 cur = (f32x2){bf_lo(wc_), bf_hi(wc_)}; f32x2 sum = cur; \
                _Pragma("unroll") for (int j = 16 - W; j <= 14; ++j) sum += cr[j]; \
                const f32x2 d = sum * (1.0f / (float)W) - cur; \
                *(unsigned*)(DIFF + (size_t)(MPR + ns) * 1024 + c) = cvt_pk_bf16(d[0], d[1]); \
                float* po = out + OFF_POOL_S + (size_t)ns * 15 * 1024 + c; \
                _Pragma("unroll") for (int j = 0; j < 14; ++j) *(f32x2*)(po + (size_t)j * 1024) = cr[j + 1]; } \
            for (int ns2 = bid + G; ns2 < 128; ns2 += G) {   \
                const float* cp = a.in[I_CPOOL] + (size_t)ns2 * 15 * 1024 + c; f32x2 c2[15]; \
                _Pragma("unroll") for (int j = 0; j < 15; ++j) c2[j] = *(const f32x2*)(cp + (size_t)j * 1024); \
                const unsigned w2 = *(const unsigned*)(Ub + (size_t)(MPR + ns2) * 1024 + c); const f32x2 cur = (f32x2){bf_lo(w2), bf_hi(w2)}; f32x2 sum = cur; \
                _Pragma("unroll") for (int j = 16 - W; j <= 14; ++j) sum += c2[j]; \
                const f32x2 d = sum * (1.0f / (float)W) - cur; \
                *(unsigned*)(DIFF + (size_t)(MPR + ns2) * 1024 + c) = cvt_pk_bf16(d[0], d[1]); \
                float* po = out + OFF_POOL_S + (size_t)ns2 * 15 * 1024 + c; \
                _Pragma("unroll") for (int j = 0; j < 14; ++j) *(f32x2*)(po + (size_t)j * 1024) = c2[j + 1]; } \
            } while (0)
        const bool conv_first = ((bid >> 3) & 1) != 0;
        if (conv_first) { const int lane = lane_id(); LAS float* scr = (LAS float*)(lds + wave * 16640); const int gw = bid * 8 + wave, NGW = G * 8; TRANSPOSE_ITEMS(TI_EARLY, TI_ALL); }
        __syncthreads();
        { const int c = 2 * tid, wsel = wave >> 1;
          if (wsel == 0) POOL_ALL(2); else if (wsel == 1) POOL_ALL(4); else if (wsel == 2) POOL_ALL(8); else POOL_ALL(16); }
#undef POOL_ALL
#undef POOL_COMP
#undef POOL_LOADS
        LAS float* Hl = (LAS float*)(lds + 131072) + wave * 512;
        const float* LRE = a.in[I_LRE]; const float* LIM = a.in[I_LIM]; const float* LOGDT = a.in[I_LOGDT];
        typedef float f32x16 __attribute__((ext_vector_type(16)));
        constexpr int UROW = 528;
        LAS unsigned char* UL = lds;
        LAS unsigned char* SL = lds + 128 * UROW;
        LAS unsigned char* KL = lds + 256 * UROW;
        for (int item = bid; item < 256; item += G) {
            const int n = item >> 6, g = item & 63;
            const bf16_t* PM = (const bf16_t*)(ws + WS_PM) + (size_t)g * 128 * 256; const bf16_t* QM = (const bf16_t*)(ws + WS_QM) + (size_t)g * 256 * 128; const bf16_t* KT = (const bf16_t*)(ws + WS_KT) + (size_t)g * 4096;
            const int li_ = lane & 31, kq = lane >> 5;
            u32x4 ut[8];
#pragma unroll
            for (int i = 0; i < 8; ++i) ut[i] = *((const u32x4*)(Ussm + (size_t)item * 2048 * 16) + tid + 512 * i);
            const u32x4 ktv = *(const u32x4*)(KT + tid * 8);
            bf16x8 pmf[16], qmf[8];
            { const bf16_t* pa = PM + (size_t)(32 * (wave & 3) + li_) * 256 + 8 * kq;
#pragma unroll
              for (int ks = 0; ks < 16; ++ks) pmf[ks] = *(const bf16x8*)(pa + 16 * ks); }
            float a16r = 0.f, a16i = 0.f;
            if (wave == 0) { const f32x2 a16 = A16T[g * 64 + lane]; a16r = a16[0]; a16i = a16[1]; }
            __syncthreads();
#pragma unroll
            for (int i = 0; i < 8; ++i) { const int idx = tid + 512 * i; *(LAS u32x4*)(UL + (idx >> 5) * UROW + (idx & 31) * 16) = ut[i]; }
            *(LAS u32x4*)(KL + tid * 16) = ktv;
            __syncthreads();
            {
                const int rb = wave & 3, cbp = wave >> 2; f32x16 s0, s1;
#pragma unroll
                for (int r = 0; r < 16; ++r) { s0[r] = 0.f; s1[r] = 0.f; }
                const LAS unsigned char* ub0 = UL + (64 * cbp + li_) * UROW + 16 * kq, * ub1 = ub0 + 32 * UROW;
#pragma unroll
                for (int ks = 0; ks < 16; ++ks) { const bf16x8 af = pmf[ks];
                    s0 = __builtin_amdgcn_mfma_f32_32x32x16_bf16(af, *(const LAS bf16x8*)(ub0 + 32 * ks), s0, 0, 0, 0);
                    s1 = __builtin_amdgcn_mfma_f32_32x32x16_bf16(af, *(const LAS bf16x8*)(ub1 + 32 * ks), s1, 0, 0, 0); }
                LAS unsigned char* sr0 = SL + (64 * cbp + li_) * UROW + (32 * rb + 4 * kq) * 4, * sr1 = sr0 + 32 * UROW;
#pragma unroll
                for (int rq = 0; rq < 4; ++rq) { *(LAS f32x4*)(sr0 + rq * 32) = (f32x4){s0[4 * rq], s0[4 * rq + 1], s0[4 * rq + 2], s0[4 * rq + 3]};
                                                 *(LAS f32x4*)(sr1 + rq * 32) = (f32x4){s1[4 * rq], s1[4 * rq + 1], s1[4 * rq + 2], s1[4 * rq + 3]}; }
            }
            { const bf16_t* qa = QM + (size_t)(32 * wave + li_) * 128 + 8 * kq;
#pragma unroll
              for (int kc = 0; kc < 8; ++kc) qmf[kc] = *(const bf16x8*)(qa + 16 * kc); }
            __syncthreads();
            if (wave == 0) {
                const int p = lane;
                float hr = 0.f, hi = 0.f;
#pragma unroll 8
                for (int c = 0; c < 128; ++c) { LAS unsigned char* row = SL + c * UROW;
                    const float sr = *(const LAS float*)(row + p * 4), si = *(const LAS float*)(row + 256 + p * 4);
                    const unsigned hb = cvt_pk_bf16(hr, hi);
                    *(LAS bf16_t*)(row + p * 2) = (bf16_t)(hb & 0xffffu); *(LAS bf16_t*)(row + 128 + p * 2) = (bf16_t)(hb >> 16);
                    const float nhr = a16r * hr - a16i * hi + sr, nhi = a16r * hi + a16i * hr + si; hr = nhr; hi = nhi; }
                out[OFF_RE_P + (size_t)(n * 64 + g) * 64 + p] = hr; out[OFF_IM_P + (size_t)(n * 64 + g) * 64 + p] = hi;
            }
            __syncthreads();
            {
                f32x16 y0, y1, y2, y3;
#pragma unroll
                for (int r = 0; r < 16; ++r) { y0[r] = 0.f; y1[r] = 0.f; y2[r] = 0.f; y3[r] = 0.f; }
                const int tq = 2 * wave + (li_ >> 4), hp = li_ & 15;
                const LAS unsigned char* ub = UL + li_ * UROW + 16 * kq;
                for (int ks = 0; ks <= 2 * wave + 1; ++ks) { const int d = tq - ks;
                    bf16x8 af = (bf16x8){0, 0, 0, 0, 0, 0, 0, 0}; if (d >= 0) af = *(const LAS bf16x8*)(KL + ((d * 16 + hp) * 16 + 8 * kq) * 2);
                    y0 = __builtin_amdgcn_mfma_f32_32x32x16_bf16(af, *(const LAS bf16x8*)(ub + 32 * ks), y0, 0, 0, 0);
                    y1 = __builtin_amdgcn_mfma_f32_32x32x16_bf16(af, *(const LAS bf16x8*)(ub + 32 * UROW + 32 * ks), y1, 0, 0, 0);
                    y2 = __builtin_amdgcn_mfma_f32_32x32x16_bf16(af, *(const LAS bf16x8*)(ub + 64 * UROW + 32 * ks), y2, 0, 0, 0);
                    y3 = __builtin_amdgcn_mfma_f32_32x32x16_bf16(af, *(const LAS bf16x8*)(ub + 96 * UROW + 32 * ks), y3, 0, 0, 0); }
                const LAS unsigned char* hb = SL + li_ * UROW + 16 * kq;
#pragma unroll
                for (int kc = 0; kc < 8; ++kc) { const bf16x8 af = qmf[kc];
                    y0 = __builtin_amdgcn_mfma_f32_32x32x16_bf16(af, *(const LAS bf16x8*)(hb + 32 * kc), y0, 0, 0, 0);
                    y1 = __builtin_amdgcn_mfma_f32_32x32x16_bf16(af, *(const LAS bf16x8*)(hb + 32 * UROW + 32 * kc), y1, 0, 0, 0);
                    y2 = __builtin_amdgcn_mfma_f32_32x32x16_bf16(af, *(const LAS bf16x8*)(hb + 64 * UROW + 32 * kc), y2, 0, 0, 0);
                    y3 = __builtin_amdgcn_mfma_f32_32x32x16_bf16(af, *(const LAS bf16x8*)(hb + 96 * UROW + 32 * kc), y3, 0, 0, 0); }
#define SSM_STORE(yv, cb) do { _Pragma("unroll") for (int rq = 0; rq < 4; ++rq) { f32x4 v = (f32x4){yv[4 * rq], yv[4 * rq + 1], yv[4 * rq + 2], yv[4 * rq + 3]}; \
                    _Pragma("unroll") for (int j = 0; j < 4; ++j) v[j] = gelu_tanh_f(v[j]); \
                    const int tok = 16 * (32 * (cb) + li_) + 2 * wave + (rq >> 1); \
                    *(u32x2*)(SSMACT + (size_t)(n * 2048 + tok) * 1024 + g * 16 + 8 * (rq & 1) + 4 * kq) = pack4(v); } } while (0)
                SSM_STORE(y0, 0); SSM_STORE(y1, 1); SSM_STORE(y2, 2); SSM_STORE(y3, 3);
#undef SSM_STORE
            }
        }
        __syncthreads();
        {
            const int lane = lane_id();
            const int gwv = bid * 8 + wave, g = gwv & 63, ns0 = (gwv >> 6) * 4, p = lane;
            if (gwv < 2048) {
                const f32x2 av = ABAR[g * 64 + p]; const float ar = av[0], ai = av[1];
                float Br[16], Bi[16];
#pragma unroll
                for (int q = 0; q < 8; ++q) { const f32x4 b = *((const f32x4*)(BBAR + (size_t)(g * 64 + p) * 16) + q); Br[2 * q] = b[0]; Bi[2 * q] = b[1]; Br[2 * q + 1] = b[2]; Bi[2 * q + 1] = b[3]; }
                const int hp = lane & 15, pq = lane >> 4;
                f32x4 Cr[4], Ci[4];
#pragma unroll
                for (int q = 0; q < 4; ++q) { Cr[q] = *(const f32x4*)(a.in[I_CRE] + (size_t)(g * 16 + hp) * 64 + pq * 16 + q * 4); Ci[q] = *(const f32x4*)(a.in[I_CIM] + (size_t)(g * 16 + hp) * 64 + pq * 16 + q * 4); }
                const float dsk = a.in[I_D][g * 16 + hp];
#pragma unroll
                for (int k = 0; k < 4; ++k) { const int ns = ns0 + k;
                    const bf16_t* ur = Usam + (size_t)ns * 1024 + g * 16; float bur = 0.f, bui = 0.f;
#pragma unroll
                    for (int q = 0; q < 4; ++q) { const f32x4 uv = unpack4(*(const u32x2*)(ur + q * 4));
#pragma unroll
                        for (int jj = 0; jj < 4; ++jj) { bur += Br[q * 4 + jj] * uv[jj]; bui += Bi[q * 4 + jj] * uv[jj]; } }
                    const float h0r = a.in[I_SRE][(size_t)(ns * 64 + g) * 64 + p], h0i = a.in[I_SIM][(size_t)(ns * 64 + g) * 64 + p];
                    const float hr = ar * h0r - ai * h0i + bur, hi = ar * h0i + ai * h0r + bui;
                    out[OFF_RE_S + (size_t)(ns * 64 + g) * 64 + p] = hr; out[OFF_IM_S + (size_t)(ns * 64 + g) * 64 + p] = hi;
                    *(LAS f32x2*)(Hl + k * 128 + p * 2) = (f32x2){hr, hi};
                    float y = 0.f;
#pragma unroll
                    for (int q = 0; q < 4; ++q)
#pragma unroll
                        for (int jj = 0; jj < 4; ++jj) { const f32x2 hv = *(const LAS f32x2*)(Hl + k * 128 + (pq * 16 + q * 4 + jj) * 2); y += Cr[q][jj] * hv[0] - Ci[q][jj] * hv[1]; }
                    y += shfl_xor_f(y, lane, 16); y += shfl_xor_f(y, lane, 32);
                    if (pq == 0) { y = gelu_tanh_f(y + dsk * bf_lo((unsigned)ur[hp])); SSMACT[(size_t)(MPR + ns) * 1024 + g * 16 + hp] = (bf16_t)(cvt_pk_bf16(y, 0.f) & 0xffffu); }
                }
            }
        }
        __syncthreads();
        if (!conv_first) { const int lane = lane_id(); LAS float* scr = (LAS float*)(lds + wave * 16640); const int gw = bid * 8 + wave, NGW = G * 8; TRANSPOSE_ITEMS(TI_EARLY, TI_ALL); }
}
    GRID_SYNC();
    }

    {
    { pg8::Gemm g{DIFF, W_POOL, 1024, 256, 256, 32, 4, 256, 128, 256}; EpiBf E{YCAT, 2048, a.in[I_PSCALE]}; pg8::gemm_phase(lds, g, G, bid, wave_s, E); }
    { pg8::Gemm g{SSMACT, W_GLU, 1024, 1024, 1024, 32, 8, 0, 1024, 128}; EpiGlu E{YCAT, 2048, 1024}; pg8::gemm_phase(lds, g, G, bid, wave_s, E); }
    GRID_SYNC();
    }

    {
    { pg8::Gemm g{YCAT, W_BP, 2048, 2048, 2048, 32, 8, 0, 128, 256}; EpiMerge E{GATES, MERGED}; pg8::gemm_phase(lds, g, G, bid, wave_s, E); }
    GRID_SYNC();
    }

    {
    { pg8::Gemm g{MERGED, W_OUT, 2048, 2048, 2048, 32, 8, 0, 128, 256}; EpiRes<false> E{a.in[I_XP], a.in[I_XS], nullptr, X1B, RS1}; pg8::gemm_phase(lds, g, G, bid, wave_s, E); }
    GRID_SYNC();
    }

    {
    { pg8::Gemm g{X1B, W_UP, 2048, 2048, 2048, 32, 48, 0, 6144, 128}; EpiUp E{RS1, VBUF, SAb, SAb + 128 * SA_BLK, out, a.in[I_WCONV], a.in[I_BCONV]}; pg8::gemm_phase(lds, g, G, bid, wave_s, E); }
    GRID_SYNC();
    }

    {
    {
        FRESH_IDS
        const float* WC = a.in[I_WCONV]; const float* BC = a.in[I_BCONV]; const float* CC = a.in[I_CCONV]; const float* SAS = SAb + 128 * SA_BLK;
        for (int id = bid * 512 + tid; id < (256 + 128) * 768; id += G * 512) {
            const int ri = id / 768, c0 = (id - ri * 768) * 8;
            const f32x4 w0a = *(const f32x4*)(WC + c0), w0b = *(const f32x4*)(WC + c0 + 4), w1a = *(const f32x4*)(WC + 6144 + c0), w1b = *(const f32x4*)(WC + 6144 + c0 + 4);
            const f32x4 w2a = *(const f32x4*)(WC + 12288 + c0), w2b = *(const f32x4*)(WC + 12288 + c0 + 4), bca = *(const f32x4*)(BC + c0), bcb = *(const f32x4*)(BC + c0 + 4);
            const f32x4 z4 = (f32x4){0.f, 0.f, 0.f, 0.f};
            f32x4 a0, a1, m1a = z4, m1b = z4, m2a = z4, m2b = z4; int row;
            if (ri < 256) { const int blk = ri >> 1, j = ri & 1; row = 64 * blk + j; const bool first = (blk & 31) == 0;
                const float* sb = SAb + (size_t)blk * SA_BLK + c0; a0 = *(const f32x4*)(sb + (size_t)j * 6144); a1 = *(const f32x4*)(sb + (size_t)j * 6144 + 4);
                const float* sp = sb - SA_BLK;
                if (j == 0) { if (!first) { m1a = *(const f32x4*)(sp + 3 * 6144); m1b = *(const f32x4*)(sp + 3 * 6144 + 4); m2a = *(const f32x4*)(sp + 2 * 6144); m2b = *(const f32x4*)(sp + 2 * 6144 + 4); } }
                else { m1a = *(const f32x4*)sb; m1b = *(const f32x4*)(sb + 4); if (!first) { m2a = *(const f32x4*)(sp + 3 * 6144); m2b = *(const f32x4*)(sp + 3 * 6144 + 4); } }
            } else { const int ns = ri - 256; row = MPR + ns; const float* c = CC + (size_t)ns * 2 * 6144 + c0;
                m2a = *(const f32x4*)c; m2b = *(const f32x4*)(c + 4); m1a = *(const f32x4*)(c + 6144); m1b = *(const f32x4*)(c + 6144 + 4);
                a0 = *(const f32x4*)(SAS + (size_t)ns * 6144 + c0); a1 = *(const f32x4*)(SAS + (size_t)ns * 6144 + c0 + 4);
                float* q = out + OFF_CONV_S + (size_t)ns * 2 * 6144 + c0; *(f32x4*)q = m1a; *(f32x4*)(q + 4) = m1b; }
            bf16_t* vp = VBUF + (size_t)(c0 >> 11) * ((size_t)MPAD * 2048) + (size_t)row * 2048 + (c0 & 2047); f32x4 v0, v1; unpack8(*(const u32x4*)vp, v0, v1);
            f32x4 ca = bca + w0a * m2a + w1a * m1a + w2a * a0, cb = bcb + w0b * m2b + w1b * m1b + w2b * a1;
#pragma unroll
            for (int j = 0; j < 4; ++j) { ca[j] = gelu_tanh_f(ca[j]) * v0[j]; cb[j] = gelu_tanh_f(cb[j]) * v1[j]; }
            *(u32x4*)vp = pack8(ca, cb);
        }
    }
    GRID_SYNC();
    }

    {
    { pg8::Gemm g{VBUF, W_DOWN, 2048, 2048, 6144, 32, 8, 0, 128, 256, 5, (unsigned)((size_t)MPAD * 2048 * 2), (unsigned)(2048u * 2048u * 2u)}; EpiRes<true> E{nullptr, nullptr, X1B, X2B, RS2}; pg8::gemm_phase(lds, g, G, bid, wave_s, E); }
    GRID_SYNC();
    }

    if constexpr (FUSE_FINAL) {
    { pg8::Gemm g{X2B, W_PG, 2048, 2048, 2048, 32, 8, 0, 128, 256}; EpiPleF E{RS2, Pb, X2B, RS3, out, a.in[I_GFINAL], xbar.bar}; pg8::gemm_phase(lds, g, G, bid, wave_s, E); }
    } else {
    {
    { pg8::Gemm g{X2B, W_PG, 2048, 2048, 2048, 32, 8, 0, 128, 256}; EpiPle E{RS2, Pb, X2B, RS3, X1B}; pg8::gemm_phase(lds, g, G, bid, wave_s, E); }
    GRID_SYNC();
    }
    { FRESH_IDS
    for (int row = bid * 8 + wave; row < MT; row += G * 8) {
        const float r = rsqrtf(wave_sum((row < MPR && lane >= 32) ? 0.f : RS3[(size_t)row * RS_SLOTS + lane], lane) * (1.0f / (float)DM) + EPS);
        const u32x4* xi = (const u32x4*)(X1B + (size_t)row * 2048) + lane; f32x4* o = (f32x4*)(out + (size_t)row * 2048) + 2 * lane;
#pragma unroll
        for (int j = 0; j < 4; ++j) { f32x4 v0, v1; unpack8(xi[64 * j], v0, v1); const f32x4 g0 = *((const f32x4*)a.in[I_GFINAL] + 2 * lane + 128 * j), g1 = *((const f32x4*)a.in[I_GFINAL] + 2 * lane + 128 * j + 1);
            o[128 * j] = v0 * r * g0; o[128 * j + 1] = v1 * r * g1; }
    } }
    }
}

extern "C" void kernel_launch(void* const* d_in, const int* in_sizes, int n_in, void* d_out, int out_size, void* d_ws, size_t ws_size, hipStream_t stream) {
    static int grid = 0; static const void* fn = nullptr;
    if (grid == 0) {
        if (n_in != 33 || ws_size < WS_END) { fprintf(stderr, "kernel_launch: unexpected n_in %d or ws_size %zu (< %zu)\n", n_in, ws_size, (size_t)WS_END); grid = -1; return; }
        int dev = 0, cus = 0, per_cu = 0;
        (void)hipGetDevice(&dev); (void)hipDeviceGetAttribute(&cus, hipDeviceAttributeMultiprocessorCount, dev);
        fn = cus == 256 ? (const void*)fwd_kernel<true> : (const void*)fwd_kernel<false>;
        if (hipFuncSetAttribute(fn, hipFuncAttributeMaxDynamicSharedMemorySize, LDS_BYTES) != hipSuccess) { fprintf(stderr, "kernel_launch: hipFuncSetAttribute failed\n"); grid = -1; return; }
        if (hipOccupancyMaxActiveBlocksPerMultiprocessor(&per_cu, fn, 512, LDS_BYTES) != hipSuccess || per_cu < 1) { fprintf(stderr, "kernel_launch: occupancy query says %d blocks/CU\n", per_cu); grid = -1; return; }
        grid = cus;
        fprintf(stderr, "kernel_launch: grid %d (per_cu %d), ws %zu\n", grid, per_cu, ws_size);
    }
    if (grid < 0) return;
    if (hipMemsetAsync((char*)d_ws + WS_CTL, 0, XCD_BAR_WORDS * sizeof(unsigned), stream) != hipSuccess) { fprintf(stderr, "kernel_launch: hipMemsetAsync of the barrier words failed\n"); return; }
    Args a{};
    for (int i = 0; i < 33; ++i) a.in[i] = (const float*)d_in[i];
    a.out = (float*)d_out; a.ws = (unsigned char*)d_ws;
    void* args[] = {&a};
    hipError_t e = hipLaunchCooperativeKernel(fn, dim3(grid), dim3(512), args, LDS_BYTES, stream);
    if (e != hipSuccess) fprintf(stderr, "kernel_launch: cooperative launch failed: %s\n", hipGetErrorString(e));
}
```

```cpp
#include <hip/hip_runtime.h>
#include <hip/hip_cooperative_groups.h>
#include <cstdio>
#include <cstdint>
namespace cg = cooperative_groups;

#define LAS __attribute__((address_space(3)))
typedef unsigned short bf16_t;
typedef short bf16x8 __attribute__((ext_vector_type(8)));
typedef float f32x4 __attribute__((ext_vector_type(4)));
typedef float f32x2 __attribute__((ext_vector_type(2)));
typedef unsigned u32x4 __attribute__((ext_vector_type(4)));
typedef unsigned u32x2 __attribute__((ext_vector_type(2)));

constexpr int DM = 2048, SEQ = 2048, NSMP = 128, MPR = 8192, MT = 8320, MPAD = 8448;
constexpr int DFF = 6144, DPLE = 256;
constexpr float EPS = 1e-6f;
constexpr size_t OFF_Y = 0;
constexpr size_t OFF_POOL_P = (size_t)MT * DM;
constexpr size_t OFF_RE_P = OFF_POOL_P + 4 * 15 * 1024;
constexpr size_t OFF_IM_P = OFF_RE_P + 4 * 64 * 64;
constexpr size_t OFF_CONV_P = OFF_IM_P + 4 * 64 * 64;
constexpr size_t OFF_POOL_S = OFF_CONV_P + 4 * 2 * 6144;
constexpr size_t OFF_RE_S = OFF_POOL_S + (size_t)128 * 15 * 1024;
constexpr size_t OFF_IM_S = OFF_RE_S + 128 * 64 * 64;
constexpr size_t OFF_CONV_S = OFF_IM_S + 128 * 64 * 64;
constexpr size_t MiB = 1u << 20;
constexpr size_t WS_WUP = 0, WS_WDOWN = 48 * MiB, WS_WPG = 72 * MiB, WS_WPLE = 80 * MiB, WS_WOUT = 81 * MiB, WS_WIN = 89 * MiB,
                 WS_WGLU = 113 * MiB, WS_WBP = 117 * MiB, WS_WBS = 121 * MiB, WS_WPOOL = 125 * MiB;
constexpr size_t WS_X1B = 89 * MiB;
constexpr size_t WS_P = 126 * MiB;
constexpr size_t WS_H = 159 * MiB, WS_PB = 192 * MiB;
constexpr size_t WS_U = 197 * MiB, WS_GATES = 263 * MiB;
constexpr size_t WS_DIFF = 329 * MiB, WS_SSMACT = WS_DIFF + (size_t)MPAD * 1024 * 2;
constexpr size_t WS_YCAT = 197 * MiB, WS_T1 = 197 * MiB, WS_MERGED = 329 * MiB;
constexpr size_t WS_ABUF = 159 * MiB, WS_VBUF = 258 * MiB, WS_X2B = 159 * MiB;
constexpr size_t WS_ROWSS = 372 * MiB, WS_CTL = 362 * MiB + 512 * 1024;
constexpr size_t WS_PM = 363 * MiB, WS_QM = 367 * MiB, WS_KT = 371 * MiB, WS_END = 379 * MiB;
constexpr int LDS_BYTES = 163840;

typedef __bf16 bf16x2_t __attribute__((ext_vector_type(2)));
__device__ __forceinline__ unsigned cvt_pk_bf16(float lo, float hi) { const f32x2 v = {lo, hi}; return __builtin_bit_cast(unsigned, __builtin_convertvector(v, bf16x2_t)); }
__device__ __forceinline__ float bf_lo(unsigned w) { return __uint_as_float(w << 16); }
__device__ __forceinline__ float bf_hi(unsigned w) { return __uint_as_float(w & 0xffff0000u); }
__device__ __forceinline__ float sigmoid_f(float x) { return __builtin_amdgcn_rcpf(1.0f + __builtin_amdgcn_exp2f(-1.4426950408889634f * x)); }
__device__ __forceinline__ float gelu_tanh_f(float x) { const float z = 1.5957691216057308f * (x + 0.044715f * x * x * x); return x * sigmoid_f(z); }
constexpr float GC1 = -(1.5957691216057308f * 1.4426950408889634f), GC2 = GC1 * 0.044715f;
__device__ __forceinline__ f32x2 gelu2(const f32x2 x) { const f32x2 t = x * x; const f32x2 u = t * GC2 + GC1; const f32x2 w = x * u;
    const f32x2 e = (f32x2){__builtin_amdgcn_exp2f(w[0]), __builtin_amdgcn_exp2f(w[1])} + 1.0f; return x * (f32x2){__builtin_amdgcn_rcpf(e[0]), __builtin_amdgcn_rcpf(e[1])}; }
__device__ __forceinline__ u32x4 pack8(const f32x4 a, const f32x4 b) { u32x4 w; w.x = cvt_pk_bf16(a[0], a[1]); w.y = cvt_pk_bf16(a[2], a[3]); w.z = cvt_pk_bf16(b[0], b[1]); w.w = cvt_pk_bf16(b[2], b[3]); return w; }
__device__ __forceinline__ void unpack8(const u32x4 w, f32x4& a, f32x4& b) { a = (f32x4){bf_lo(w.x), bf_hi(w.x), bf_lo(w.y), bf_hi(w.y)}; b = (f32x4){bf_lo(w.z), bf_hi(w.z), bf_lo(w.w), bf_hi(w.w)}; }
__device__ __forceinline__ float sumsq8(const f32x4 a, const f32x4 b) { return (a[0] * a[0] + a[1] * a[1]) + (a[2] * a[2] + a[3] * a[3]) + (b[0] * b[0] + b[1] * b[1]) + (b[2] * b[2] + b[3] * b[3]); }
__device__ __forceinline__ int lane_id() { int l; asm volatile("v_mbcnt_lo_u32_b32 %0, -1, 0\n\tv_mbcnt_hi_u32_b32 %0, -1, %0" : "=v"(l)); return l; }
__device__ __forceinline__ float shfl_xor_f(float v, int lane, int m) { return __int_as_float(__builtin_amdgcn_ds_bpermute((lane ^ m) << 2, __float_as_int(v))); }
constexpr int RS_SLOTS = 64;
__device__ __forceinline__ void put_rowss(float* rs, int row, int slot, float s, int fr, int fq, bool valid) {
    const int lane = fq * 16 + fr; s += shfl_xor_f(s, lane, 16); s += shfl_xor_f(s, lane, 32);
    if (fq == 0 && valid) rs[(size_t)row * RS_SLOTS + slot] = s;
}
__device__ __forceinline__ float rs_rstd_main(const float* rs, int row, int fr, int fq) {
    const f32x4 a = *(const f32x4*)(rs + (size_t)row * RS_SLOTS + 8 * fq), b = *(const f32x4*)(rs + (size_t)row * RS_SLOTS + 8 * fq + 4);
    float s = (a[0] + a[1]) + (a[2] + a[3]) + (b[0] + b[1]) + (b[2] + b[3]); const int lane = fq * 16 + fr;
    s += shfl_xor_f(s, lane, 16); s += shfl_xor_f(s, lane, 32);
    return rsqrtf(s * (1.0f / (float)DM) + EPS);
}
__device__ __forceinline__ float rs_rstd_x(const float* rs, int row, int fr, int fq) {
    float s = 0.f;
#pragma unroll
    for (int q = 0; q < 4; ++q) { const f32x4 a = *(const f32x4*)(rs + (size_t)row * RS_SLOTS + 16 * fq + 4 * q); s += (a[0] + a[1]) + (a[2] + a[3]); }
    const int lane = fq * 16 + fr; s += shfl_xor_f(s, lane, 16); s += shfl_xor_f(s, lane, 32);
    return rsqrtf(s * (1.0f / (float)DM) + EPS);
}
__device__ __forceinline__ float wave_sum(float v, int lane) {
#pragma unroll
    for (int o = 1; o < 64; o <<= 1) v += shfl_xor_f(v, lane, o);
    return v;
}

namespace pg8 {
constexpr int BM = 256, BK = 64, HALF = 128, HTB = HALF * BK * 2, STAGE_BYTES = 8 * HTB, NXCD = 8, WGM = 4;
__device__ __forceinline__ int lds_byte(int r, int c) { const int st = (r >> 4) * 2 + (c >> 5), rr = r & 15, cc = c & 31, ob = rr * 64 + cc * 2; return st * 1024 + (ob ^ (((ob >> 9) & 1) << 5)); }
__device__ __forceinline__ void stage_rc(int b, int& R, int& C) { const int st = b / 1024, sb = b % 1024, swz = sb ^ (((sb >> 9) & 1) << 5); R = (st >> 1) * 16 + swz / 64; C = (st & 1) * 32 + (swz % 64) / 2; }
__device__ __forceinline__ int perm32(int rho) { const int n = rho >> 4, i = rho & 15; return 8 * (i >> 2) + 4 * n + (i & 3); }
struct Unit { int pm, pn, ui; };
struct Gemm { const bf16_t* A; const bf16_t* B; int lda, ldb, K, nM, nN, a_koff, b_half_rows, b_tile_rows; int kp_shift; unsigned a_pstride, b_pstride; };
struct StaticOrder {
    int nM, nN, nwg, G, c;
    __device__ __forceinline__ void init(int nM_, int nN_, int G_, int c_) { nM = nM_; nN = nN_; nwg = nM * nN; G = G_; c = c_; }
    __device__ __forceinline__ bool next(int i, Unit& u) const {
        const long L = (long)i * G + c; if (L >= nwg) return false;
        int wgid = (int)L; { const int q = nwg / NXCD, r = nwg % NXCD, xcd = wgid % NXCD, off = wgid / NXCD; wgid = (xcd < r ? xcd * (q + 1) : r * (q + 1) + (xcd - r) * q) + off; }
        const int nig = WGM * nN, gid = wgid / nig, fm = gid * WGM, gsz = (nM - fm) < WGM ? (nM - fm) : WGM;
        u.pm = fm + ((wgid % nig) % gsz); u.pn = (wgid % nig) / gsz; u.ui = i; return true;
    }
};

template <class Epi, bool XROWS_, int WR>
__device__ __forceinline__ void gemm_phase_wr(LAS unsigned char* lds, const Gemm g, int G, int cidx, int wave_s, const Epi& E) {
    const int lane = lane_id();
    constexpr int wr = WR;
    constexpr bool XROWS = XROWS_ && WR == 1;
    const int wid = wave_s, tid = wid * 64 + lane, wc = wid & 3, fr = lane & 15, fq = lane >> 4;
    int K = g.K; asm volatile("" : "+s"(K));
    const int nt = K / BK;
    StaticOrder S; S.init(g.nM, g.nN, G, cidx);
    unsigned voffA[2], voffB[2];
#pragma unroll
    for (int i = 0; i < 2; ++i) { int R, C; stage_rc(tid * 16 + i * 8192, R, C); const int Rb = (R & ~31) + perm32(R & 31);
        voffA[i] = (unsigned)(R * g.lda + C) * 2u; voffB[i] = (unsigned)(Rb * g.ldb + C) * 2u; }
    const unsigned kstep = (unsigned)(BK * 2);
    const unsigned kps = g.kp_shift > 0 ? (unsigned)g.kp_shift : 31u, kpm = (1u << kps) - 1u;
    const unsigned hstepA = (unsigned)HALF * g.lda * 2u, tstepA = 2u * hstepA, kofA = (unsigned)g.a_koff * 2u;
    const unsigned hstepB = (unsigned)g.b_half_rows * g.ldb * 2u, tstepB = (unsigned)g.b_tile_rows * g.ldb * 2u;
    const __amdgpu_buffer_rsrc_t rsA = __builtin_amdgcn_make_buffer_rsrc((void*)g.A, (short)0, 0x7fffffff, 0x00020000);
    const __amdgpu_buffer_rsrc_t rsB = __builtin_amdgcn_make_buffer_rsrc((void*)g.B, (short)0, 0x7fffffff, 0x00020000);
    const unsigned ldsw = (unsigned)wid * 1024u;
    const int aoff = lds_byte(wr * 64 + fr, fq * 8), boff = lds_byte(wc * 32 + fr, fq * 8);
    const unsigned voffX = (unsigned)(fr * g.lda + fq * 8) * 2u;
    const unsigned xrow0 = (unsigned)MPR * g.lda * 2u, xstep = 4u * g.lda * 2u;
#define PG8_SA(b, h) (((b) * 2 + (h)) * HTB)
#define PG8_SB(b, h) ((4 + (b) * 2 + (h)) * HTB)
#define PG8_STAGE(bufoff, rs, soff, voff) do { _Pragma("unroll") for (int _i = 0; _i < 2; ++_i) \
        __builtin_amdgcn_raw_ptr_buffer_load_lds(rs, (LAS unsigned*)(lds + (bufoff) + ldsw + _i * 8192), 16, (voff)[_i], (soff), 0, 0); } while (0)
#define PG8_LDA(dst, b, h) do { _Pragma("unroll") for (int m = 0; m < 4; ++m) _Pragma("unroll") for (int k = 0; k < 2; ++k) dst[m][k] = *(const LAS bf16x8*)(lds + PG8_SA(b, h) + aoff + m * 2048 + k * 1024); } while (0)
#define PG8_LDB(dst, b, h) do { _Pragma("unroll") for (int n = 0; n < 2; ++n) _Pragma("unroll") for (int k = 0; k < 2; ++k) dst[n][k] = *(const LAS bf16x8*)(lds + PG8_SB(b, h) + boff + n * 2048 + k * 1024); } while (0)
#define PG8_MMA(ai, bj, At, Bt) do { __builtin_amdgcn_s_setprio(1); _Pragma("unroll") for (int m = 0; m < 4; ++m) _Pragma("unroll") for (int n = 0; n < 2; ++n) _Pragma("unroll") for (int k = 0; k < 2; ++k) \
        acc[ai][bj][m][n] = __builtin_amdgcn_mfma_f32_16x16x32_bf16(Bt[n][k], At[m][k], acc[ai][bj][m][n], 0, 0, 0); __builtin_amdgcn_s_setprio(0); } while (0)
#define PG8_LOADX(dst, soff) do { if (XROWS) { _Pragma("unroll") for (int k = 0; k < 2; ++k) dst[k] = __builtin_bit_cast(bf16x8, __builtin_amdgcn_raw_buffer_load_b128(rsA, voffX + k * 64, (soff), 0)); } } while (0)
#define PG8_MMAX(Xf) do { if (!XROWS) break; __builtin_amdgcn_s_setprio(1); _Pragma("unroll") for (int k = 0; k < 2; ++k) _Pragma("unroll") for (int n = 0; n < 2; ++n) { \
        accX[n] = __builtin_amdgcn_mfma_f32_16x16x32_bf16(B0[n][k], Xf[k], accX[n], 0, 0, 0); accX[2 + n] = __builtin_amdgcn_mfma_f32_16x16x32_bf16(B1[n][k], Xf[k], accX[2 + n], 0, 0, 0); } __builtin_amdgcn_s_setprio(0); } while (0)
#define PG8_WAIT_V(n) asm volatile("s_waitcnt vmcnt(" #n ")" ::: "memory")
#define PG8_WAITV_SP2 do { if constexpr (XROWS) PG8_WAIT_V(10); else PG8_WAIT_V(8); } while (0)
#define PG8_WAIT_L(n) asm volatile("s_waitcnt lgkmcnt(" #n ")" ::: "memory")
#define PG8_BAR __builtin_amdgcn_s_barrier()
#define PG8_SCHED __builtin_amdgcn_sched_barrier(0)
    Unit cur, nxt; int ui = 0;
    if (!S.next(0, cur)) return;
    f32x4 acc[2][2][4][2];
#pragma unroll
    for (int a = 0; a < 2; ++a)
#pragma unroll
        for (int b = 0; b < 2; ++b)
#pragma unroll
            for (int m = 0; m < 4; ++m)
#pragma unroll
                for (int n = 0; n < 2; ++n) acc[a][b][m][n] = (f32x4){0.f, 0.f, 0.f, 0.f};
    bf16x8 At[4][2], B0[2][2], B1[2][2], XA[2];
    f32x4 accX[4]; accX[0] = (f32x4){0.f, 0.f, 0.f, 0.f}; accX[1] = accX[0]; accX[2] = accX[0]; accX[3] = accX[0];
    unsigned cA = (unsigned)cur.pm * tstepA + (unsigned)cur.pn * kofA, cB = (unsigned)cur.pn * tstepB;
    unsigned cX = xrow0 + (unsigned)cur.pm * xstep + (unsigned)cur.pn * kofA;
    PG8_LOADX(XA, cX);
    PG8_STAGE(PG8_SB(0, 0), rsB, cB, voffB); PG8_STAGE(PG8_SB(0, 1), rsB, cB + hstepB, voffB); PG8_STAGE(PG8_SA(0, 0), rsA, cA, voffA); PG8_STAGE(PG8_SA(0, 1), rsA, cA + hstepA, voffA);
    if (wr == 1) PG8_BAR;
    PG8_WAIT_V(2); PG8_BAR;
    PG8_STAGE(PG8_SB(1, 0), rsB, cB + kstep, voffB); PG8_STAGE(PG8_SA(1, 0), rsA, cA + kstep, voffA); PG8_STAGE(PG8_SB(1, 1), rsB, cB + hstepB + kstep, voffB);
    PG8_WAIT_V(6); PG8_BAR;
    for (;;) {
        const bool has_next = S.next(ui + 1, nxt);
        const unsigned nA = has_next ? (unsigned)nxt.pm * tstepA + (unsigned)nxt.pn * kofA : cA, nB = has_next ? (unsigned)nxt.pn * tstepB : cB;
        const unsigned nX = has_next ? xrow0 + (unsigned)nxt.pm * xstep + (unsigned)nxt.pn * kofA : cX;
        for (int seg = 0; seg < (Epi::MIDK ? 2 : 1); ++seg) {
        const int tbeg = (Epi::MIDK && seg == 1) ? (nt >> 1) : 0, tend = (Epi::MIDK && seg == 0) ? (nt >> 1) : nt;
        if constexpr (Epi::MIDK) { if (seg == 1) E.mid(acc, accX, cur, wr, wc, fr, fq); }
        for (int t = tbeg; t < tend; t += 2) {
            const bool last = (t == nt - 2);
            const unsigned t1 = (unsigned)(t + 1), t2 = (unsigned)(t + 2);
            const unsigned ko1 = (t1 & kpm) * kstep, ko2 = (t2 & kpm) * kstep, pa1 = (t1 >> kps) * g.a_pstride, pa2 = (t2 >> kps) * g.a_pstride, pb2 = (t2 >> kps) * g.b_pstride;
            const unsigned a1 = cA + pa1 + ko1, x1 = cX + pa1 + ko1;
            const unsigned a2 = last ? nA : cA + pa2 + ko2, b2 = last ? nB : cB + pb2 + ko2;
            const unsigned a3 = a2 + kstep, b3 = b2 + kstep, x2 = last ? nX : cX + pa2 + ko2;
            PG8_LDB(B0, 0, 0); PG8_LDB(B1, 0, 1); PG8_SCHED; PG8_LDA(At, 0, 0); PG8_STAGE(PG8_SA(1, 1), rsA, a1 + hstepA, voffA);
            PG8_WAIT_V(8); PG8_WAIT_L(0); PG8_BAR; PG8_MMA(0, 0, At, B0); PG8_MMA(0, 1, At, B1); PG8_MMAX(XA); PG8_LOADX(XA, x1); PG8_BAR; PG8_SCHED;
            PG8_LDA(At, 0, 1); PG8_STAGE(PG8_SB(0, 0), rsB, b2, voffB); PG8_STAGE(PG8_SB(0, 1), rsB, b2 + hstepB, voffB); PG8_STAGE(PG8_SA(0, 0), rsA, a2, voffA);
            PG8_WAITV_SP2; PG8_WAIT_L(0); PG8_BAR; PG8_MMA(1, 0, At, B0); PG8_MMA(1, 1, At, B1); PG8_BAR; PG8_SCHED;
            PG8_LDB(B0, 1, 0); PG8_LDB(B1, 1, 1); PG8_SCHED; PG8_LDA(At, 1, 0); PG8_STAGE(PG8_SA(0, 1), rsA, a2 + hstepA, voffA);
            PG8_WAIT_V(8); PG8_WAIT_L(0); PG8_BAR; PG8_MMA(0, 0, At, B0); PG8_MMA(0, 1, At, B1); PG8_MMAX(XA); PG8_LOADX(XA, x2); PG8_BAR; PG8_SCHED;
            PG8_LDA(At, 1, 1); PG8_STAGE(PG8_SB(1, 0), rsB, b3, voffB); PG8_STAGE(PG8_SB(1, 1), rsB, b3 + hstepB, voffB); PG8_STAGE(PG8_SA(1, 0), rsA, a3, voffA);
            PG8_WAITV_SP2; PG8_WAIT_L(0); PG8_BAR; PG8_MMA(1, 0, At, B0); PG8_MMA(1, 1, At, B1); PG8_BAR; PG8_SCHED;
        }
        }
        if (wr == 0) PG8_BAR;
        if constexpr (Epi::FUSED) { E.template fused<XROWS>(acc, accX, cur, wr, wc, fr, fq, tid == 0); }
        else {
        if constexpr (XROWS) { { const f32x4 ax2[2] = {accX[0], accX[2]}; E.x(ax2, cur, 0, wc, fr, fq); } { const f32x4 ax3[2] = {accX[1], accX[3]}; E.x(ax3, cur, 1, wc, fr, fq); } }
        E(acc, cur, wr, wc, fr, fq);
        }
        if (!has_next) break;
        accX[0] = (f32x4){0.f, 0.f, 0.f, 0.f}; accX[1] = accX[0]; accX[2] = accX[0]; accX[3] = accX[0];
#pragma unroll
        for (int a = 0; a < 2; ++a)
#pragma unroll
            for (int b = 0; b < 2; ++b)
#pragma unroll
                for (int m = 0; m < 4; ++m)
#pragma unroll
                    for (int n = 0; n < 2; ++n) acc[a][b][m][n] = (f32x4){0.f, 0.f, 0.f, 0.f};
        cur = nxt; cA = nA; cB = nB; cX = nX; ++ui;
        if (wr == 1) PG8_BAR;
    }
    PG8_WAIT_V(0);
    PG8_BAR;
#undef PG8_SA
#undef PG8_SB
#undef PG8_STAGE
#undef PG8_LDA
#undef PG8_LDB
#undef PG8_MMA
#undef PG8_LOADX
#undef PG8_MMAX
#undef PG8_WAIT_V
#undef PG8_WAITV_SP2
#undef PG8_WAIT_L
#undef PG8_BAR
#undef PG8_SCHED
}
template <class Epi, bool XROWS = true>
__device__ __forceinline__ void gemm_phase(LAS unsigned char* lds, const Gemm g, int G, int cidx, int wave_s, const Epi& E) {
    if (wave_s < 4) gemm_phase_wr<Epi, XROWS, 0>(lds, g, G, cidx, wave_s, E); else gemm_phase_wr<Epi, XROWS, 1>(lds, g, G, cidx, wave_s, E);
}
}
using pg8::Unit;

#define EPI_ARGS const f32x4 (&acc)[2][2][4][2], const Unit& u, int wr, int wc, int fr, int fq
#define EPI_FOR_ROWS _Pragma("unroll") for (int ai = 0; ai < 2; ++ai) _Pragma("unroll") for (int m = 0; m < 4; ++m)
#define EPI_ROW (u.pm * 256 + ai * 128 + wr * 64 + m * 16 + fr)

#define XROW_SETUP const bool valid = fr < 4; const int row = MPR + 4 * u.pm + fr; const int cq = wc * 32 + 8 * fq + 4 * wr; (void)valid; (void)row; (void)cq;
__device__ __forceinline__ u32x2 pack4(const f32x4 a) { u32x2 w; w.x = cvt_pk_bf16(a[0], a[1]); w.y = cvt_pk_bf16(a[2], a[3]); return w; }
__device__ __forceinline__ f32x4 unpack4(const u32x2 w) { return (f32x4){bf_lo(w.x), bf_hi(w.x), bf_lo(w.y), bf_hi(w.y)}; }
__device__ __forceinline__ float sumsq4(const f32x4 a) { return (a[0] * a[0] + a[1] * a[1]) + (a[2] * a[2] + a[3] * a[3]); }
#define XEPI_ARGS const f32x4 (&ax)[2], const Unit& u, int wr, int wc, int fr, int fq

struct EpiZ { static constexpr bool MIDK = false; static constexpr bool FUSED = false;
    bf16_t* U; bf16_t* US; bf16_t* UX; bf16_t* GATES; float* out;
    static __device__ __forceinline__ void gate_pair(const f32x4 gp, const f32x4 gs, f32x4& ratio, f32x4& sg) {
#pragma unroll
        for (int j = 0; j < 4; ++j) { const float ea = __builtin_amdgcn_exp2f(-1.4426950408889634f * gp[j]), eb = fminf(__builtin_amdgcn_exp2f(-1.4426950408889634f * gs[j]), 1e20f), db = 1.0f + eb;
            sg[j] = __builtin_amdgcn_rcpf(db); ratio[j] = db * __builtin_amdgcn_rcpf(1.0f + ea); } }
    __device__ __forceinline__ void operator()(EPI_ARGS) const {
        const int colh = wc * 32 + 8 * fq;
        if (u.pn < 8) {
            EPI_FOR_ROWS { const int row = EPI_ROW;
#pragma unroll
                for (int bj = 0; bj < 2; ++bj) { const int col = u.pn * 256 + bj * 128 + colh;
                    bf16_t* dst = u.pn < 4 ? U + (size_t)row * 1024 + col : US + (((size_t)((row >> 11) * 64 + ((col - 1024) >> 4)) * 2048 + (row & 2047)) * 16 + (col & 8));
                    *(u32x4*)dst = pack8(acc[ai][bj][m][0], acc[ai][bj][m][1]);
                    if (u.pn < 4) { const int t = row & 2047;
                        if (t >= 2033) { float* q = out + OFF_POOL_P + ((size_t)((row >> 11) * 15 + (t - 2033))) * 1024 + col; *(f32x4*)q = acc[ai][bj][m][0]; *(f32x4*)(q + 4) = acc[ai][bj][m][1]; } } } }
        } else {
            EPI_FOR_ROWS { const int row = EPI_ROW; const int col = (u.pn - 8) * 128 + colh; f32x4 r0, r1, s0, s1;
                gate_pair(acc[ai][0][m][0], acc[ai][1][m][0], r0, s0); gate_pair(acc[ai][0][m][1], acc[ai][1][m][1], r1, s1);
                *(u32x4*)(GATES + (size_t)row * 4096 + col) = pack8(r0, r1); *(u32x4*)(GATES + (size_t)row * 4096 + 2048 + col) = pack8(s0, s1); }
        }
    }
    __device__ __forceinline__ void x(XEPI_ARGS) const { XROW_SETUP
        if (!valid) return;
#pragma unroll
        for (int bj = 0; bj < 2; ++bj) { const int col = u.pn * 256 + bj * 128 + cq;
            if (u.pn < 8) { *(u32x2*)(u.pn < 4 ? U + (size_t)row * 1024 + col : UX + (size_t)(row - MPR) * 1024 + (col - 1024)) = pack4(ax[bj]); if (u.pn < 4) *(f32x4*)(out + OFF_POOL_S + ((size_t)(row - MPR) * 15 + 14) * 1024 + col) = ax[bj]; }
            else if (bj == 0) { const int c = (u.pn - 8) * 128 + cq; f32x4 r, sg; gate_pair(ax[0], ax[1], r, sg);
                *(u32x2*)(GATES + (size_t)row * 4096 + c) = pack4(r); *(u32x2*)(GATES + (size_t)row * 4096 + 2048 + c) = pack4(sg); } }
    }
};
struct EpiBf { static constexpr bool MIDK = false; static constexpr bool FUSED = false;
    bf16_t* O; int ldo; const float* cscale;
    __device__ __forceinline__ void operator()(EPI_ARGS) const {
        const int colh = wc * 32 + 8 * fq;
#pragma unroll
        for (int bj = 0; bj < 2; ++bj) { const int col = u.pn * 256 + bj * 128 + colh;
            f32x4 s0 = (f32x4){1.f, 1.f, 1.f, 1.f}, s1 = s0; if (cscale) { s0 = *(const f32x4*)(cscale + col); s1 = *(const f32x4*)(cscale + col + 4); }
            EPI_FOR_ROWS { const int row = EPI_ROW; *(u32x4*)(O + (size_t)row * ldo + col) = pack8(acc[ai][bj][m][0] * s0, acc[ai][bj][m][1] * s1); } }
    }
    __device__ __forceinline__ void x(XEPI_ARGS) const { XROW_SETUP
        if (!valid) return;
#pragma unroll
        for (int bj = 0; bj < 2; ++bj) { const int col = u.pn * 256 + bj * 128 + cq; f32x4 v = ax[bj]; if (cscale) v = v * *(const f32x4*)(cscale + col);
            *(u32x2*)(O + (size_t)row * ldo + col) = pack4(v); }
    }
};
struct EpiGlu { static constexpr bool MIDK = false; static constexpr bool FUSED = false;
    bf16_t* O; int ldo; int coff;
    __device__ __forceinline__ void operator()(EPI_ARGS) const {
        const int col = coff + u.pn * 128 + wc * 32 + 8 * fq;
        EPI_FOR_ROWS { const int row = EPI_ROW; f32x4 v0 = acc[ai][0][m][0], v1 = acc[ai][0][m][1]; const f32x4 g0 = acc[ai][1][m][0], g1 = acc[ai][1][m][1];
#pragma unroll
            for (int j = 0; j < 4; ++j) { v0[j] *= sigmoid_f(g0[j]); v1[j] *= sigmoid_f(g1[j]); }
            *(u32x4*)(O + (size_t)row * ldo + col) = pack8(v0, v1); }
    }
    __device__ __forceinline__ void x(XEPI_ARGS) const { XROW_SETUP
        if (!valid) return;
        f32x4 v = ax[0];
#pragma unroll
        for (int j = 0; j < 4; ++j) v[j] *= sigmoid_f(ax[1][j]);
        *(u32x2*)(O + (size_t)row * ldo + coff + u.pn * 128 + cq) = pack4(v);
    }
};
struct EpiMerge { static constexpr bool MIDK = true; static constexpr bool FUSED = false;
    const bf16_t* GATES; bf16_t* MERGED;
    static __device__ __forceinline__ f32x4 clampg(f32x4 g) { return (f32x4){fmaxf(g[0], 1e-20f), fmaxf(g[1], 1e-20f), fmaxf(g[2], 1e-20f), fmaxf(g[3], 1e-20f)}; }
    static __device__ __forceinline__ f32x4 rcp4(f32x4 g) { return (f32x4){__builtin_amdgcn_rcpf(g[0]), __builtin_amdgcn_rcpf(g[1]), __builtin_amdgcn_rcpf(g[2]), __builtin_amdgcn_rcpf(g[3])}; }
    __device__ __forceinline__ void mid(f32x4 (&acc)[2][2][4][2], f32x4 (&ax)[4], const Unit& u, int wr, int wc, int fr0, int fq) const {
        int fr = fr0; asm volatile("" : "+v"(fr));
        const int colh = wc * 32 + 8 * fq;
#pragma unroll
        for (int ai = 0; ai < 2; ++ai)
#pragma unroll
            for (int m = 0; m < 4; ++m) { u32x4 gp[2];
#pragma unroll
                for (int bj = 0; bj < 2; ++bj) gp[bj] = __builtin_nontemporal_load((const u32x4*)(GATES + (size_t)EPI_ROW * 4096 + u.pn * 256 + bj * 128 + colh));
#pragma unroll
                for (int bj = 0; bj < 2; ++bj) { f32x4 p0, p1; unpack8(gp[bj], p0, p1);
                    acc[ai][bj][m][0] = acc[ai][bj][m][0] * p0; acc[ai][bj][m][1] = acc[ai][bj][m][1] * p1; }
                if (m & 1) asm volatile("" ::: "memory"); }
        if (wr == 0) return;
        const int row = MPR + 4 * u.pm + (fr & 3);
#pragma unroll
        for (int bj = 0; bj < 2; ++bj)
#pragma unroll
            for (int n = 0; n < 2; ++n) { const bf16_t* gr = GATES + (size_t)row * 4096 + u.pn * 256 + bj * 128 + wc * 32 + 8 * fq + 4 * n;
                ax[2 * bj + n] = ax[2 * bj + n] * unpack4(*(const u32x2*)gr); }
    }
    __device__ __forceinline__ void operator()(EPI_ARGS) const {
        const int colh = wc * 32 + 8 * fq;
#pragma unroll
        for (int ai = 0; ai < 2; ++ai) { u32x4 gs[4][2];
#pragma unroll
            for (int m = 0; m < 4; ++m)
#pragma unroll
                for (int bj = 0; bj < 2; ++bj) gs[m][bj] = __builtin_nontemporal_load((const u32x4*)(GATES + (size_t)EPI_ROW * 4096 + 2048 + u.pn * 256 + bj * 128 + colh));
#pragma unroll
            for (int m = 0; m < 4; ++m) { const int row = EPI_ROW;
#pragma unroll
                for (int bj = 0; bj < 2; ++bj) { const int col = u.pn * 256 + bj * 128 + colh; f32x4 s0, s1; unpack8(gs[m][bj], s0, s1);
                    *(u32x4*)(MERGED + (size_t)row * 2048 + col) = pack8(acc[ai][bj][m][0] * clampg(s0), acc[ai][bj][m][1] * clampg(s1)); } }
            asm volatile("" ::: "memory"); }
    }
    __device__ __forceinline__ void x(XEPI_ARGS) const { XROW_SETUP
        if (!valid) return;
#pragma unroll
        for (int bj = 0; bj < 2; ++bj) { const int col = u.pn * 256 + bj * 128 + cq; const f32x4 g = clampg(unpack4(*(const u32x2*)(GATES + (size_t)row * 4096 + 2048 + col)));
            *(u32x2*)(MERGED + (size_t)row * 2048 + col) = pack4(ax[bj] * g); }
    }
};
template <bool SRC_BF16> struct EpiRes { static constexpr bool MIDK = false; static constexpr bool FUSED = false;
    const bf16_t* XS; bf16_t* XB; float* rs; const float* rsc;
    __device__ __forceinline__ void operator()(EPI_ARGS) const {
        const int colh = wc * 32 + 8 * fq;
#pragma unroll
        for (int ai = 0; ai < 2; ++ai) { f32x4 xr[4][2][2];
#pragma unroll
            for (int m = 0; m < 4; ++m)
#pragma unroll
                for (int bj = 0; bj < 2; ++bj) { const size_t off = (size_t)EPI_ROW * 2048 + u.pn * 256 + bj * 128 + colh;
                    unpack8(__builtin_nontemporal_load((const u32x4*)(XS + off)), xr[m][bj][0], xr[m][bj][1]); }
#pragma unroll
            for (int m = 0; m < 4; ++m) { const int row = EPI_ROW; float ss = 0.f; const float sc = SRC_BF16 ? 1.0f : rsc[row];
#pragma unroll
                for (int bj = 0; bj < 2; ++bj) { const int col = u.pn * 256 + bj * 128 + colh;
                    const f32x4 v0 = acc[ai][bj][m][0] + xr[m][bj][0] * sc, v1 = acc[ai][bj][m][1] + xr[m][bj][1] * sc;
                    *(u32x4*)(XB + (size_t)row * 2048 + col) = pack8(v0, v1); ss += sumsq8(v0, v1); }
                put_rowss(rs, row, u.pn * 4 + wc, ss, fr, fq, true); }
            asm volatile("" ::: "memory"); }
    }
    __device__ __forceinline__ void x(XEPI_ARGS) const { XROW_SETUP
        float ss = 0.f;
        if (valid) {
#pragma unroll
            for (int bj = 0; bj < 2; ++bj) { const int col = u.pn * 256 + bj * 128 + cq;
                const f32x4 xo = unpack4(*(const u32x2*)(XS + (size_t)row * 2048 + col)) * (SRC_BF16 ? 1.0f : rsc[row]);
                const f32x4 v = ax[bj] + xo; *(u32x2*)(XB + (size_t)row * 2048 + col) = pack4(v); ss += sumsq4(v); } }
        put_rowss(rs, row, u.pn * 8 + wr * 4 + wc, ss, fr, fq, valid);
    }
};
__device__ __forceinline__ float dpp_prev1(float cur, float prevgrp) { const int o = __builtin_amdgcn_mov_dpp(__float_as_int(prevgrp), 0x121, 0xf, 0xf, true);
    return __int_as_float(__builtin_amdgcn_update_dpp(o, __float_as_int(cur), 0x111, 0xf, 0xf, false)); }
__device__ __forceinline__ float dpp_prev2(float cur, float prevgrp) { const int o = __builtin_amdgcn_mov_dpp(__float_as_int(prevgrp), 0x122, 0xf, 0xf, true);
    return __int_as_float(__builtin_amdgcn_update_dpp(o, __float_as_int(cur), 0x112, 0xf, 0xf, false)); }
constexpr int UP_STG = 784, UP_STG_MAX = 10;
constexpr size_t SA_BLK = (size_t)4 * 6144;
struct EpiUp { static constexpr bool MIDK = false; static constexpr bool FUSED = false;
    const float* rs; bf16_t* VB; float* SA; float* SAS; float* out; const float* WC; const float* BC;
    const LAS float* stg;
    __device__ __forceinline__ void operator()(const f32x4 (&acc)[2][2][4][2], const Unit& u, int wr, int wc, int fr0, int fq0) const {
        int fr = fr0, fq = fq0; asm volatile("" : "+v"(fr), "+v"(fq));
        const int col = u.pn * 128 + wc * 32 + 8 * fq;
        f32x4 w0a, w0b, w1a, w1b, w2a, w2b, bca, bcb;
        const LAS float* su = stg + u.ui * UP_STG;
        if (stg) { const LAS float* cw = su + 272 + wc * 32 + 8 * fq;
            w0a = *(const LAS f32x4*)cw; w0b = *(const LAS f32x4*)(cw + 4); w1a = *(const LAS f32x4*)(cw + 128); w1b = *(const LAS f32x4*)(cw + 132);
            w2a = *(const LAS f32x4*)(cw + 256); w2b = *(const LAS f32x4*)(cw + 260); bca = *(const LAS f32x4*)(cw + 384); bcb = *(const LAS f32x4*)(cw + 388);
        } else {
            w0a = *(const f32x4*)(WC + col); w0b = *(const f32x4*)(WC + col + 4); w1a = *(const f32x4*)(WC + 6144 + col); w1b = *(const f32x4*)(WC + 6144 + col + 4);
            w2a = *(const f32x4*)(WC + 12288 + col); w2b = *(const f32x4*)(WC + 12288 + col + 4); bca = *(const f32x4*)(BC + col); bcb = *(const f32x4*)(BC + col + 4); }
        bf16_t* vbase = VB + (size_t)(u.pn >> 4) * ((size_t)MPAD * 2048) + (col & 2047);
#pragma unroll
        for (int ai = 0; ai < 2; ++ai) { f32x4 pa0, pa1; float rr[4];
#pragma unroll
            for (int m = 0; m < 4; ++m) rr[m] = stg ? su[ai * 128 + wr * 64 + m * 16 + fr] : rs_rstd_main(rs, EPI_ROW, fr, fq);
            float* sa = SA + (size_t)(4 * u.pm + 2 * ai + wr) * SA_BLK + col;
#pragma unroll
            for (int m = 0; m < 4; ++m) { const int row = EPI_ROW; const float r = rr[m];
                const f32x4 a0 = acc[ai][0][m][0] * r, a1 = acc[ai][0][m][1] * r, v0 = acc[ai][1][m][0] * r, v1 = acc[ai][1][m][1] * r;
                if (m == 0) { pa0 = a0; pa1 = a1; }
                f32x4 o0, o1;
#pragma unroll
                for (int j = 0; j < 4; j += 2) {
                    const f32x2 q0 = (f32x2){dpp_prev2(a0[j], pa0[j]), dpp_prev2(a0[j + 1], pa0[j + 1])}, p0 = (f32x2){dpp_prev1(a0[j], pa0[j]), dpp_prev1(a0[j + 1], pa0[j + 1])};
                    const f32x2 q1 = (f32x2){dpp_prev2(a1[j], pa1[j]), dpp_prev2(a1[j + 1], pa1[j + 1])}, p1 = (f32x2){dpp_prev1(a1[j], pa1[j]), dpp_prev1(a1[j + 1], pa1[j + 1])};
                    const f32x2 c0 = (f32x2){bca[j], bca[j + 1]} + (f32x2){w0a[j], w0a[j + 1]} * q0 + (f32x2){w1a[j], w1a[j + 1]} * p0 + (f32x2){w2a[j], w2a[j + 1]} * (f32x2){a0[j], a0[j + 1]};
                    const f32x2 c1 = (f32x2){bcb[j], bcb[j + 1]} + (f32x2){w0b[j], w0b[j + 1]} * q1 + (f32x2){w1b[j], w1b[j + 1]} * p1 + (f32x2){w2b[j], w2b[j + 1]} * (f32x2){a1[j], a1[j + 1]};
                    const f32x2 g0 = gelu2(c0) * (f32x2){v0[j], v0[j + 1]}, g1 = gelu2(c1) * (f32x2){v1[j], v1[j + 1]};
                    o0[j] = g0[0]; o0[j + 1] = g0[1]; o1[j] = g1[0]; o1[j + 1] = g1[1]; }
                if (m == 0 && fr < 2) { o0 = v0; o1 = v1; float* q = sa + (size_t)fr * 6144; *(f32x4*)q = a0; *(f32x4*)(q + 4) = a1; }
                if (m == 3 && fr >= 14) { float* q = sa + (size_t)(fr - 12) * 6144; *(f32x4*)q = a0; *(f32x4*)(q + 4) = a1;
                    const int t = row & 2047; if (t >= 2046) { float* q2 = out + OFF_CONV_P + ((size_t)((row >> 11) * 2 + (t - 2046))) * 6144 + col; *(f32x4*)q2 = a0; *(f32x4*)(q2 + 4) = a1; } }
                *(u32x4*)(vbase + (size_t)row * 2048) = pack8(o0, o1);
                pa0 = a0; pa1 = a1; }
            asm volatile("" ::: "memory"); }
    }
    __device__ __forceinline__ void x(XEPI_ARGS) const { XROW_SETUP
        const float r = stg ? stg[u.ui * UP_STG + 256 + (fr & 3)] : rs_rstd_x(rs, valid ? row : MPR, fr, fq);
        if (!valid) return;
        const int col = u.pn * 128 + cq; const f32x4 av = ax[0] * r, vv = ax[1] * r;
        *(f32x4*)(SAS + (size_t)(row - MPR) * 6144 + col) = av;
        *(u32x2*)(VB + (size_t)(u.pn >> 4) * ((size_t)MPAD * 2048) + (size_t)row * 2048 + (col & 2047)) = pack4(vv);
        *(f32x4*)(out + OFF_CONV_S + ((size_t)(row - MPR) * 2 + 1) * 6144 + col) = av;
    }
};
struct EpiPle { static constexpr bool MIDK = false; static constexpr bool FUSED = false;
    const float* rs2; const bf16_t* P; const bf16_t* X2; float* rs3; bf16_t* wout;
    __device__ __forceinline__ void operator()(EPI_ARGS) const {
        const int colh = wc * 32 + 8 * fq;
#pragma unroll
        for (int ai = 0; ai < 2; ++ai)
#pragma unroll
            for (int mp = 0; mp < 2; ++mp) { u32x4 pt[2][2], xt[2][2]; float rr[2];
#pragma unroll
                for (int mm = 0; mm < 2; ++mm) { const int m = 2 * mp + mm; rr[mm] = rs_rstd_main(rs2, EPI_ROW, fr, fq);
#pragma unroll
                    for (int bj = 0; bj < 2; ++bj) { const int col = u.pn * 256 + bj * 128 + colh; pt[mm][bj] = __builtin_nontemporal_load((const u32x4*)(P + (size_t)EPI_ROW * 2048 + col));
                        xt[mm][bj] = *(const u32x4*)(X2 + (size_t)EPI_ROW * 2048 + col); } }
#pragma unroll
                for (int mm = 0; mm < 2; ++mm) { const int m = 2 * mp + mm; const int row = EPI_ROW; float ss = 0.f; const float r = rr[mm];
#pragma unroll
                    for (int bj = 0; bj < 2; ++bj) { const int col = u.pn * 256 + bj * 128 + colh; f32x4 p0, p1; unpack8(pt[mm][bj], p0, p1);
                        f32x4 v0, v1; unpack8(xt[mm][bj], v0, v1);
#pragma unroll
                        for (int j = 0; j < 4; ++j) { v0[j] += sigmoid_f(r * acc[ai][bj][m][0][j]) * p0[j]; v1[j] += sigmoid_f(r * acc[ai][bj][m][1][j]) * p1[j]; }
                        *(u32x4*)(wout + (size_t)row * 2048 + col) = pack8(v0, v1); ss += sumsq8(v0, v1); }
                    put_rowss(rs3, row, u.pn * 4 + wc, ss, fr, fq, true); }
                asm volatile("" ::: "memory"); }
    }
    __device__ __forceinline__ void x(XEPI_ARGS) const { XROW_SETUP
        float ss = 0.f; const float r = rs_rstd_x(rs2, valid ? row : MPR, fr, fq);
        if (valid) {
#pragma unroll
            for (int bj = 0; bj < 2; ++bj) { const int col = u.pn * 256 + bj * 128 + cq; const f32x4 p = unpack4(*(const u32x2*)(P + (size_t)row * 2048 + col));
                f32x4 v = unpack4(*(const u32x2*)(X2 + (size_t)row * 2048 + col));
#pragma unroll
                for (int j = 0; j < 4; ++j) v[j] += sigmoid_f(r * ax[bj][j]) * p[j];
                *(u32x2*)(wout + (size_t)row * 2048 + col) = pack4(v); ss += sumsq4(v); } }
        put_rowss(rs3, row, u.pn * 8 + wr * 4 + wc, ss, fr, fq, valid);
    }
};

#define XB_TMO      128
#define XB_XCNT(j)  (256  + 64 * (j))
#define XB_XSUB(j)  (1280 + 64 * (j))
#define XB_XGEN(j)  (2304 + 64 * (j))
#define XB_TOP      3328
#define XB_TOPGEN   3392
#define XB_PANEL(j) (3456 + 64 * (j))
#define XCD_BAR_WORDS 5504
#define XB_SPIN_CAP (1u << 22)
__device__ __forceinline__ unsigned xb_ld(unsigned* p)              { return __hip_atomic_load(p, __ATOMIC_RELAXED, __HIP_MEMORY_SCOPE_AGENT); }
__device__ __forceinline__ unsigned xb_add(unsigned* p, unsigned v) { return __hip_atomic_fetch_add(p, v, __ATOMIC_RELAXED, __HIP_MEMORY_SCOPE_AGENT); }
__device__ __forceinline__ unsigned xb_xcc_id() { return (unsigned)__builtin_amdgcn_s_getreg((3 << 11) | 20) & 0xFu; }
#define XB_SPIN(cond, bar) do { unsigned _sp = 0; while (cond) { __builtin_amdgcn_s_sleep(1); \
    if ((++_sp & 255u) == 0u) { if (xb_ld(&(bar)[XB_TMO])) break; if (_sp > XB_SPIN_CAP) { atomicAdd(&(bar)[XB_TMO], 1u); break; } } } } while (0)
struct XcdBarrier { unsigned* bar; unsigned x; volatile LAS unsigned* st; };
__device__ __forceinline__ void xcd_barrier_complete(unsigned* bar, unsigned x, unsigned G, unsigned& nloc, unsigned& nx) {
    unsigned sum, cnt, mine, sp = 0u;
    for (;;) {
        sum = 0u; cnt = 0u; mine = 0u;
#pragma unroll
        for (unsigned j = 0; j < 16; ++j) { const unsigned c = xb_ld(&bar[XB_XCNT(j)]); sum += c; cnt += (c > 0u) ? 1u : 0u; mine = (j == x) ? c : mine; }
        if (sum == G) break;
        __builtin_amdgcn_s_sleep(1);
        if ((++sp & 255u) == 0u) { if (xb_ld(&bar[XB_TMO])) break; if (sp > XB_SPIN_CAP) { atomicAdd(&bar[XB_TMO], 1u); break; } }
    }
    nloc = mine > 0u ? mine : 1u; nx = cnt > 0u ? cnt : 1u;
}
__device__ __forceinline__ void xcd_barrier(const XcdBarrier& b, bool leader, unsigned G) {
    asm volatile("s_waitcnt vmcnt(0)" ::: "memory");
    __syncthreads();
    if (leader) {
        unsigned* bar = b.bar;
        __builtin_amdgcn_s_waitcnt(0);
        unsigned nloc = b.st[0], nx = b.st[1];
        if (nloc == 0u) { xcd_barrier_complete(bar, b.x, G, nloc, nx); b.st[0] = nloc; b.st[1] = nx; }
        const unsigned old = xb_add(&bar[XB_XSUB(b.x)], 1u);
        const unsigned gen = old / nloc;
        if (old + 1u == (gen + 1u) * nloc) {
            __builtin_amdgcn_fence(__ATOMIC_RELEASE, "agent");
            asm volatile("s_waitcnt vmcnt(0)" ::: "memory");
            const unsigned og = xb_add(&bar[XB_TOP], 1u);
            const unsigned tg = og / nx;
            if (og + 1u == (tg + 1u) * nx) { xb_add(&bar[XB_TOPGEN], 1u); __builtin_amdgcn_fence(__ATOMIC_ACQUIRE, "agent"); asm volatile("s_waitcnt vmcnt(0)" ::: "memory"); }
            else { __builtin_amdgcn_fence(__ATOMIC_ACQUIRE, "agent"); asm volatile("s_waitcnt vmcnt(0)" ::: "memory"); XB_SPIN(xb_ld(&bar[XB_TOPGEN]) == tg, bar); }
            xb_add(&bar[XB_XGEN(b.x)], 1u);
        } else {
            __builtin_amdgcn_fence(__ATOMIC_ACQUIRE, "agent");
            asm volatile("s_waitcnt vmcnt(0)" ::: "memory");
            XB_SPIN(xb_ld(&bar[XB_XGEN(b.x)]) == gen, bar);
        }
    }
    __syncthreads();
}

struct EpiPleF { static constexpr bool MIDK = false; static constexpr bool FUSED = true;
    const float* rs2; const bf16_t* P; const bf16_t* X2; float* rs3; float* out; const float* gf; unsigned* bar;
    template <bool XR>
    __device__ __forceinline__ void fused(f32x4 (&acc)[2][2][4][2], f32x4 (&accX)[4], const Unit& u, int wr, int wc, int fr0, int fq0, bool leader) const {
        int fr = fr0, fq = fq0; asm volatile("" : "+v"(fr), "+v"(fq));
        const int colh = wc * 32 + 8 * fq;
#pragma unroll
        for (int ai = 0; ai < 2; ++ai)
#pragma unroll
            for (int mp = 0; mp < 2; ++mp) { u32x4 pt[2][2], xt[2][2]; float rr[2];
#pragma unroll
                for (int mm = 0; mm < 2; ++mm) { const int m = 2 * mp + mm; rr[mm] = rs_rstd_main(rs2, EPI_ROW, fr, fq);
#pragma unroll
                    for (int bj = 0; bj < 2; ++bj) { const int col = u.pn * 256 + bj * 128 + colh; pt[mm][bj] = __builtin_nontemporal_load((const u32x4*)(P + (size_t)EPI_ROW * 2048 + col));
                        xt[mm][bj] = *(const u32x4*)(X2 + (size_t)EPI_ROW * 2048 + col); } }
#pragma unroll
                for (int mm = 0; mm < 2; ++mm) { const int m = 2 * mp + mm; const int row = EPI_ROW; float ss = 0.f; const float r = rr[mm];
#pragma unroll
                    for (int bj = 0; bj < 2; ++bj) { f32x4 p0, p1; unpack8(pt[mm][bj], p0, p1);
                        f32x4 v0, v1; unpack8(xt[mm][bj], v0, v1);
#pragma unroll
                        for (int j = 0; j < 4; ++j) { v0[j] += sigmoid_f(r * acc[ai][bj][m][0][j]) * p0[j]; v1[j] += sigmoid_f(r * acc[ai][bj][m][1][j]) * p1[j]; }
                        acc[ai][bj][m][0] = v0; acc[ai][bj][m][1] = v1; ss += sumsq8(v0, v1); }
                    put_rowss(rs3, row, u.pn * 4 + wc, ss, fr, fq, true); }
                asm volatile("" ::: "memory"); }
        const bool xvalid = fr < 4; const int xrow = MPR + 4 * u.pm + fr;
        if constexpr (XR) {
#pragma unroll
            for (int n = 0; n < 2; ++n) { float ss = 0.f; const float r = rs_rstd_x(rs2, xvalid ? xrow : MPR, fr, fq);
                if (xvalid) {
#pragma unroll
                    for (int bj = 0; bj < 2; ++bj) { const int col = u.pn * 256 + bj * 128 + wc * 32 + 8 * fq + 4 * n; const f32x4 p = unpack4(*(const u32x2*)(P + (size_t)xrow * 2048 + col));
                        f32x4 v = unpack4(*(const u32x2*)(X2 + (size_t)xrow * 2048 + col));
#pragma unroll
                        for (int j = 0; j < 4; ++j) v[j] += sigmoid_f(r * accX[bj * 2 + n][j]) * p[j];
                        accX[bj * 2 + n] = v; ss += sumsq4(v); } }
                put_rowss(rs3, xrow, u.pn * 8 + n * 4 + wc, ss, fr, fq, xvalid); }
        }
        asm volatile("s_waitcnt vmcnt(0)" ::: "memory");
        __builtin_amdgcn_s_barrier();
        if (leader) {
            __builtin_amdgcn_fence(__ATOMIC_RELEASE, "agent");
            asm volatile("s_waitcnt vmcnt(0)" ::: "memory");
            unsigned* ctr = bar + XB_PANEL(u.pm);
            (void)xb_add(ctr, 1u);
            XB_SPIN(xb_ld(ctr) < 8u, bar);
            __builtin_amdgcn_fence(__ATOMIC_ACQUIRE, "agent");
            asm volatile("s_waitcnt vmcnt(0)" ::: "memory");
        }
        __builtin_amdgcn_s_barrier();
        asm volatile("" ::: "memory");
        { const float* gp = gf + u.pn * 256 + colh;
          const f32x4 g00 = *(const f32x4*)gp, g01 = *(const f32x4*)(gp + 4), g10 = *(const f32x4*)(gp + 128), g11 = *(const f32x4*)(gp + 132);
          EPI_FOR_ROWS { const int row = EPI_ROW; const float r = rs_rstd_main(rs3, row, fr, fq); float* o = out + (size_t)row * 2048 + u.pn * 256 + colh;
              *(f32x4*)o = acc[ai][0][m][0] * r * g00; *(f32x4*)(o + 4) = acc[ai][0][m][1] * r * g01; *(f32x4*)(o + 128) = acc[ai][1][m][0] * r * g10; *(f32x4*)(o + 132) = acc[ai][1][m][1] * r * g11; } }
        if constexpr (XR) {
            const float r = rs_rstd_x(rs3, xvalid ? xrow : MPR, fr, fq);
            if (xvalid) {
#pragma unroll
                for (int n = 0; n < 2; ++n)
#pragma unroll
                    for (int bj = 0; bj < 2; ++bj) { const int col = u.pn * 256 + bj * 128 + wc * 32 + 8 * fq + 4 * n;
                        *(f32x4*)(out + (size_t)xrow * 2048 + col) = accX[bj * 2 + n] * r * *(const f32x4*)(gf + col); } }
        }
    }
};

struct Args { const float* in[33]; float* out; unsigned char* ws; };
enum { I_XP = 0, I_XS, I_CPOOL, I_SRE, I_SIM, I_CCONV, I_PP, I_PS, I_GMIX, I_WIN, I_WPOOL, I_PSCALE, I_LRE, I_LIM, I_LOGDT, I_BRE, I_BIM, I_CRE, I_CIM, I_D,
       I_WGLU, I_WBP, I_WBS, I_WOUT, I_GFFN, I_WUP, I_WCONV, I_BCONV, I_WDOWN, I_GPLE, I_WPG, I_WPLE, I_GFINAL };

__device__ __forceinline__ void transpose_item(const float* W, int K, int N, bf16_t* WT, const float* kscale, LAS float* scr, int item, int lane, int ldw = 0, bool nts = false) {
    if (ldw == 0) ldw = K;
    const int nblk = N >> 6, kb = item / nblk, nb = item - kb * nblk, k0 = kb * 64, n0 = nb * 64;
    const int c4 = (lane & 15) * 4, kr = lane >> 4;
    f32x4 v[16];
#pragma unroll
    for (int i = 0; i < 16; ++i) v[i] = __builtin_nontemporal_load((const f32x4*)(W + (size_t)(k0 + 4 * i + kr) * N + n0 + c4));
    const int c = lane & 7;
    f32x4 ks0 = (f32x4){1.f, 1.f, 1.f, 1.f}, ks1 = ks0;
    if (kscale) { ks0 = *(const f32x4*)(kscale + k0 + 8 * c); ks1 = *(const f32x4*)(kscale + k0 + 8 * c + 4); }
#pragma unroll
    for (int i = 0; i < 16; ++i) { LAS float* s = scr + (4 * i + kr) * 65 + c4; s[0] = v[i][0]; s[1] = v[i][1]; s[2] = v[i][2]; s[3] = v[i][3]; }
    asm volatile("s_waitcnt lgkmcnt(0)" ::: "memory");
#pragma unroll
    for (int j = 0; j < 8; ++j) { const int n = (lane >> 3) + 8 * j; const LAS float* s = scr + (8 * c) * 65 + n;
        u32x4 o; o.x = cvt_pk_bf16(s[0 * 65] * ks0[0], s[1 * 65] * ks0[1]); o.y = cvt_pk_bf16(s[2 * 65] * ks0[2], s[3 * 65] * ks0[3]); o.z = cvt_pk_bf16(s[4 * 65] * ks1[0], s[5 * 65] * ks1[1]); o.w = cvt_pk_bf16(s[6 * 65] * ks1[2], s[7 * 65] * ks1[3]);
        u32x4* dst = (u32x4*)(WT + (size_t)(n0 + n) * ldw + k0 + 8 * c); if (nts) __builtin_nontemporal_store(o, dst); else *dst = o; }
    asm volatile("s_waitcnt lgkmcnt(0)" ::: "memory");
}


constexpr int TI_IN = 32 * 96, TI_LE = 4 * 32, TI_EARLY = TI_IN + TI_LE, TI_PL = 4 * 4 * 4, TI_G = 16 * 32, TI_O = 32 * 32, TI_U = 32 * 192, TI_DN = 96 * 32;
constexpr int TI_ALL = TI_EARLY + TI_PL + 3 * TI_G + TI_O + TI_U + TI_DN + TI_O;
#define TRANSPOSE_ITEMS(first, last) do { for (int it = (first) + gw; it < (last); it += NGW) { int r = it; \
        if (r < TI_IN) { const int n0_ = (r % 96) * 64;   \
            const int nd_ = n0_ < 2048 ? n0_ : (n0_ < 4096 ? 2048 + ((n0_ - 2048) >> 7) * 256 + ((n0_ - 2048) & 127) : 2048 + ((n0_ - 4096) >> 7) * 256 + 128 + ((n0_ - 4096) & 127)); \
            transpose_item(a.in[I_WIN], 2048, 6144, W_IN + (long)(nd_ - n0_) * 2048, a.in[I_GMIX], scr, r, lane); continue; } r -= TI_IN; \
        if (r < TI_LE) { transpose_item(a.in[I_WPLE], 256, 2048, W_PLE, nullptr, scr, r, lane); continue; } r -= TI_LE; \
        if (r < TI_PL) { const int k = r >> 4; transpose_item(a.in[I_WPOOL] + (size_t)k * 65536, 256, 256, W_POOL + (size_t)k * 65536, nullptr, scr, r & 15, lane); continue; } r -= TI_PL; \
        if (r < TI_G) { transpose_item(a.in[I_WGLU], 1024, 2048, W_GLU, nullptr, scr, r, lane); continue; } r -= TI_G; \
        if (r < TI_G) { transpose_item(a.in[I_WBP], 1024, 2048, W_BP, nullptr, scr, r, lane, 2048); continue; } r -= TI_G; \
        if (r < TI_G) { transpose_item(a.in[I_WBS], 1024, 2048, W_BP + 1024, nullptr, scr, r, lane, 2048); continue; } r -= TI_G; \
        if (r < TI_O) { transpose_item(a.in[I_WOUT], 2048, 2048, W_OUT, nullptr, scr, r, lane); continue; } r -= TI_O; \
        if (r < TI_U) { transpose_item(a.in[I_WUP], 2048, 12288, W_UP, a.in[I_GFFN], scr, r, lane, 0, true); continue; } r -= TI_U; \
        if (r < TI_DN) { const int pnl = r >> 10; transpose_item(a.in[I_WDOWN] + (size_t)pnl * 2048 * 2048, 2048, 2048, W_DOWN + (size_t)pnl * 2048 * 2048, nullptr, scr, r & 1023, lane, 0, true); continue; } r -= TI_DN; \
        transpose_item(a.in[I_WPG], 2048, 2048, W_PG, a.in[I_GPLE], scr, r, lane, 0, true); } } while (0)

template <bool FUSE_FINAL>
__global__ void __launch_bounds__(512, 2) fwd_kernel(Args a) {
    extern __shared__ __attribute__((aligned(16))) unsigned char smem[];
    cg::grid_group grid = cg::this_grid();
    LAS unsigned char* lds = (LAS unsigned char*)smem;
    const int G = gridDim.x, bid = blockIdx.x;
    const int wave_s = __builtin_amdgcn_readfirstlane((int)(threadIdx.x >> 6));
#define GRID_SYNC() do { const bool _ld = (wave_s == 0) && (lane_id() == 0); xcd_barrier(xbar, _ld, (unsigned)G); } while (0)
#define FRESH_IDS const int lane = lane_id(); const int wave = wave_s, tid = wave * 64 + lane; (void)tid;
    unsigned char* ws = a.ws; float* out = a.out;
    bf16_t* W_UP = (bf16_t*)(ws + WS_WUP); bf16_t* W_DOWN = (bf16_t*)(ws + WS_WDOWN); bf16_t* W_PG = (bf16_t*)(ws + WS_WPG); bf16_t* W_PLE = (bf16_t*)(ws + WS_WPLE);
    bf16_t* W_OUT = (bf16_t*)(ws + WS_WOUT); bf16_t* W_IN = (bf16_t*)(ws + WS_WIN); bf16_t* W_GLU = (bf16_t*)(ws + WS_WGLU); bf16_t* W_BP = (bf16_t*)(ws + WS_WBP);
    bf16_t* W_BS = (bf16_t*)(ws + WS_WBS); bf16_t* W_POOL = (bf16_t*)(ws + WS_WPOOL);
    bf16_t* Hb = (bf16_t*)(ws + WS_H); bf16_t* PBb = (bf16_t*)(ws + WS_PB); bf16_t* Pb = (bf16_t*)(ws + WS_P);
    bf16_t* Ub = (bf16_t*)(ws + WS_U); bf16_t* GATES = (bf16_t*)(ws + WS_GATES);
    f32x2* ABAR = (f32x2*)(ws + WS_U + 44 * MiB); f32x2* A16T = ABAR + 4096; f32x2* BBAR = ABAR + 8192;
    bf16_t* Ussm = (bf16_t*)(ws + WS_U + 20 * MiB); bf16_t* Usam = (bf16_t*)(ws + WS_U + 40 * MiB);
    bf16_t* DIFF = (bf16_t*)(ws + WS_DIFF); bf16_t* SSMACT = (bf16_t*)(ws + WS_SSMACT); bf16_t* YCAT = (bf16_t*)(ws + WS_YCAT);
 bf16_t* MERGED = (bf16_t*)(ws + WS_MERGED); bf16_t* X1B = (bf16_t*)(ws + WS_X1B);
    float* SAb = (float*)(ws + WS_ABUF + 40 * MiB);
    bf16_t* VBUF = (bf16_t*)(ws + WS_VBUF); bf16_t* X2B = (bf16_t*)(ws + WS_X2B);
    float* RS1 = (float*)(ws + WS_ROWSS); float* RS2 = RS1 + (size_t)MPAD * RS_SLOTS; float* RS3 = RS2 + (size_t)MPAD * RS_SLOTS; float* INVR = RS3 + (size_t)MPAD * RS_SLOTS;

    XcdBarrier xbar; xbar.bar = (unsigned*)(ws + WS_CTL); xbar.st = (volatile LAS unsigned*)(lds + LDS_BYTES - 16);
    { const int t0 = threadIdx.x; if (t0 < 2) xbar.st[t0] = 0u;
      if (gridDim.y == 0x7fffu) grid.sync();
      xbar.x = xb_xcc_id(); if (t0 == 0) (void)xb_add(&xbar.bar[XB_XCNT(xbar.x)], 1u); }
    {
    {
        FRESH_IDS
        const int gtid = bid * 512 + tid, GT = G * 512;
        auto s5_tables = [&]() {
        if (bid < 256) {
            const int g = bid >> 2, q = bid & 3;
            LAS float* La = (LAS float*)lds;
            LAS float* Lap = (LAS float*)(lds + 512);
            LAS float* Lbb = (LAS float*)(lds + 9216);
            LAS float* Lcc = (LAS float*)(lds + 17408);
            bf16_t* PM = (bf16_t*)(ws + WS_PM) + (size_t)g * 128 * 256; bf16_t* QM = (bf16_t*)(ws + WS_QM) + (size_t)g * 256 * 128; bf16_t* KT = (bf16_t*)(ws + WS_KT) + (size_t)g * 4096;
            if (tid < 64) { const int p = tid;
                const float dt = expf(a.in[I_LOGDT][g]), lr = a.in[I_LRE][g * 64 + p], li = a.in[I_LIM][g * 64 + p];
                const float mag = expf(lr * dt), ar = mag * cosf(li * dt), ai = mag * sinf(li * dt);
                const float nr = ar - 1.0f, ni = ai, den = lr * lr + li * li, cr = (nr * lr + ni * li) / den, ci = (ni * lr - nr * li) / den;
                La[p * 2] = ar; La[p * 2 + 1] = ai;
                float wr_ = 1.f, wi_ = 0.f;
                for (int d = 0; d <= 16; ++d) { Lap[(d * 64 + p) * 2] = wr_; Lap[(d * 64 + p) * 2 + 1] = wi_; const float tr = wr_ * ar - wi_ * ai, ti = wr_ * ai + wi_ * ar; wr_ = tr; wi_ = ti; }
                for (int h = 0; h < 16; ++h) { const float br = a.in[I_BRE][(size_t)(g * 64 + p) * 16 + h], bi = a.in[I_BIM][(size_t)(g * 64 + p) * 16 + h];
                    Lbb[(p * 16 + h) * 2] = cr * br - ci * bi; Lbb[(p * 16 + h) * 2 + 1] = cr * bi + ci * br; } }
            for (int i = tid; i < 1024; i += 512) { Lcc[i * 2] = a.in[I_CRE][(size_t)g * 1024 + i]; Lcc[i * 2 + 1] = a.in[I_CIM][(size_t)g * 1024 + i]; }
            __syncthreads();
            if (q == 0) {
                if (tid < 64) { ABAR[g * 64 + tid] = *(const LAS f32x2*)(La + tid * 2); A16T[g * 64 + tid] = *(const LAS f32x2*)(Lap + (16 * 64 + tid) * 2); }
                for (int i = tid; i < 1024; i += 512) BBAR[(size_t)g * 1024 + i] = *(const LAS f32x2*)(Lbb + i * 2); }
            if (tid < 256) {
                const int hp = tid >> 4, h = tid & 15; float acc0 = 0.f, acc1 = 0.f, acc2 = 0.f, acc3 = 0.f;
                for (int p = 0; p < 64; ++p) { const f32x2 c = *(const LAS f32x2*)(Lcc + (hp * 64 + p) * 2), b = *(const LAS f32x2*)(Lbb + (p * 16 + h) * 2), w = *(const LAS f32x2*)(Lap + (4 * q * 64 + p) * 2), av = *(const LAS f32x2*)(La + p * 2);
                    const float mr = c[0] * b[0] - c[1] * b[1], mi = c[0] * b[1] + c[1] * b[0];
                    float zr = mr * w[0] - mi * w[1], zi = mr * w[1] + mi * w[0]; float t_;
                    acc0 += zr; t_ = zr * av[0] - zi * av[1]; zi = zr * av[1] + zi * av[0]; zr = t_;
                    acc1 += zr; t_ = zr * av[0] - zi * av[1]; zi = zr * av[1] + zi * av[0]; zr = t_;
                    acc2 += zr; t_ = zr * av[0] - zi * av[1]; zi = zr * av[1] + zi * av[0]; zr = t_;
                    acc3 += zr; }
                if (q == 0 && h == hp) acc0 += a.in[I_D][g * 16 + hp];
                bf16_t* k = KT + (size_t)(4 * q) * 256 + hp * 16 + h;
                k[0] = (bf16_t)(cvt_pk_bf16(acc0, 0.f) & 0xffffu); k[256] = (bf16_t)(cvt_pk_bf16(acc1, 0.f) & 0xffffu); k[512] = (bf16_t)(cvt_pk_bf16(acc2, 0.f) & 0xffffu); k[768] = (bf16_t)(cvt_pk_bf16(acc3, 0.f) & 0xffffu);
            }
            {
                const int pr = 32 * q + (tid >> 4), h = tid & 15, part = pr >> 6, p = pr & 63;
                const f32x2 b = *(const LAS f32x2*)(Lbb + (p * 16 + h) * 2);
                for (int s_ = 0; s_ < 16; ++s_) { const f32x2 w = *(const LAS f32x2*)(Lap + ((15 - s_) * 64 + p) * 2);
                    const float v = part ? (w[0] * b[1] + w[1] * b[0]) : (w[0] * b[0] - w[1] * b[1]);
                    PM[(size_t)pr * 256 + s_ * 16 + h] = (bf16_t)(cvt_pk_bf16(v, 0.f) & 0xffffu); } }
            {
                const int rloc = tid >> 3, tq = 4 * q + (rloc >> 4), hp = rloc & 15, pg = tid & 7; float vr[8], vi[8];
#pragma unroll
                for (int e = 0; e < 8; ++e) { const int p = pg * 8 + e; const f32x2 c = *(const LAS f32x2*)(Lcc + (hp * 64 + p) * 2), w = *(const LAS f32x2*)(Lap + ((tq + 1) * 64 + p) * 2);
                    vr[e] = c[0] * w[0] - c[1] * w[1]; vi[e] = -(c[0] * w[1] + c[1] * w[0]); }
                bf16_t* qrow = QM + (size_t)(tq * 16 + hp) * 128 + pg * 8;
                *(u32x4*)qrow = pack8((f32x4){vr[0], vr[1], vr[2], vr[3]}, (f32x4){vr[4], vr[5], vr[6], vr[7]});
                *(u32x4*)(qrow + 64) = pack8((f32x4){vi[0], vi[1], vi[2], vi[3]}, (f32x4){vi[4], vi[5], vi[6], vi[7]}); }
            __syncthreads();
        }
        };
        const bool tables_first = ((bid >> 3) & 1) == 0;
        if (tables_first) s5_tables();
        LAS float* scr = (LAS float*)(lds + wave * 16640);
        const int gw = bid * 8 + wave, NGW = G * 8;
        TRANSPOSE_ITEMS(0, TI_EARLY);
        for (int row = (gw + (NGW >> 1)) % NGW; row < MPAD; row += NGW) {
            u32x2* o = (u32x2*)(Hb + (size_t)row * 2048) + lane;
            if (row < MT) {
                const float* xr = row < MPR ? a.in[I_XP] + (size_t)row * 2048 : a.in[I_XS] + (size_t)(row - MPR) * 2048;
                f32x4 v[8]; float s = 0.f;
#pragma unroll
                for (int j = 0; j < 8; ++j) { v[j] = __builtin_nontemporal_load((const f32x4*)xr + lane + 64 * j); s += (v[j][0] * v[j][0] + v[j][1] * v[j][1]) + (v[j][2] * v[j][2] + v[j][3] * v[j][3]); }
                const float ms = wave_sum(s, lane) * (1.0f / 2048.0f) + EPS, r = rsqrtf(ms);
                if (lane == 0) INVR[row] = ms * r;
#pragma unroll
                for (int j = 0; j < 8; ++j) { const f32x4 y = v[j] * r; u32x2 w; w.x = cvt_pk_bf16(y[0], y[1]); w.y = cvt_pk_bf16(y[2], y[3]); o[64 * j] = w; }
            } else {
                if (lane == 0) INVR[row] = 0.f;
#pragma unroll
                for (int j = 0; j < 8; ++j) o[64 * j] = (u32x2){0u, 0u};
            }
        }
        for (int i0 = gtid; i0 < MPAD * 64; i0 += 4 * GT) { f32x4 v[4];
#pragma unroll
            for (int k = 0; k < 4; ++k) { const int i = i0 + k * GT, row = i >> 6, c4 = (i & 63) * 4; v[k] = (f32x4){0.f, 0.f, 0.f, 0.f};
                if (i < MPAD * 64 && row < MT) { const float* pr = row < MPR ? a.in[I_PP] + (size_t)row * 256 : a.in[I_PS] + (size_t)(row - MPR) * 256; v[k] = __builtin_nontemporal_load((const f32x4*)(pr + c4)); } }
#pragma unroll
            for (int k = 0; k < 4; ++k) { const int i = i0 + k * GT, row = i >> 6, c4 = (i & 63) * 4;
                if (i < MPAD * 64) { u32x2 w; w.x = cvt_pk_bf16(v[k][0], v[k][1]); w.y = cvt_pk_bf16(v[k][2], v[k][3]); *(u32x2*)(PBb + (size_t)row * 256 + c4) = w; } } }
        if (!tables_first) { __syncthreads(); s5_tables(); }
    }
    GRID_SYNC();
    }

    {
    { pg8::Gemm g{Hb, W_IN, 2048, 2048, 2048, 32, 24, 0, 128, 256}; EpiZ E{Ub, Ussm, Usam, GATES, out}; pg8::gemm_phase(lds, g, G, bid, wave_s, E); }
    { pg8::Gemm g{PBb, W_PLE, 256, 256, 256, 32, 8, 0, 128, 256}; EpiBf E{Pb, 2048, nullptr}; pg8::gemm_phase(lds, g, G, bid, wave_s, E); }
    GRID_SYNC();
    }

    {
    {
        FRESH_IDS
#define POOL_LOADS(W, tile_, raw) do { const int r0_ = (tile_) * 16, t0_ = r0_ & 2047; const bf16_t* up_ = Ub + (size_t)r0_ * 1024 + c; \
            _Pragma("unroll") for (int j = 0; j < 15 + W; ++j) { const int dr = j - (W - 1); unsigned w_ = 0u; if (t0_ + dr >= 0) w_ = *(const unsigned*)(up_ + (long)dr * 1024); raw[j] = w_; } } while (0)
#define POOL_COMP(W, tile_, raw) do { const int r0_ = (tile_) * 16, t0_ = r0_ & 2047; f32x2 v[15 + W]; \
            _Pragma("unroll") for (int j = 0; j < 15 + W; ++j) v[j] = (f32x2){bf_lo(raw[j]), bf_hi(raw[j])}; \
            f32x2 sum = (f32x2){0.f, 0.f}; _Pragma("unroll") for (int j = 0; j < W - 1; ++j) sum += v[j]; \
            _Pragma("unroll") for (int i = 0; i < 16; ++i) { const int t = t0_ + i; const f32x2 cur = v[W - 1 + i]; sum += cur; \
                const float inv = 1.0f / (float)((t + 1) < W ? (t + 1) : W); const f32x2 d = sum * inv - cur; \
                *(unsigned*)(DIFF + (size_t)(r0_ + i) * 1024 + c) = cvt_pk_bf16(d[0], d[1]); sum -= v[i]; } } while (0)
#define POOL_ALL(W) do { \
            const bool has_s = bid < 128; const int ns = has_s ? bid : 0; f32x2 cr[15]; unsigned wc_ = 0u; \
            { const float* cp = a.in[I_CPOOL] + (size_t)ns * 15 * 1024 + c; \
              _Pragma("unroll") for (int j = 0; j < 15; ++j) cr[j] = has_s ? *(const f32x2*)(cp + (size_t)j * 1024) : (f32x2){0.f, 0.f}; \
              if (has_s) wc_ = *(const unsigned*)(Ub + (size_t)(MPR + ns) * 1024 + c); } \
            for (int tA = bid; tA < 512; tA += 2 * G) { const int tB = tA + G; const bool hasB = tB < 512; unsigned rawA[15 + W], rawB[15 + W]; \
                POOL_LOADS(W, tA, rawA); POOL_LOADS(W, hasB ? tB : tA, rawB); \
                POOL_COMP(W, tA, rawA); if (hasB) POOL_COMP(W, tB, rawB); } \
            if (has_s) { const f32x2 cur = (f32x2){bf_lo(wc_), bf_hi(wc_)}; f32x2 sum = cur; \
                _Pragma("unroll") for (int j = 16 - W; j <= 14; ++j) sum += cr[j]; \
                const f32x2 d = sum * (1.0f / (float)W) - cur; \
                *(unsigned*)(DIFF + (size_t)(MPR + ns) * 1024 + c) = cvt_pk_bf16(d[0], d[1]); \
                float* po = out + OFF_POOL_S + (size_t)ns * 15 * 1024 + c; \
                _Pragma("unroll") for (int j = 0; j < 14; ++j) *(f32x2*)(po + (size_t)j * 1024) = cr[j + 1]; } \
            for (int ns2 = bid + G; ns2 < 128; ns2 += G) {   \
                const float* cp = a.in[I_CPOOL] + (size_t)ns2 * 15 * 1024 + c; f32x2 c2[15]; \
                _Pragma("unroll") for (int j = 0; j < 15; ++j) c2[j] = *(const f32x2*)(cp + (size_t)j * 1024); \
                const unsigned w2 = *(const unsigned*)(Ub + (size_t)(MPR + ns2) * 1024 + c); const f32x2 cur = (f32x2){bf_lo(w2), bf_hi(w2)}; f32x2 sum = cur; \
                _Pragma("unroll") for (int j = 16 - W; j <= 14; ++j) sum += c2[j]; \
                const f32x2 d = sum * (1.0f / (float)W) - cur; \
                *(unsigned*)(DIFF + (size_t)(MPR + ns2) * 1024 + c) = cvt_pk_bf16(d[0], d[1]); \
                float* po = out + OFF_POOL_S + (size_t)ns2 * 15 * 1024 + c; \
                _Pragma("unroll") for (int j = 0; j < 14; ++j) *(f32x2*)(po + (size_t)j * 1024) = c2[j + 1]; } \
            } while (0)
        const bool conv_first = ((bid >> 3) & 1) != 0;
        if (conv_first) { const int lane = lane_id(); LAS float* scr = (LAS float*)(lds + wave * 16640); const int gw = bid * 8 + wave, NGW = G * 8; TRANSPOSE_ITEMS(TI_EARLY, TI_ALL - TI_O); }
        __syncthreads();
        { const int c = 2 * tid, wsel = wave >> 1;
          if (wsel == 0) POOL_ALL(2); else if (wsel == 1) POOL_ALL(4); else if (wsel == 2) POOL_ALL(8); else POOL_ALL(16); }
#undef POOL_ALL
#undef POOL_COMP
#undef POOL_LOADS
        LAS float* Hl = (LAS float*)(lds + 131072) + wave * 512;
        typedef float f32x16 __attribute__((ext_vector_type(16)));
        constexpr int UROW = 528;
        LAS unsigned char* UL = lds;
        LAS unsigned char* SL = lds + 128 * UROW;
        LAS unsigned char* KL = lds + 256 * UROW;
        for (int item = bid; item < 256; item += G) {
            const int n = item >> 6, g = item & 63;
            const bf16_t* PM = (const bf16_t*)(ws + WS_PM) + (size_t)g * 128 * 256; const bf16_t* QM = (const bf16_t*)(ws + WS_QM) + (size_t)g * 256 * 128; const bf16_t* KT = (const bf16_t*)(ws + WS_KT) + (size_t)g * 4096;
            const int li_ = lane & 31, kq = lane >> 5;
            u32x4 ut[8];
#pragma unroll
            for (int i = 0; i < 8; ++i) ut[i] = __builtin_nontemporal_load((const u32x4*)(Ussm + (size_t)item * 2048 * 16) + tid + 512 * i);
            const u32x4 ktv = *(const u32x4*)(KT + tid * 8);
            bf16x8 pmf[16], qmf[8];
            { const bf16_t* pa = PM + (size_t)(32 * (wave & 3) + li_) * 256 + 8 * kq;
#pragma unroll
              for (int ks = 0; ks < 16; ++ks) pmf[ks] = *(const bf16x8*)(pa + 16 * ks); }
            float a16r = 0.f, a16i = 0.f;
            { const f32x2 a16 = A16T[g * 64 + lane]; a16r = a16[0]; a16i = a16[1]; }
            __syncthreads();
#pragma unroll
            for (int i = 0; i < 8; ++i) { const int idx = tid + 512 * i; *(LAS u32x4*)(UL + (idx >> 5) * UROW + (idx & 31) * 16) = ut[i]; }
            *(LAS u32x4*)(KL + tid * 16) = ktv;
            __syncthreads();
            {
                const int rb = wave & 3, cbp = wave >> 2; f32x16 s0, s1;
#pragma unroll
                for (int r = 0; r < 16; ++r) { s0[r] = 0.f; s1[r] = 0.f; }
                const LAS unsigned char* ub0 = UL + (64 * cbp + li_) * UROW + 16 * kq, * ub1 = ub0 + 32 * UROW;
#pragma unroll
                for (int ks = 0; ks < 16; ++ks) { const bf16x8 af = pmf[ks];
                    s0 = __builtin_amdgcn_mfma_f32_32x32x16_bf16(af, *(const LAS bf16x8*)(ub0 + 32 * ks), s0, 0, 0, 0);
                    s1 = __builtin_amdgcn_mfma_f32_32x32x16_bf16(af, *(const LAS bf16x8*)(ub1 + 32 * ks), s1, 0, 0, 0); }
                LAS unsigned char* sr0 = SL + (64 * cbp + li_) * UROW + (32 * rb + 4 * kq) * 4, * sr1 = sr0 + 32 * UROW;
#pragma unroll
                for (int rq = 0; rq < 4; ++rq) { *(LAS f32x4*)(sr0 + rq * 32) = (f32x4){s0[4 * rq], s0[4 * rq + 1], s0[4 * rq + 2], s0[4 * rq + 3]};
                                                 *(LAS f32x4*)(sr1 + rq * 32) = (f32x4){s1[4 * rq], s1[4 * rq + 1], s1[4 * rq + 2], s1[4 * rq + 3]}; }
            }
            { const bf16_t* qa = QM + (size_t)(32 * wave + li_) * 128 + 8 * kq;
#pragma unroll
              for (int kc = 0; kc < 8; ++kc) qmf[kc] = *(const bf16x8*)(qa + 16 * kc); }
            __syncthreads();
            {
                const int p = lane, c0 = 16 * wave;
                LAS f32x2* Eb = (LAS f32x2*)(lds + 144384);
                float er = 0.f, ei = 0.f;
#pragma unroll 4
                for (int j = 0; j < 16; ++j) { const LAS unsigned char* row = SL + (c0 + j) * UROW;
                    const float sr = *(const LAS float*)(row + p * 4), si = *(const LAS float*)(row + 256 + p * 4);
                    const float nr = a16r * er - a16i * ei + sr, ni = a16r * ei + a16i * er + si; er = nr; ei = ni; }
                Eb[wave * 64 + p] = (f32x2){er, ei};
                float Ar = a16r, Ai = a16i;
#pragma unroll
                for (int sq = 0; sq < 4; ++sq) { const float tr = Ar * Ar - Ai * Ai, ti = 2.0f * Ar * Ai; Ar = tr; Ai = ti; }
                __syncthreads();
                float hr = 0.f, hi = 0.f;
                for (int v = 0; v < wave; ++v) { const f32x2 e = Eb[v * 64 + p]; const float nr = Ar * hr - Ai * hi + e[0], ni = Ar * hi + Ai * hr + e[1]; hr = nr; hi = ni; }
                if (wave == 7) { out[OFF_RE_P + (size_t)(n * 64 + g) * 64 + p] = Ar * hr - Ai * hi + er; out[OFF_IM_P + (size_t)(n * 64 + g) * 64 + p] = Ar * hi + Ai * hr + ei; }
#pragma unroll 4
                for (int j = 0; j < 16; ++j) { LAS unsigned char* row = SL + (c0 + j) * UROW;
                    const float sr = *(const LAS float*)(row + p * 4), si = *(const LAS float*)(row + 256 + p * 4);
                    const unsigned hb = cvt_pk_bf16(hr, hi);
                    *(LAS bf16_t*)(row + p * 2) = (bf16_t)(hb & 0xffffu); *(LAS bf16_t*)(row + 128 + p * 2) = (bf16_t)(hb >> 16);
                    const float nhr = a16r * hr - a16i * hi + sr, nhi = a16r * hi + a16i * hr + si; hr = nhr; hi = nhi; }
            }
            __syncthreads();
            {
                f32x16 y0, y1, y2, y3;
#pragma unroll
                for (int r = 0; r < 16; ++r) { y0[r] = 0.f; y1[r] = 0.f; y2[r] = 0.f; y3[r] = 0.f; }
                const int tq = 2 * wave + (li_ >> 4), hp = li_ & 15;
                const LAS unsigned char* ub = UL + li_ * UROW + 16 * kq;
                for (int ks = 0; ks <= 2 * wave + 1; ++ks) { const int d = tq - ks;
                    bf16x8 af = (bf16x8){0, 0, 0, 0, 0, 0, 0, 0}; if (d >= 0) af = *(const LAS bf16x8*)(KL + ((d * 16 + hp) * 16 + 8 * kq) * 2);
                    y0 = __builtin_amdgcn_mfma_f32_32x32x16_bf16(af, *(const LAS bf16x8*)(ub + 32 * ks), y0, 0, 0, 0);
                    y1 = __builtin_amdgcn_mfma_f32_32x32x16_bf16(af, *(const LAS bf16x8*)(ub + 32 * UROW + 32 * ks), y1, 0, 0, 0);
                    y2 = __builtin_amdgcn_mfma_f32_32x32x16_bf16(af, *(const LAS bf16x8*)(ub + 64 * UROW + 32 * ks), y2, 0, 0, 0);
                    y3 = __builtin_amdgcn_mfma_f32_32x32x16_bf16(af, *(const LAS bf16x8*)(ub + 96 * UROW + 32 * ks), y3, 0, 0, 0); }
                const LAS unsigned char* hb = SL + li_ * UROW + 16 * kq;
#pragma unroll
                for (int kc = 0; kc < 8; ++kc) { const bf16x8 af = qmf[kc];
                    y0 = __builtin_amdgcn_mfma_f32_32x32x16_bf16(af, *(const LAS bf16x8*)(hb + 32 * kc), y0, 0, 0, 0);
                    y1 = __builtin_amdgcn_mfma_f32_32x32x16_bf16(af, *(const LAS bf16x8*)(hb + 32 * UROW + 32 * kc), y1, 0, 0, 0);
                    y2 = __builtin_amdgcn_mfma_f32_32x32x16_bf16(af, *(const LAS bf16x8*)(hb + 64 * UROW + 32 * kc), y2, 0, 0, 0);
                    y3 = __builtin_amdgcn_mfma_f32_32x32x16_bf16(af, *(const LAS bf16x8*)(hb + 96 * UROW + 32 * kc), y3, 0, 0, 0); }
#define SSM_STORE(yv, cb) do { _Pragma("unroll") for (int rq = 0; rq < 4; ++rq) { f32x4 v = (f32x4){yv[4 * rq], yv[4 * rq + 1], yv[4 * rq + 2], yv[4 * rq + 3]}; \
                    _Pragma("unroll") for (int j = 0; j < 4; ++j) v[j] = gelu_tanh_f(v[j]); \
                    const int tok = 16 * (32 * (cb) + li_) + 2 * wave + (rq >> 1); \
                    *(u32x2*)(SSMACT + (size_t)(n * 2048 + tok) * 1024 + g * 16 + 8 * (rq & 1) + 4 * kq) = pack4(v); } } while (0)
                SSM_STORE(y0, 0); SSM_STORE(y1, 1); SSM_STORE(y2, 2); SSM_STORE(y3, 3);
#undef SSM_STORE
            }
        }
        __syncthreads();
        {
            const int lane = lane_id();
            const int gwv = bid * 8 + wave, g = gwv & 63, ns0 = (gwv >> 6) * 4, p = lane;
            if (gwv < 2048) {
                const f32x2 av = ABAR[g * 64 + p]; const float ar = av[0], ai = av[1];
                float Br[16], Bi[16];
#pragma unroll
                for (int q = 0; q < 8; ++q) { const f32x4 b = *((const f32x4*)(BBAR + (size_t)(g * 64 + p) * 16) + q); Br[2 * q] = b[0]; Bi[2 * q] = b[1]; Br[2 * q + 1] = b[2]; Bi[2 * q + 1] = b[3]; }
                const int hp = lane & 15, pq = lane >> 4;
                f32x4 Cr[4], Ci[4];
#pragma unroll
                for (int q = 0; q < 4; ++q) { Cr[q] = *(const f32x4*)(a.in[I_CRE] + (size_t)(g * 16 + hp) * 64 + pq * 16 + q * 4); Ci[q] = *(const f32x4*)(a.in[I_CIM] + (size_t)(g * 16 + hp) * 64 + pq * 16 + q * 4); }
                const float dsk = a.in[I_D][g * 16 + hp];
#pragma unroll
                for (int k = 0; k < 4; ++k) { const int ns = ns0 + k;
                    const bf16_t* ur = Usam + (size_t)ns * 1024 + g * 16; float bur = 0.f, bui = 0.f;
#pragma unroll
                    for (int q = 0; q < 4; ++q) { const f32x4 uv = unpack4(*(const u32x2*)(ur + q * 4));
#pragma unroll
                        for (int jj = 0; jj < 4; ++jj) { bur += Br[q * 4 + jj] * uv[jj]; bui += Bi[q * 4 + jj] * uv[jj]; } }
                    const float h0r = a.in[I_SRE][(size_t)(ns * 64 + g) * 64 + p], h0i = a.in[I_SIM][(size_t)(ns * 64 + g) * 64 + p];
                    const float hr = ar * h0r - ai * h0i + bur, hi = ar * h0i + ai * h0r + bui;
                    out[OFF_RE_S + (size_t)(ns * 64 + g) * 64 + p] = hr; out[OFF_IM_S + (size_t)(ns * 64 + g) * 64 + p] = hi;
                    *(LAS f32x2*)(Hl + k * 128 + p * 2) = (f32x2){hr, hi};
                    float y = 0.f;
#pragma unroll
                    for (int q = 0; q < 4; ++q)
#pragma unroll
                        for (int jj = 0; jj < 4; ++jj) { const f32x2 hv = *(const LAS f32x2*)(Hl + k * 128 + (pq * 16 + q * 4 + jj) * 2); y += Cr[q][jj] * hv[0] - Ci[q][jj] * hv[1]; }
                    y += shfl_xor_f(y, lane, 16); y += shfl_xor_f(y, lane, 32);
                    if (pq == 0) { y = gelu_tanh_f(y + dsk * bf_lo((unsigned)ur[hp])); SSMACT[(size_t)(MPR + ns) * 1024 + g * 16 + hp] = (bf16_t)(cvt_pk_bf16(y, 0.f) & 0xffffu); }
                }
            }
        }
        __syncthreads();
        if (!conv_first) { const int lane = lane_id(); LAS float* scr = (LAS float*)(lds + wave * 16640); const int gw = bid * 8 + wave, NGW = G * 8; TRANSPOSE_ITEMS(TI_EARLY, TI_ALL - TI_O); }
}
    GRID_SYNC();
    }

    {
    {
        const int half = G >> 1;
        if (bid >= half) { FRESH_IDS LAS float* scr = (LAS float*)(lds + wave * 16640); const int gw = (bid - half) * 8 + wave, NGW = (G - half) * 8; TRANSPOSE_ITEMS(TI_ALL - TI_O, TI_ALL); }
        __syncthreads();
    }
    { pg8::Gemm g{DIFF, W_POOL, 1024, 256, 256, 32, 4, 256, 128, 256}; EpiBf E{YCAT, 2048, a.in[I_PSCALE]}; pg8::gemm_phase(lds, g, G, bid, wave_s, E); }
    { pg8::Gemm g{SSMACT, W_GLU, 1024, 1024, 1024, 32, 8, 0, 1024, 128}; EpiGlu E{YCAT, 2048, 1024}; pg8::gemm_phase(lds, g, G, bid, wave_s, E); }
    GRID_SYNC();
    }

    {
    { pg8::Gemm g{YCAT, W_BP, 2048, 2048, 2048, 32, 8, 0, 128, 256}; EpiMerge E{GATES, MERGED}; pg8::gemm_phase(lds, g, G, bid, wave_s, E); }
    GRID_SYNC();
    }

    {
    { pg8::Gemm g{MERGED, W_OUT, 2048, 2048, 2048, 32, 8, 0, 128, 256}; EpiRes<false> E{Hb, X1B, RS1, INVR}; pg8::gemm_phase(lds, g, G, bid, wave_s, E); }
    GRID_SYNC();
    }

    {
    const LAS float* up_stg = nullptr;
    if ((32 * 48 + G - 1) / G <= UP_STG_MAX) {
        FRESH_IDS
        LAS float* stg = (LAS float*)(lds + 131072);
        pg8::StaticOrder S6; S6.init(32, 48, G, bid); Unit u6;
        for (int ui = 0; ui < UP_STG_MAX && S6.next(ui, u6); ++ui) { LAS float* su = stg + ui * UP_STG;
            if (tid < 256) { const float* rp = RS1 + (size_t)(u6.pm * 256 + tid) * RS_SLOTS; float sum = 0.f;
#pragma unroll
                for (int q = 0; q < 8; ++q) { const f32x4 v = *(const f32x4*)(rp + 4 * q); sum += (v[0] + v[1]) + (v[2] + v[3]); }
                su[tid] = rsqrtf(sum * (1.0f / (float)DM) + EPS);
            } else if (tid < 260) { const float* rp = RS1 + (size_t)(MPR + 4 * u6.pm + (tid - 256)) * RS_SLOTS; float sum = 0.f;
#pragma unroll
                for (int q = 0; q < 16; ++q) { const f32x4 v = *(const f32x4*)(rp + 4 * q); sum += (v[0] + v[1]) + (v[2] + v[3]); }
                su[tid] = rsqrtf(sum * (1.0f / (float)DM) + EPS); }
            { const int kk = tid >> 7, c = tid & 127; su[272 + tid] = kk < 3 ? a.in[I_WCONV][kk * 6144 + u6.pn * 128 + c] : a.in[I_BCONV][u6.pn * 128 + c]; }
        }
        __syncthreads();
        up_stg = stg;
    }
    { pg8::Gemm g{X1B, W_UP, 2048, 2048, 2048, 32, 48, 0, 6144, 128}; EpiUp E{RS1, VBUF, SAb, SAb + 128 * SA_BLK, out, a.in[I_WCONV], a.in[I_BCONV], up_stg}; pg8::gemm_phase(lds, g, G, bid, wave_s, E); }
    GRID_SYNC();
    }

    {
    {
        FRESH_IDS
        const float* WC = a.in[I_WCONV]; const float* BC = a.in[I_BCONV]; const float* CC = a.in[I_CCONV]; const float* SAS = SAb + 128 * SA_BLK;
        constexpr int NIT = (256 + 128) * 768;
        for (int id0 = bid * 512 + tid; id0 < NIT; id0 += 3 * G * 512) {
            f32x4 w0a[3], w0b[3], w1a[3], w1b[3], w2a[3], w2b[3], bca[3], bcb[3], a0[3], a1[3], m1a[3], m1b[3], m2a[3], m2b[3]; u32x4 vv[3]; int rows[3], c0s[3];
            const f32x4 z4 = (f32x4){0.f, 0.f, 0.f, 0.f};
#pragma unroll
            for (int k = 0; k < 3; ++k) { const int idk = id0 + k * G * 512; const int id = idk < NIT ? idk : id0;
                const int ri = id / 768, c0 = (id - ri * 768) * 8; c0s[k] = c0;
                w0a[k] = *(const f32x4*)(WC + c0); w0b[k] = *(const f32x4*)(WC + c0 + 4); w1a[k] = *(const f32x4*)(WC + 6144 + c0); w1b[k] = *(const f32x4*)(WC + 6144 + c0 + 4);
                w2a[k] = *(const f32x4*)(WC + 12288 + c0); w2b[k] = *(const f32x4*)(WC + 12288 + c0 + 4); bca[k] = *(const f32x4*)(BC + c0); bcb[k] = *(const f32x4*)(BC + c0 + 4);
                m1a[k] = z4; m1b[k] = z4; m2a[k] = z4; m2b[k] = z4; int row;
                if (ri < 256) { const int blk = ri >> 1, j = ri & 1; row = 64 * blk + j; const bool first = (blk & 31) == 0;
                    const float* sb = SAb + (size_t)blk * SA_BLK + c0; a0[k] = __builtin_nontemporal_load((const f32x4*)(sb + (size_t)j * 6144)); a1[k] = __builtin_nontemporal_load((const f32x4*)(sb + (size_t)j * 6144 + 4));
                    const float* sp = sb - SA_BLK;
                    if (j == 0) { if (!first) { m1a[k] = *(const f32x4*)(sp + 3 * 6144); m1b[k] = *(const f32x4*)(sp + 3 * 6144 + 4); m2a[k] = *(const f32x4*)(sp + 2 * 6144); m2b[k] = *(const f32x4*)(sp + 2 * 6144 + 4); } }
                    else { m1a[k] = *(const f32x4*)sb; m1b[k] = *(const f32x4*)(sb + 4); if (!first) { m2a[k] = *(const f32x4*)(sp + 3 * 6144); m2b[k] = *(const f32x4*)(sp + 3 * 6144 + 4); } }
                } else { const int ns = ri - 256; row = MPR + ns; const float* c = CC + (size_t)ns * 2 * 6144 + c0;
                    m2a[k] = *(const f32x4*)c; m2b[k] = *(const f32x4*)(c + 4); m1a[k] = *(const f32x4*)(c + 6144); m1b[k] = *(const f32x4*)(c + 6144 + 4);
                    a0[k] = __builtin_nontemporal_load((const f32x4*)(SAS + (size_t)ns * 6144 + c0)); a1[k] = __builtin_nontemporal_load((const f32x4*)(SAS + (size_t)ns * 6144 + c0 + 4)); }
                rows[k] = row;
                vv[k] = __builtin_nontemporal_load((const u32x4*)(VBUF + (size_t)(c0 >> 11) * ((size_t)MPAD * 2048) + (size_t)row * 2048 + (c0 & 2047))); }
#pragma unroll
            for (int k = 0; k < 3; ++k) { const int idk = id0 + k * G * 512; if (idk >= NIT) continue;
                const int row = rows[k], c0 = c0s[k];
                if (row >= MPR) { float* q = out + OFF_CONV_S + (size_t)(row - MPR) * 2 * 6144 + c0; *(f32x4*)q = m1a[k]; *(f32x4*)(q + 4) = m1b[k]; }
                bf16_t* vp = VBUF + (size_t)(c0 >> 11) * ((size_t)MPAD * 2048) + (size_t)row * 2048 + (c0 & 2047); f32x4 v0, v1; unpack8(vv[k], v0, v1);
                f32x4 ca = bca[k] + w0a[k] * m2a[k] + w1a[k] * m1a[k] + w2a[k] * a0[k], cb = bcb[k] + w0b[k] * m2b[k] + w1b[k] * m1b[k] + w2b[k] * a1[k];
#pragma unroll
                for (int j = 0; j < 4; ++j) { ca[j] = gelu_tanh_f(ca[j]) * v0[j]; cb[j] = gelu_tanh_f(cb[j]) * v1[j]; }
                *(u32x4*)vp = pack8(ca, cb); }
        }
    }
    GRID_SYNC();
    }

    {
    { pg8::Gemm g{VBUF, W_DOWN, 2048, 2048, 6144, 32, 8, 0, 128, 256, 5, (unsigned)((size_t)MPAD * 2048 * 2), (unsigned)(2048u * 2048u * 2u)}; EpiRes<true> E{X1B, X2B, RS2, nullptr}; pg8::gemm_phase(lds, g, G, bid, wave_s, E); }
    GRID_SYNC();
    }

    if constexpr (FUSE_FINAL) {
    { pg8::Gemm g{X2B, W_PG, 2048, 2048, 2048, 32, 8, 0, 128, 256}; EpiPleF E{RS2, Pb, X2B, RS3, out, a.in[I_GFINAL], xbar.bar}; pg8::gemm_phase(lds, g, G, bid, wave_s, E); }
    } else {
    {
    { pg8::Gemm g{X2B, W_PG, 2048, 2048, 2048, 32, 8, 0, 128, 256}; EpiPle E{RS2, Pb, X2B, RS3, X1B}; pg8::gemm_phase(lds, g, G, bid, wave_s, E); }
    GRID_SYNC();
    }
    { FRESH_IDS
    for (int row = bid * 8 + wave; row < MT; row += G * 8) {
        const float r = rsqrtf(wave_sum((row < MPR && lane >= 32) ? 0.f : RS3[(size_t)row * RS_SLOTS + lane], lane) * (1.0f / (float)DM) + EPS);
        const u32x4* xi = (const u32x4*)(X1B + (size_t)row * 2048) + lane; f32x4* o = (f32x4*)(out + (size_t)row * 2048) + 2 * lane;
#pragma unroll
        for (int j = 0; j < 4; ++j) { f32x4 v0, v1; unpack8(xi[64 * j], v0, v1); const f32x4 g0 = *((const f32x4*)a.in[I_GFINAL] + 2 * lane + 128 * j), g1 = *((const f32x4*)a.in[I_GFINAL] + 2 * lane + 128 * j + 1);
            o[128 * j] = v0 * r * g0; o[128 * j + 1] = v1 * r * g1; }
    } }
    }
}

extern "C" void kernel_launch(void* const* d_in, const int* in_sizes, int n_in, void* d_out, int out_size, void* d_ws, size_t ws_size, hipStream_t stream) {
    static int grid = 0; static const void* fn = nullptr;
    if (grid == 0) {
        if (n_in != 33 || ws_size < WS_END) { fprintf(stderr, "kernel_launch: unexpected n_in %d or ws_size %zu (< %zu)\n", n_in, ws_size, (size_t)WS_END); grid = -1; return; }
        int dev = 0, cus = 0, per_cu = 0;
        (void)hipGetDevice(&dev); (void)hipDeviceGetAttribute(&cus, hipDeviceAttributeMultiprocessorCount, dev);
        fn = cus == 256 ? (const void*)fwd_kernel<true> : (const void*)fwd_kernel<false>;
        if (hipFuncSetAttribute(fn, hipFuncAttributeMaxDynamicSharedMemorySize, LDS_BYTES) != hipSuccess) { fprintf(stderr, "kernel_launch: hipFuncSetAttribute failed\n"); grid = -1; return; }
        if (hipOccupancyMaxActiveBlocksPerMultiprocessor(&per_cu, fn, 512, LDS_BYTES) != hipSuccess || per_cu < 1) { fprintf(stderr, "kernel_launch: occupancy query says %d blocks/CU\n", per_cu); grid = -1; return; }
        grid = cus;
        fprintf(stderr, "kernel_launch: grid %d (per_cu %d), ws %zu\n", grid, per_cu, ws_size);
    }
    if (grid < 0) return;
    if (hipMemsetAsync((char*)d_ws + WS_CTL, 0, XCD_BAR_WORDS * sizeof(unsigned), stream) != hipSuccess) { fprintf(stderr, "kernel_launch: hipMemsetAsync of the barrier words failed\n"); return; }
    Args a{};
    for (int i = 0; i < 33; ++i) a.in[i] = (const float*)d_in[i];
    a.out = (float*)d_out; a.ws = (unsigned char*)d_ws;
    void* args[] = {&a};
    hipError_t e = hipLaunchCooperativeKernel(fn, dim3(grid), dim3(512), args, LDS_BYTES, stream);
    if (e != hipSuccess) fprintf(stderr, "kernel_launch: cooperative launch failed: %s\n", hipGetErrorString(e));
}
```
